# Optimizing an MI355X kernel written in HIP

```python
import jax, jax.numpy as jnp
from jax import lax
import numpy as np

D_MODEL = 2048
BATCH = 2
SEQ = 8192
DEPTH = 2

GRID_W = 64
CTX_LEN = 256
HEAD_DIM = 128
ATT_Q_HEADS = 4
ATT_KV_HEADS = 2
LRU_WIDTH = 1024
LRU_BLOCKS = 8
LRU_BLOCK = LRU_WIDTH // LRU_BLOCKS
LRU_C = 8.0
CONV_W = 4
NA_HEADS = 4
NA_ROWS = 8
NA_COLS = 16
Q_BLOCK = 128
ATT_Q_W = ATT_Q_HEADS * HEAD_DIM
ATT_KV_W = ATT_KV_HEADS * HEAD_DIM
NA_W = NA_HEADS * HEAD_DIM
MIX_WIDTH = ATT_Q_W + LRU_WIDTH + NA_W
IN_WIDTH = ATT_Q_W + 2 * ATT_KV_W + 2 * LRU_WIDTH + 3 * NA_W
MOE_GROUPS = 4
MOE_EXPERTS_PER_GROUP = 8
MOE_EXPERTS = MOE_GROUPS * MOE_EXPERTS_PER_GROUP
MOE_TOP_K = 2
MOE_HIDDEN = 1024
MOE_BLOCK = 128
ROPE_THETA = 10000.0
EPS = 1e-6

kernel_name = 'hybrid_parallel_mixer_dit_block'


def _rmsnorm(x, g):
    x32 = x.astype(jnp.float32)
    y = x32 * lax.rsqrt(jnp.mean(x32 * x32, axis=-1, keepdims=True) + EPS)
    return y.astype(x.dtype) * g


def _heads(t, n):
    return t.reshape(*t.shape[:-1], n, HEAD_DIM)


def _split_cols(p):
    sizes = (ATT_Q_W, ATT_KV_W, ATT_KV_W, LRU_WIDTH, LRU_WIDTH, NA_W, NA_W, NA_W)
    idx = [int(i) for i in np.cumsum(sizes)[:-1]]
    return jnp.split(p, idx, axis=-1)


def _axial_rope_tables(n_tokens):
    pos = jnp.arange(n_tokens, dtype=jnp.int32)
    rows = (pos // GRID_W).astype(jnp.float32)
    cols = (pos % GRID_W).astype(jnp.float32)
    n_freq = HEAD_DIM // 4
    inv = 1.0 / (ROPE_THETA ** (jnp.arange(n_freq, dtype=jnp.float32) / n_freq))
    ang = jnp.stack([rows[:, None] * inv, cols[:, None] * inv], axis=1)
    return jnp.cos(ang), jnp.sin(ang)


def _rope(t, cos, sin):
    n_freq = HEAD_DIM // 4
    t32 = t.astype(jnp.float32).reshape(*t.shape[:-1], 2, 2, n_freq)
    t1, t2 = t32[..., 0, :], t32[..., 1, :]
    cs = cos[None, :, None]
    sn = sin[None, :, None]
    out = jnp.stack([t1 * cs - t2 * sn, t2 * cs + t1 * sn], axis=-2)
    return out.reshape(t.shape).astype(t.dtype)


def _gqa_attend(q, k, v):
    s = jnp.einsum('bqkgd,bskd->bkgqs', q, k).astype(jnp.float32) * (HEAD_DIM ** -0.5)
    p = jax.nn.softmax(s, axis=-1).astype(v.dtype)
    return jnp.einsum('bkgqs,bskd->bqkgd', p, v)


def _gqa_latent(q, k, v, k_ctx, v_ctx):
    B, S = q.shape[:2]
    g = ATT_Q_HEADS // ATT_KV_HEADS
    k_all = jnp.concatenate([k, k_ctx], axis=1)
    v_all = jnp.concatenate([v, v_ctx], axis=1)
    qb = jnp.moveaxis(q.reshape(B, S // Q_BLOCK, Q_BLOCK, ATT_KV_HEADS, g, HEAD_DIM), 1, 0)
    o = lax.map(lambda qi: _gqa_attend(qi, k_all, v_all), qb)
    return jnp.moveaxis(o, 0, 1).reshape(B, S, ATT_Q_W)


def _neighbourhood_latent(q, k, v, k_ctx, v_ctx, rpb):
    B, S = q.shape[:2]
    rows = S // GRID_W
    kr = min(NA_ROWS, rows)
    qg = q.reshape(B, rows, GRID_W, NA_HEADS, HEAD_DIM)
    kg = k.reshape(B, rows, GRID_W, NA_HEADS, HEAD_DIM)
    vg = v.reshape(B, rows, GRID_W, NA_HEADS, HEAD_DIM)
    j = np.arange(GRID_W)
    cs = np.clip(j - NA_COLS // 2, 0, GRID_W - NA_COLS)
    col_idx = cs[:, None] + np.arange(NA_COLS)[None, :]
    dc_idx = col_idx - j[:, None] + (NA_COLS - 1)
    bias_c = rpb[:, :, dc_idx]
    n_loc = kr * NA_COLS
    scale = HEAD_DIM ** -0.5

    def one_row(r):
        rs = jnp.clip(r - NA_ROWS // 2, 0, rows - kr)
        kb = lax.dynamic_slice_in_dim(kg, rs, kr, axis=1)
        vb = lax.dynamic_slice_in_dim(vg, rs, kr, axis=1)
        kn = kb[:, :, col_idx]
        vn = vb[:, :, col_idx]
        qr = lax.dynamic_index_in_dim(qg, r, axis=1, keepdims=False)
        dr_idx = rs + jnp.arange(kr) - r + (NA_ROWS - 1)
        bias = jnp.take(bias_c, dr_idx, axis=1).transpose(0, 2, 1, 3)
        s_loc = jnp.einsum('bjhd,bajchd->bhjac', qr, kn).astype(jnp.float32) * scale
        s_loc = s_loc + bias[None].astype(jnp.float32)
        s_ctx = jnp.einsum('bjhd,bnhd->bhjn', qr, k_ctx).astype(jnp.float32) * scale
        s = jnp.concatenate([s_loc.reshape(B, NA_HEADS, GRID_W, n_loc), s_ctx], axis=-1)
        p = jax.nn.softmax(s, axis=-1).astype(v.dtype)
        p_loc = p[..., :n_loc].reshape(B, NA_HEADS, GRID_W, kr, NA_COLS)
        p_ctx = p[..., n_loc:]
        o = jnp.einsum('bhjac,bajchd->bjhd', p_loc, vn) + jnp.einsum('bhjn,bnhd->bjhd', p_ctx, v_ctx)
        return o.reshape(B, GRID_W, NA_W)

    o = lax.map(one_row, jnp.arange(rows, dtype=jnp.int32))
    return jnp.moveaxis(o, 0, 1).reshape(B, S, NA_W)


def _dwconv(x, w, b):
    L = x.shape[1]
    left = (CONV_W - 1) // 2
    right = CONV_W - 1 - left
    xp = jnp.pad(x, ((0, 0), (left, right), (0, 0)))
    y = b
    for i in range(CONV_W):
        y = y + xp[:, i:i + L] * w[i]
    return y


def _blockdiag(x, w, b):
    xb = x.reshape(*x.shape[:-1], LRU_BLOCKS, LRU_BLOCK)
    return jnp.einsum('blnk,nkm->blnm', xb, w).reshape(x.shape) + b


def _lin_combine(left, right):
    return (left[0] * right[0], right[0] * left[1] + right[1])


def _rglru_dir(u, wr, br, wi, bi, lam, h0, reverse):
    if reverse:
        u = jnp.flip(u, axis=1)
    r = jax.nn.sigmoid(_blockdiag(u, wr, br)).astype(jnp.float32)
    i = jax.nn.sigmoid(_blockdiag(u, wi, bi)).astype(jnp.float32)
    log_a = -LRU_C * r * jax.nn.softplus(-lam.astype(jnp.float32))
    a = jnp.exp(log_a)
    b = jnp.sqrt(-jnp.expm1(2.0 * log_a)) * (i * u.astype(jnp.float32))
    a_cum, b_cum = lax.associative_scan(_lin_combine, (a, b), axis=1)
    h = b_cum if h0 is None else a_cum * h0[:, None] + b_cum
    final = h[:, -1]
    if reverse:
        h = jnp.flip(h, axis=1)
    return h, final


def _rglru_mixer(ul, gl, uc, gc, conv_w, conv_b, wr, br, wi, bi, lam, with_ctx_out):
    ul = _dwconv(ul, conv_w, conv_b)
    uc = _dwconv(uc, conv_w, conv_b)
    yl = None
    yc = None
    for d in range(2):
        hc, hc_final = _rglru_dir(uc, wr[d], br[d], wi[d], bi[d], lam[d], None, d == 1)
        hl, _ = _rglru_dir(ul, wr[d], br[d], wi[d], bi[d], lam[d], hc_final, d == 1)
        yl = hl if yl is None else yl + hl
        yc = hc if yc is None else yc + hc
    out_l = yl.astype(gl.dtype) * jax.nn.gelu(gl)
    out_c = yc.astype(gc.dtype) * jax.nn.gelu(gc) if with_ctx_out else None
    return out_l, out_c


def _hmoe(h, wg, bg, we, be, w_gate, w_up, w_down):
    T, D = h.shape
    lg = (h @ wg + bg).astype(jnp.float32)
    pg = jax.nn.softmax(lg, axis=-1)
    g_star = jnp.argmax(lg, axis=-1).astype(jnp.int32)
    g_gate = jnp.max(pg, axis=-1)
    le = (h @ we + be).astype(jnp.float32).reshape(T, MOE_GROUPS, MOE_EXPERTS_PER_GROUP)
    le_sel = jnp.take_along_axis(le, g_star[:, None, None], axis=1)[:, 0]
    vals, idx = lax.top_k(le_sel, MOE_TOP_K)
    w = (g_gate[:, None] * jax.nn.softmax(vals, axis=-1)).reshape(-1)
    e_ids = (g_star[:, None] * MOE_EXPERTS_PER_GROUP + idx).reshape(-1).astype(jnp.int32)
    tok = jnp.repeat(jnp.arange(T, dtype=jnp.int32), MOE_TOP_K)
    tk = T * MOE_TOP_K
    n_blocks = -(-(tk + MOE_EXPERTS * (MOE_BLOCK - 1)) // MOE_BLOCK)
    P = n_blocks * MOE_BLOCK
    order = jnp.argsort(e_ids)
    e_sorted = e_ids[order]
    counts = jnp.bincount(e_ids, length=MOE_EXPERTS)
    starts = jnp.cumsum(counts) - counts
    padded = (counts + MOE_BLOCK - 1) // MOE_BLOCK * MOE_BLOCK
    pad_ends = jnp.cumsum(padded)
    pad_starts = pad_ends - padded
    dest = pad_starts[e_sorted] + (jnp.arange(tk, dtype=jnp.int32) - starts[e_sorted])
    row_tok = jnp.full((P,), T, dtype=jnp.int32).at[dest].set(tok[order])
    row_w = jnp.zeros((P,), jnp.float32).at[dest].set(w[order])
    block_starts = jnp.arange(n_blocks, dtype=jnp.int32) * MOE_BLOCK
    block_e = jnp.minimum(jnp.searchsorted(pad_ends, block_starts, side='right'), MOE_EXPERTS - 1)
    xs = jnp.concatenate([h, jnp.zeros((1, D), h.dtype)], axis=0)[row_tok]
    xs = xs.reshape(n_blocks, MOE_BLOCK, D)

    def expert_block(args):
        xb, e = args
        return (jax.nn.silu(xb @ w_gate[e]) * (xb @ w_up[e])) @ w_down[e]

    yb = lax.map(expert_block, (xs, block_e)).reshape(P, D)
    y = jax.ops.segment_sum(yb * row_w[:, None].astype(yb.dtype), row_tok, num_segments=T + 1)
    return y[:T]


def setup_inputs(seed: int = 0) -> dict:
    key = jax.random.key(seed)
    ks = jax.random.split(key, 32)
    L = DEPTH
    f32 = jnp.float32

    def nrm(k, shape, scale):
        return jax.random.normal(k, shape, f32) * scale

    u = jax.random.uniform(ks[18], (L, 2, LRU_WIDTH), f32, 0.9, 0.999)
    return {
        'x': nrm(ks[0], (BATCH, SEQ, D_MODEL), 1.0),
        'c': nrm(ks[1], (BATCH, D_MODEL), 1.0),
        'ctx': nrm(ks[2], (BATCH, CTX_LEN, D_MODEL), 1.0),
        'c_ctx': nrm(ks[3], (D_MODEL,), 1.0),
        'ada_w': nrm(ks[4], (L, D_MODEL, 6 * D_MODEL), 0.5 * D_MODEL ** -0.5),
        'ada_b': nrm(ks[5], (L, 6 * D_MODEL), 0.01),
        'norm1_g': 1.0 + nrm(ks[6], (L, D_MODEL), 0.01),
        'norm2_g': 1.0 + nrm(ks[7], (L, D_MODEL), 0.01),
        'w_in': nrm(ks[8], (L, D_MODEL, IN_WIDTH), D_MODEL ** -0.5),
        'w_out': nrm(ks[9], (L, MIX_WIDTH, D_MODEL), MIX_WIDTH ** -0.5),
        'att_q_norm': 1.0 + nrm(ks[10], (L, HEAD_DIM), 0.01),
        'att_k_norm': 1.0 + nrm(ks[11], (L, HEAD_DIM), 0.01),
        'conv_w': nrm(ks[12], (L, CONV_W, LRU_WIDTH), CONV_W ** -0.5),
        'conv_b': nrm(ks[13], (L, LRU_WIDTH), 0.01),
        'lru_wr': nrm(ks[14], (L, 2, LRU_BLOCKS, LRU_BLOCK, LRU_BLOCK), LRU_BLOCK ** -0.5),
        'lru_br': nrm(ks[15], (L, 2, LRU_WIDTH), 0.01),
        'lru_wi': nrm(ks[16], (L, 2, LRU_BLOCKS, LRU_BLOCK, LRU_BLOCK), LRU_BLOCK ** -0.5),
        'lru_bi': nrm(ks[17], (L, 2, LRU_WIDTH), 0.01),
        'lru_lambda': jnp.log(u) - jnp.log1p(-u),
        'na_rpb': nrm(ks[19], (L, NA_HEADS, 2 * NA_ROWS - 1, 2 * NA_COLS - 1), 0.1),
        'router_wg': nrm(ks[20], (L, D_MODEL, MOE_GROUPS), D_MODEL ** -0.5),
        'router_bg': nrm(ks[21], (L, MOE_GROUPS), 0.01),
        'router_we': nrm(ks[22], (L, D_MODEL, MOE_EXPERTS), D_MODEL ** -0.5),
        'router_be': nrm(ks[23], (L, MOE_EXPERTS), 0.01),
        'moe_w_gate': nrm(ks[24], (L, MOE_EXPERTS, D_MODEL, MOE_HIDDEN), D_MODEL ** -0.5),
        'moe_w_up': nrm(ks[25], (L, MOE_EXPERTS, D_MODEL, MOE_HIDDEN), D_MODEL ** -0.5),
        'moe_w_down': nrm(ks[26], (L, MOE_EXPERTS, MOE_HIDDEN, D_MODEL), MOE_HIDDEN ** -0.5),
        'final_g': 1.0 + nrm(ks[27], (D_MODEL,), 0.01),
    }


def reference(x, c, ctx, c_ctx, ada_w, ada_b, norm1_g, norm2_g, w_in, w_out, att_q_norm, att_k_norm,
              conv_w, conv_b, lru_wr, lru_br, lru_wi, lru_bi, lru_lambda, na_rpb,
              router_wg, router_bg, router_we, router_be, moe_w_gate, moe_w_up, moe_w_down, final_g):
    B, S, D = x.shape
    C = ctx.shape[1]
    g_att = ATT_Q_HEADS // ATT_KV_HEADS
    cos, sin = _axial_rope_tables(S)
    s_lat = jax.nn.silu(c)
    s_ctx = jax.nn.silu(c_ctx)
    xc = ctx
    for l in range(DEPTH):
        update_ctx = l < DEPTH - 1
        m_lat = jnp.split((s_lat @ ada_w[l] + ada_b[l])[:, None, :], 6, axis=-1)
        m_ctx = jnp.split(s_ctx @ ada_w[l] + ada_b[l], 6, axis=-1)
        h = _rmsnorm(x, norm1_g[l]) * (1.0 + m_lat[1]) + m_lat[0]
        hc = _rmsnorm(xc, norm1_g[l]) * (1.0 + m_ctx[1]) + m_ctx[0]
        qa, ka, va, ub, gb, qn, kn, vn = _split_cols(h @ w_in[l])
        qa_c, ka_c, va_c, ub_c, gb_c, qn_c, kn_c, vn_c = _split_cols(hc @ w_in[l])

        qa = _rope(_rmsnorm(_heads(qa, ATT_Q_HEADS), att_q_norm[l]), cos, sin)
        ka = _rope(_rmsnorm(_heads(ka, ATT_KV_HEADS), att_k_norm[l]), cos, sin)
        ka_c = _rmsnorm(_heads(ka_c, ATT_KV_HEADS), att_k_norm[l])
        va_c = _heads(va_c, ATT_KV_HEADS)
        oa = _gqa_latent(qa, ka, _heads(va, ATT_KV_HEADS), ka_c, va_c)

        ob, ob_c = _rglru_mixer(ub, gb, ub_c, gb_c, conv_w[l], conv_b[l], lru_wr[l], lru_br[l],
                                lru_wi[l], lru_bi[l], lru_lambda[l], update_ctx)

        kn_c = _heads(kn_c, NA_HEADS)
        vn_c = _heads(vn_c, NA_HEADS)
        oc = _neighbourhood_latent(_heads(qn, NA_HEADS), _heads(kn, NA_HEADS), _heads(vn, NA_HEADS),
                                   kn_c, vn_c, na_rpb[l])

        x = x + m_lat[2] * (jnp.concatenate([oa, ob, oc], axis=-1) @ w_out[l])
        h2 = _rmsnorm(x, norm2_g[l]) * (1.0 + m_lat[4]) + m_lat[3]
        tokens = h2.reshape(B * S, D)
        if update_ctx:
            qa_c = _rmsnorm(_heads(qa_c, ATT_Q_HEADS), att_q_norm[l])
            oa_c = _gqa_attend(qa_c.reshape(B, C, ATT_KV_HEADS, g_att, HEAD_DIM), ka_c, va_c)
            oc_c = _gqa_attend(_heads(qn_c, NA_HEADS)[:, :, :, None], kn_c, vn_c)
            o_c = jnp.concatenate([oa_c.reshape(B, C, ATT_Q_W), ob_c, oc_c.reshape(B, C, NA_W)], axis=-1)
            xc = xc + m_ctx[2] * (o_c @ w_out[l])
            h2c = _rmsnorm(xc, norm2_g[l]) * (1.0 + m_ctx[4]) + m_ctx[3]
            y = _hmoe(jnp.concatenate([tokens, h2c.reshape(B * C, D)], axis=0), router_wg[l], router_bg[l],
                      router_we[l], router_be[l], moe_w_gate[l], moe_w_up[l], moe_w_down[l])
            x = x + m_lat[5] * y[:B * S].reshape(B, S, D)
            xc = xc + m_ctx[5] * y[B * S:].reshape(B, C, D)
        else:
            y = _hmoe(tokens, router_wg[l], router_bg[l], router_we[l], router_be[l],
                      moe_w_gate[l], moe_w_up[l], moe_w_down[l])
            x = x + m_lat[5] * y.reshape(B, S, D)
    return _rmsnorm(x, final_g)
```

```cpp
#include <hip/hip_runtime.h>
#include <stdint.h>
#include <stdio.h>

#ifndef MK_N_LAUNCHES
#define MK_N_LAUNCHES 1
#endif

#define LAS __attribute__((address_space(3)))
typedef unsigned short bf16_t;
typedef short bf16x8 __attribute__((ext_vector_type(8)));
typedef short s16x4 __attribute__((ext_vector_type(4)));
typedef float f32x2 __attribute__((ext_vector_type(2)));
typedef float f32x4 __attribute__((ext_vector_type(4)));
typedef float f32x16 __attribute__((ext_vector_type(16)));
typedef unsigned u32x2 __attribute__((ext_vector_type(2)));
typedef unsigned u32x4 __attribute__((ext_vector_type(4)));

constexpr int DM = 2048, NB = 2, SEQ = 8192, CTXL = 256, TB = SEQ + CTXL, MTOK = NB * TB;
constexpr int INW = 4608;
constexpr int C_QA = 0, C_KA = 512, C_VA = 768, C_UB = 1024, C_GB = 2048, C_QN = 3072, C_KN = 3584, C_VN = 4096;
constexpr int NEXP = 32, HID = 1024, CAP = MTOK, NCHUNK = TB / 64;
constexpr int PMAX = 2 * MTOK + NEXP * 256;
constexpr float EPS = 1e-6f;
constexpr int NTHR = 512;
constexpr int GRID = 256;

constexpr size_t al256(size_t x) { return (x + 255) / 256 * 256; }
constexpr size_t WS_CTL = 0, CTL_BYTES = 65536;
constexpr size_t CTL_CNT = 16384, CTL_Q = 20480;
constexpr size_t WS_MOD = WS_CTL + CTL_BYTES;
constexpr size_t WS_ROPE = WS_MOD + al256((size_t)2 * 3 * 12288 * 4);
constexpr size_t WS_WRT = WS_ROPE + 32768;
constexpr size_t WS_AGG = WS_WRT + al256((size_t)2 * 36 * 2048 * 4);
constexpr size_t WS_LDEST = WS_AGG + al256((size_t)2 * 2 * NCHUNK * 1024 * 8);
constexpr size_t WS_LW = WS_LDEST + al256((size_t)NEXP * CAP * 4);
constexpr size_t WS_X = WS_LW + al256((size_t)NEXP * CAP * 4);
constexpr size_t WS_HB = WS_X + al256((size_t)MTOK * DM * 4);
constexpr size_t WS_P = WS_HB + al256((size_t)MTOK * DM * 2);
constexpr size_t WS_MIX = WS_P + al256((size_t)MTOK * INW * 2);
constexpr size_t WS_ACT = WS_MIX + al256((size_t)MTOK * DM * 2);
constexpr size_t WS_Y = WS_ACT + al256((size_t)PMAX * HID * 2);
constexpr size_t WS_LAB = WS_Y + al256((size_t)MTOK * 2 * DM * 2);
constexpr size_t WS_WIN = WS_LAB + al256((size_t)NB * NCHUNK * 8 * 8 * 8 * 64 * 16);
constexpr size_t WS_WOUT = WS_WIN + al256((size_t)2 * INW * DM * 2);
constexpr size_t WS_LRUW = WS_WOUT + al256((size_t)2 * DM * DM * 2);
constexpr size_t WS_W1 = WS_LRUW + al256((size_t)2 * 2 * 8 * 2 * 128 * 128 * 2);
constexpr size_t WS_W2 = WS_W1 + al256((size_t)2 * NEXP * 2048 * DM);
constexpr size_t WS_END = WS_W2 + al256((size_t)2 * NEXP * DM * HID);

constexpr int LDS_STAGE = 131072;
constexpr int LDS_BARW = LDS_STAGE;
constexpr int LDS_MISC = LDS_STAGE + 64;
constexpr int LDS_UD = LDS_STAGE + 512;
constexpr int LDS_ROWS = LDS_STAGE + 1024;
constexpr int LDS_WTS = LDS_ROWS + 8192;
constexpr int LDS_BYTES = LDS_WTS + 8192;

struct Params { const float* in[30]; int ph_lo, ph_hi; };
enum { I_X = 0, I_C, I_CTX, I_CCTX, I_ADAW, I_ADAB, I_N1G, I_N2G, I_WIN, I_WOUT, I_QNORM, I_KNORM, I_CONVW, I_CONVB, I_LRUWR, I_LRUBR, I_LRUWI, I_LRUBI, I_LAM, I_RPB,
       I_RWG, I_RBG, I_RWE, I_RBE, I_MWG, I_MWU, I_MWD, I_FING, I_OUT, I_WS };

__device__ __forceinline__ unsigned cvt_pk_bf16(float lo, float hi) { unsigned r; asm volatile("v_cvt_pk_bf16_f32 %0, %1, %2" : "=v"(r) : "v"(lo), "v"(hi)); return r; }
__device__ __forceinline__ unsigned cvt_pk_fp8x4(float a, float b, float c, float d) { int w = 0; w = __builtin_amdgcn_cvt_pk_fp8_f32(a, b, w, false); w = __builtin_amdgcn_cvt_pk_fp8_f32(c, d, w, true); return (unsigned)w; }
__device__ __forceinline__ unsigned cvt_pk_fp8x4_sat(float a, float b, float c, float d) {
    return cvt_pk_fp8x4(__builtin_amdgcn_fmed3f(a, -448.f, 448.f), __builtin_amdgcn_fmed3f(b, -448.f, 448.f), __builtin_amdgcn_fmed3f(c, -448.f, 448.f), __builtin_amdgcn_fmed3f(d, -448.f, 448.f)); }
__device__ __forceinline__ float bflo(unsigned w) { return __uint_as_float(w << 16); }
__device__ __forceinline__ float bfhi(unsigned w) { return __uint_as_float(w & 0xffff0000u); }
__device__ __forceinline__ float wave_sum(float v) {
#pragma unroll
    for (int o = 32; o >= 1; o >>= 1) v += __shfl_xor(v, o);
    return v;
}
__device__ __forceinline__ float sigmoidf_(float x) { return __builtin_amdgcn_rcpf(1.0f + __expf(-x)); }
__device__ __forceinline__ float gelu_tanh(float x) { const float z = 0.7978845608028654f * (x + 0.044715f * x * x * x); const float e = __expf(2.0f * z); const float th = 1.0f - 2.0f * __builtin_amdgcn_rcpf(e + 1.0f); return 0.5f * x * (1.0f + th); }

#define XB_TMO      128
#define XB_XCNT(j)  (256  + 64 * (j))
#define XB_XSUB(j)  (1280 + 64 * (j))
#define XB_XGEN(j)  (2304 + 64 * (j))
#define XB_TOP      3328
#define XB_TOPGEN   3392
#define XCD_BAR_WORDS 3456
#define XB_SPIN_CAP (1u << 18)
__device__ __forceinline__ unsigned xb_ld(unsigned* p)              { return __hip_atomic_load(p, __ATOMIC_RELAXED, __HIP_MEMORY_SCOPE_AGENT); }
__device__ __forceinline__ unsigned xb_add(unsigned* p, unsigned v) { return __hip_atomic_fetch_add(p, v, __ATOMIC_RELAXED, __HIP_MEMORY_SCOPE_AGENT); }
__device__ __forceinline__ unsigned xb_xcc_id() { return (unsigned)__builtin_amdgcn_s_getreg((3 << 11) | 20) & 0xFu; }
#define XB_SPIN(cond, bar) do { unsigned _sp = 0; while (cond) { __builtin_amdgcn_s_sleep(1); \
    if ((++_sp & 255u) == 0u) { if (xb_ld(&(bar)[XB_TMO])) break; if (_sp > XB_SPIN_CAP) { atomicAdd(&(bar)[XB_TMO], 1u); break; } } } } while (0)
struct XcdBarrier { unsigned* bar; unsigned x; volatile LAS unsigned* st; };
__device__ __forceinline__ XcdBarrier xcd_barrier_post(unsigned* bar, volatile LAS unsigned* st) {
    XcdBarrier b; b.bar = bar; b.x = xb_xcc_id(); b.st = st;
    if (threadIdx.x == 0) (void)xb_add(&bar[XB_XCNT(b.x)], 1u);
    return b;
}
__device__ __forceinline__ void xcd_barrier_complete(unsigned* bar, unsigned x, unsigned& nloc, unsigned& nx) {
    const unsigned G = gridDim.x * gridDim.y * gridDim.z;
    unsigned sum, cnt, mine, sp = 0u;
    for (;;) {
        sum = 0u; cnt = 0u; mine = 0u;
#pragma unroll
        for (unsigned j = 0; j < 16; ++j) { const unsigned c = xb_ld(&bar[XB_XCNT(j)]); sum += c; cnt += (c > 0u) ? 1u : 0u; mine = (j == x) ? c : mine; }
        if (sum == G) break;
        __builtin_amdgcn_s_sleep(1);
        if ((++sp & 255u) == 0u) { if (xb_ld(&bar[XB_TMO])) break; if (sp > XB_SPIN_CAP) { atomicAdd(&bar[XB_TMO], 1u); break; } }
    }
    nloc = mine > 0u ? mine : 1u; nx = cnt > 0u ? cnt : 1u;
}
__device__ __forceinline__ void xcd_barrier(const XcdBarrier& b) {
    asm volatile("s_waitcnt vmcnt(0)" ::: "memory");
    __syncthreads();
    if (threadIdx.x == 0) {
        unsigned* bar = b.bar;
        __builtin_amdgcn_s_waitcnt(0);
        unsigned nloc = b.st[0], nx = b.st[1];
        if (nloc == 0u) { xcd_barrier_complete(bar, b.x, nloc, nx); b.st[0] = nloc; b.st[1] = nx; }
        const unsigned old = xb_add(&bar[XB_XSUB(b.x)], 1u);
        const unsigned gen = old / nloc;
        if (old + 1u == (gen + 1u) * nloc) {
            __builtin_amdgcn_fence(__ATOMIC_RELEASE, "agent");
            asm volatile("s_waitcnt vmcnt(0)" ::: "memory");
            const unsigned og = xb_add(&bar[XB_TOP], 1u);
            const unsigned tg = og / nx;
            if (og + 1u == (tg + 1u) * nx) xb_add(&bar[XB_TOPGEN], 1u);
            else XB_SPIN(xb_ld(&bar[XB_TOPGEN]) == tg, bar);
            __builtin_amdgcn_fence(__ATOMIC_ACQUIRE, "agent");
            xb_add(&bar[XB_XGEN(b.x)], 1u);
            asm volatile("s_waitcnt vmcnt(0)" ::: "memory");
        } else {
            XB_SPIN(xb_ld(&bar[XB_XGEN(b.x)]) == gen, bar);
            __builtin_amdgcn_fence(__ATOMIC_ACQUIRE, "agent");
            asm volatile("s_waitcnt vmcnt(0)" ::: "memory");
        }
    }
    __syncthreads();
}

namespace pg8 {
constexpr int BM = 256, BK = 64, HALF = 128, HTB = HALF * BK * 2, STAGE_BYTES = 8 * HTB, NXCD = 8, WGM = 8;
__device__ __forceinline__ int lds_byte(int r, int c) { const int st = (r >> 4) * 2 + (c >> 5), rr = r & 15, cc = c & 31, ob = rr * 64 + cc * 2; return st * 1024 + (ob ^ (((ob >> 9) & 1) << 5)); }
__device__ __forceinline__ void stage_rc(int b, int& R, int& C) { const int st = b / 1024, sb = b % 1024, swz = sb ^ (((sb >> 9) & 1) << 5); R = (st >> 1) * 16 + swz / 64; C = (st & 1) * 32 + (swz % 64) / 2; }
__device__ __forceinline__ int perm32(int rho) { const int n = rho >> 4, i = rho & 15; return 8 * (i >> 2) + 4 * n + (i & 3); }

struct Unit { int pm, pn, e, ml, cntv, ui; const char* A; const char* B; };

struct DenseOrder {
    int nM, nN, nwg, G, c, pitch, skip32; const char* A; const char* Bt;
    __device__ void init(const void* A_, const void* Bt_, int nM_, int nN_, int pitch_, int G_, int c_, int skip32_) { A = (const char*)A_; Bt = (const char*)Bt_; nM = nM_; nN = nN_; pitch = pitch_; nwg = nM * nN; G = G_; c = c_; skip32 = skip32_; }
    __device__ __forceinline__ bool next(int i, Unit& u) const {
        const long L = (long)i * G + c; if (L >= nwg) return false;
        int wgid = (int)L; { const int q = nwg / NXCD, r = nwg % NXCD, xcd = wgid % NXCD, off = wgid / NXCD; wgid = (xcd < r ? xcd * (q + 1) : r * (q + 1) + (xcd - r) * q) + off; }
        const int nig = WGM * nN, gid = wgid / nig, fm = gid * WGM, gsz = (nM - fm) < WGM ? (nM - fm) : WGM;
        int pm = fm + ((wgid % nig) % gsz); u.pn = (wgid % nig) / gsz; if (skip32) pm += pm >> 5; u.pm = pm; u.e = 0; u.ml = 0; u.cntv = 0; u.ui = 0;
        u.A = A + (size_t)pm * 256 * pitch; u.B = Bt + (size_t)u.pn * 256 * pitch; return true;
    }
    __device__ __forceinline__ unsigned grow(const Unit&, int) const { return 0u; }
};
struct MoeOrder {
    const LAS int* ud; const LAS int* rows; int pitch; const char* A; const char* Bt; size_t bstride; int gather;
    __device__ __forceinline__ bool next(int i, Unit& u) const {
        if (i >= 8) return false;
        const int e = __builtin_amdgcn_readfirstlane(ud[i * 8 + 0]); if (e < 0) return false;
        u.e = e; u.pn = __builtin_amdgcn_readfirstlane(ud[i * 8 + 1]); u.ml = __builtin_amdgcn_readfirstlane(ud[i * 8 + 2]); u.pm = __builtin_amdgcn_readfirstlane(ud[i * 8 + 3]); u.cntv = __builtin_amdgcn_readfirstlane(ud[i * 8 + 4]); u.ui = i;
        u.A = gather ? A : A + (size_t)u.pm * 256 * pitch; u.B = Bt + (size_t)e * bstride + (size_t)u.pn * 256 * pitch; return true;
    }
    __device__ __forceinline__ unsigned grow(const Unit& u, int r) const { const int d = rows[u.ui * 256 + r]; return d >= 0 ? (unsigned)(d >> 1) : 0u; }
};

typedef int i32x8 __attribute__((ext_vector_type(8)));
typedef int i32x4_ __attribute__((ext_vector_type(4)));
template <class Epi, class Sched, bool GATHER, bool FP8>
__device__ __forceinline__ void gemm_phase(LAS unsigned char* lds, const int pitch, const Sched& S, const Epi& E) {
    int tz = threadIdx.x; asm volatile("" : "+v"(tz));
    const int tid = tz, wid = __builtin_amdgcn_readfirstlane(tid >> 6), lane = tid & 63, wr = wid >> 2, wc = wid & 3, fr = lane & 15, fq = lane >> 4;
    const int nt = pitch / 128;
    unsigned voffA[2], voffB[2];
#pragma unroll
    for (int i = 0; i < 2; ++i) { int R, C; stage_rc(tid * 16 + i * 8192, R, C); const int Rb = Epi::PERM ? ((R & ~31) + perm32(R & 31)) : R;
        voffA[i] = (unsigned)(R * pitch + C * 2); voffB[i] = (unsigned)(Rb * pitch + C * 2); }
    const size_t kstep = (size_t)(BK * 2);
    const size_t hstep = (size_t)HALF * pitch;
    const unsigned ldsw = (unsigned)wid * 1024u;
    const int aoff = lds_byte(wr * 64 + fr, fq * 8), boff = lds_byte(wc * 32 + fr, fq * 8);
#define PG8_SA(b, h) (((b) * 2 + (h)) * HTB)
#define PG8_SB(b, h) ((4 + (b) * 2 + (h)) * HTB)
#define PG8_STAGE(bufoff, gbase, voff) do { _Pragma("unroll") for (int _i = 0; _i < 2; ++_i) \
        __builtin_amdgcn_global_load_lds((const unsigned*)((const char*)(gbase) + (voff)[_i]), (LAS unsigned*)(lds + (bufoff) + ldsw + _i * 8192), 16, 0, 0); } while (0)
#define PG8_STAGE_A(bufoff, gbase, h, nx) do { if (GATHER) { unsigned _v[2]; _v[0] = (nx) ? nG[h][0] : gA[h][0]; _v[1] = (nx) ? nG[h][1] : gA[h][1]; PG8_STAGE(bufoff, gbase, _v); } \
        else PG8_STAGE(bufoff, (gbase) + (h) * hstep, voffA); } while (0)
#define PG8_RD(off) (*(const LAS i32x4_*)(lds + (off)))
#define PG8_LDA(dst, b, h) do { _Pragma("unroll") for (int m = 0; m < 4; ++m) dst[m] = __builtin_shufflevector(PG8_RD(PG8_SA(b, h) + aoff + m * 2048), PG8_RD(PG8_SA(b, h) + aoff + m * 2048 + 1024), 0, 1, 2, 3, 4, 5, 6, 7); } while (0)
#define PG8_LDB(dst, b, h) do { _Pragma("unroll") for (int n = 0; n < 2; ++n) dst[n] = __builtin_shufflevector(PG8_RD(PG8_SB(b, h) + boff + n * 2048), PG8_RD(PG8_SB(b, h) + boff + n * 2048 + 1024), 0, 1, 2, 3, 4, 5, 6, 7); } while (0)
#define PG8_LO(x) __builtin_bit_cast(bf16x8, __builtin_shufflevector(x, x, 0, 1, 2, 3))
#define PG8_HI(x) __builtin_bit_cast(bf16x8, __builtin_shufflevector(x, x, 4, 5, 6, 7))
#define PG8_MMA(ai, bj, At, Bt) do { __builtin_amdgcn_s_setprio(1); \
        if (FP8) { _Pragma("unroll") for (int m = 0; m < 4; ++m) _Pragma("unroll") for (int n = 0; n < 2; ++n) \
            asm volatile("v_mfma_scale_f32_16x16x128_f8f6f4 %0, %1, %2, %0, %3, %3 op_sel_hi:[0,0,0]" : "+v"(acc[ai][bj][m][n]) : "v"(Bt[n]), "v"(At[m]), "v"(sc1)); } \
        else { _Pragma("unroll") for (int m = 0; m < 4; ++m) _Pragma("unroll") for (int n = 0; n < 2; ++n) { \
            acc[ai][bj][m][n] = __builtin_amdgcn_mfma_f32_16x16x32_bf16(PG8_LO(Bt[n]), PG8_LO(At[m]), acc[ai][bj][m][n], 0, 0, 0); \
            acc[ai][bj][m][n] = __builtin_amdgcn_mfma_f32_16x16x32_bf16(PG8_HI(Bt[n]), PG8_HI(At[m]), acc[ai][bj][m][n], 0, 0, 0); } } \
        __builtin_amdgcn_s_setprio(0); } while (0)
#define PG8_WAIT_V(n) asm volatile("s_waitcnt vmcnt(" #n ")" ::: "memory")
#define PG8_WAIT_L(n) asm volatile("s_waitcnt lgkmcnt(" #n ")" ::: "memory")
#define PG8_BAR __builtin_amdgcn_s_barrier()
#define PG8_SCHED __builtin_amdgcn_sched_barrier(0)
    Unit cur, nxt; int ui = 0;
    if (!S.next(0, cur)) return;
    unsigned gA[2][2] = {{0u, 0u}, {0u, 0u}}, nG[2][2] = {{0u, 0u}, {0u, 0u}};
    if (GATHER) {
#pragma unroll
        for (int h = 0; h < 2; ++h)
#pragma unroll
            for (int i = 0; i < 2; ++i) { int R, C; stage_rc(tid * 16 + i * 8192, R, C); gA[h][i] = S.grow(cur, h * HALF + R) * (unsigned)pitch + (unsigned)C * 2u; }
    }
    f32x4 acc[2][2][4][2];
#pragma unroll
    for (int a = 0; a < 2; ++a)
#pragma unroll
        for (int b = 0; b < 2; ++b)
#pragma unroll
            for (int m = 0; m < 4; ++m)
#pragma unroll
                for (int n = 0; n < 2; ++n) acc[a][b][m][n] = (f32x4){0.f, 0.f, 0.f, 0.f};
    i32x8 At[4], B0[2], B1[2];
    int sc1 = 0x7F7F7F7F; asm volatile("" : "+v"(sc1));
    const char* cA = cur.A; const char* cB = cur.B;
    PG8_STAGE(PG8_SB(0, 0), cB, voffB); PG8_STAGE_A(PG8_SA(0, 0), cA, 0, false); PG8_STAGE(PG8_SB(0, 1), cB + hstep, voffB); PG8_STAGE_A(PG8_SA(0, 1), cA, 1, false);
    if (wr == 1) PG8_BAR;
    PG8_WAIT_V(4); PG8_BAR;
    PG8_STAGE(PG8_SB(1, 0), cB + kstep, voffB); PG8_STAGE_A(PG8_SA(1, 0), cA + kstep, 0, false); PG8_STAGE(PG8_SB(1, 1), cB + hstep + kstep, voffB);
    PG8_WAIT_V(6); PG8_BAR;
    for (;;) {
        const bool has_next = S.next(ui + 1, nxt);
        const char* nA = has_next ? nxt.A : cA; const char* nB = has_next ? nxt.B : cB;
        if (GATHER) {
#pragma unroll
            for (int h = 0; h < 2; ++h)
#pragma unroll
                for (int i = 0; i < 2; ++i) { int tg = threadIdx.x; asm volatile("" : "+v"(tg)); int R, C; stage_rc(tg * 16 + i * 8192, R, C); nG[h][i] = has_next ? S.grow(nxt, h * HALF + R) * (unsigned)pitch + (unsigned)C * 2u : gA[h][i]; }
        }
#pragma unroll 1
        for (int t = 0; t < nt; t += 2) {
            const bool last = (t == nt - 2);
            const char* a1 = cA + (size_t)(t + 1) * kstep;
            const char* a2 = last ? nA : cA + (size_t)(t + 2) * kstep; const char* b2 = last ? nB : cB + (size_t)(t + 2) * kstep;
            const char* a3 = a2 + kstep; const char* b3 = b2 + kstep;
            PG8_LDB(B0, 0, 0); PG8_SCHED; PG8_LDA(At, 0, 0); PG8_STAGE_A(PG8_SA(1, 1), a1, 1, false);
            PG8_WAIT_L(8); PG8_BAR; PG8_WAIT_L(0); PG8_MMA(0, 0, At, B0); PG8_BAR; PG8_SCHED;
            PG8_LDB(B1, 0, 1); PG8_STAGE(PG8_SB(0, 0), b2, voffB);
            PG8_BAR; PG8_WAIT_L(0); PG8_MMA(0, 1, At, B1); PG8_BAR;
            PG8_LDA(At, 0, 1); PG8_STAGE_A(PG8_SA(0, 0), a2, 0, last);
            PG8_BAR; PG8_WAIT_L(0); PG8_MMA(1, 0, At, B0); PG8_BAR; PG8_SCHED;
            PG8_STAGE(PG8_SB(0, 1), b2 + hstep, voffB);
            PG8_WAIT_V(6); PG8_BAR; PG8_MMA(1, 1, At, B1); PG8_BAR;
            PG8_LDB(B0, 1, 0); PG8_SCHED; PG8_LDA(At, 1, 0); PG8_STAGE_A(PG8_SA(0, 1), a2, 1, last);
            PG8_WAIT_L(8); PG8_BAR; PG8_WAIT_L(0); PG8_MMA(0, 0, At, B0); PG8_BAR; PG8_SCHED;
            PG8_LDB(B1, 1, 1); PG8_STAGE(PG8_SB(1, 0), b3, voffB);
            PG8_BAR; PG8_WAIT_L(0); PG8_MMA(0, 1, At, B1); PG8_BAR;
            PG8_LDA(At, 1, 1); PG8_STAGE_A(PG8_SA(1, 0), a3, 0, last);
            PG8_BAR; PG8_WAIT_L(0); PG8_MMA(1, 0, At, B0); PG8_BAR; PG8_SCHED;
            PG8_STAGE(PG8_SB(1, 1), b3 + hstep, voffB);
            PG8_WAIT_V(6); PG8_BAR; PG8_MMA(1, 1, At, B1); PG8_BAR;
        }
        if (FP8) asm volatile("s_nop 15\n\ts_nop 15\n\ts_nop 15" ::: "memory");
        { int te = threadIdx.x; asm volatile("" : "+v"(te)); const int le = te & 63; E(acc, cur, wr, wc, le & 15, le >> 4); }
        if (!has_next) break;
#pragma unroll
        for (int a = 0; a < 2; ++a)
#pragma unroll
            for (int b = 0; b < 2; ++b)
#pragma unroll
                for (int m = 0; m < 4; ++m)
#pragma unroll
                    for (int n = 0; n < 2; ++n) acc[a][b][m][n] = (f32x4){0.f, 0.f, 0.f, 0.f};
        cur = nxt; cA = nA; cB = nB; ++ui;
        if (GATHER) {
#pragma unroll
            for (int h = 0; h < 2; ++h)
#pragma unroll
                for (int i = 0; i < 2; ++i) gA[h][i] = nG[h][i];
        }
    }
    PG8_WAIT_V(0);
    if (wr == 0) PG8_BAR;
    PG8_BAR;
#undef PG8_SA
#undef PG8_SB
#undef PG8_STAGE
#undef PG8_STAGE_A
#undef PG8_LDA
#undef PG8_LDB
#undef PG8_MMA
#undef PG8_RD
#undef PG8_LO
#undef PG8_HI
#undef PG8_WAIT_V
#undef PG8_WAIT_L
#undef PG8_BAR
#undef PG8_SCHED
}

struct EpiP {
    static constexpr bool PERM = true;
    bf16_t* O;
    __device__ __forceinline__ void operator()(const f32x4 (&acc)[2][2][4][2], const Unit& u, int wr, int wc, int fr, int fq) const {
        const int row0 = u.pm * BM + wr * 64 + fr, col0 = u.pn * BM + wc * 32 + 8 * fq;
#pragma unroll
        for (int ai = 0; ai < 2; ++ai)
#pragma unroll
            for (int m = 0; m < 4; ++m) { bf16_t* rowp = O + (size_t)(row0 + ai * HALF + m * 16) * INW + col0;
#pragma unroll
                for (int bj = 0; bj < 2; ++bj) { const f32x4 v0 = acc[ai][bj][m][0], v1 = acc[ai][bj][m][1];
                    u32x4 w; w.x = cvt_pk_bf16(v0[0], v0[1]); w.y = cvt_pk_bf16(v0[2], v0[3]); w.z = cvt_pk_bf16(v1[0], v1[1]); w.w = cvt_pk_bf16(v1[2], v1[3]);
                    *(u32x4*)(rowp + bj * HALF) = w; } }
    }
};
struct EpiResid {
    static constexpr bool PERM = true;
    bf16_t* X; const float* mod; float scale;
    __device__ __forceinline__ void operator()(const f32x4 (&acc)[2][2][4][2], const Unit& u, int wr, int wc, int fr, int fq) const {
        const int row0 = u.pm * BM + wr * 64 + fr, col0 = u.pn * BM + wc * 32 + 8 * fq;
        const int sel = (u.pm % 33 == 32) ? 2 : u.pm / 33;
        const float* gv = mod + sel * 12288 + 4096;
        f32x4 g[2][2];
#pragma unroll
        for (int bj = 0; bj < 2; ++bj)
#pragma unroll
            for (int n = 0; n < 2; ++n) g[bj][n] = *(const f32x4*)(gv + col0 + bj * HALF + n * 4) * scale;
#pragma unroll
        for (int ai = 0; ai < 2; ++ai)
#pragma unroll
            for (int m = 0; m < 4; ++m) { bf16_t* rowp = X + (size_t)(row0 + ai * HALF + m * 16) * DM + col0;
#pragma unroll
                for (int bj = 0; bj < 2; ++bj) { u32x4* q = (u32x4*)(rowp + bj * HALF); const u32x4 xw = *q;
                    const f32x4 v0 = (f32x4){bflo(xw.x), bfhi(xw.x), bflo(xw.y), bfhi(xw.y)} + g[bj][0] * acc[ai][bj][m][0], v1 = (f32x4){bflo(xw.z), bfhi(xw.z), bflo(xw.w), bfhi(xw.w)} + g[bj][1] * acc[ai][bj][m][1];
                    u32x4 w; w.x = cvt_pk_bf16(v0[0], v0[1]); w.y = cvt_pk_bf16(v0[2], v0[3]); w.z = cvt_pk_bf16(v1[0], v1[1]); w.w = cvt_pk_bf16(v1[2], v1[3]); *q = w; } }
    }
};
struct EpiSwiglu {
    static constexpr bool PERM = true;
    unsigned char* ACT;
    __device__ __forceinline__ void operator()(const f32x4 (&acc)[2][2][4][2], const Unit& u, int wr, int wc, int fr, int fq) const {
        const int row0 = u.pm * BM + wr * 64 + fr, col0 = u.pn * HALF + wc * 32 + 8 * fq;
#pragma unroll
        for (int ai = 0; ai < 2; ++ai)
#pragma unroll
            for (int m = 0; m < 4; ++m) { unsigned char* rowp = ACT + (size_t)(row0 + ai * HALF + m * 16) * HID + col0;
                float o[8];
#pragma unroll
                for (int n = 0; n < 2; ++n)
#pragma unroll
                    for (int j = 0; j < 4; ++j) { const float g = acc[ai][0][m][n][j] * 0.00390625f, up = acc[ai][1][m][n][j] * 0.00390625f; o[n * 4 + j] = g * sigmoidf_(g) * up; }
                u32x2 w; w.x = cvt_pk_fp8x4_sat(o[0], o[1], o[2], o[3]); w.y = cvt_pk_fp8x4_sat(o[4], o[5], o[6], o[7]);
                *(u32x2*)rowp = w; }
    }
};
struct EpiScatter {
    static constexpr bool PERM = true;
    unsigned char* Y; const LAS int* rows; const LAS float* wts;
    __device__ __forceinline__ void operator()(const f32x4 (&acc)[2][2][4][2], const Unit& u, int wr, int wc, int fr, int fq) const {
        const int r0 = wr * 64 + fr, col0 = u.pn * BM + wc * 32 + 8 * fq;
#pragma unroll
        for (int ai = 0; ai < 2; ++ai)
#pragma unroll
            for (int m = 0; m < 4; ++m) { const int r = r0 + ai * HALF + m * 16; const int dest = rows[u.ui * 256 + r];
                if (dest >= 0) { const float w_ = wts[u.ui * 256 + r] * 0.0625f; unsigned char* rowp = Y + (size_t)dest * DM + col0;
#pragma unroll
                    for (int bj = 0; bj < 2; ++bj) { const f32x4 v0 = acc[ai][bj][m][0] * w_, v1 = acc[ai][bj][m][1] * w_;
                        u32x2 w; w.x = cvt_pk_fp8x4_sat(v0[0], v0[1], v0[2], v0[3]); w.y = cvt_pk_fp8x4_sat(v1[0], v1[1], v1[2], v1[3]);
                        *(u32x2*)(rowp + bj * HALF) = w; } } }
    }
};
}

namespace att {
constexpr int D = 128, NW = 8, QBLK = 32, KVBLK = 64;
constexpr float SCALE = 0.088388347648318440f;
constexpr float THR = 8.f;
constexpr int LDP = INW;
constexpr int LDO = DM;
constexpr size_t SHM_V = KVBLK * D * 2, SHM_K = KVBLK * D * 2, SHM_ATTN = 2 * SHM_V + 2 * SHM_K + NW * 64 * 4;
constexpr int RPB_OFF = (int)SHM_ATTN;
#define KSWZ(row, colB) ((row) * 256 + ((colB) ^ (((row) & 7) << 4)))
#define SBAR() __builtin_amdgcn_sched_barrier(0)
__device__ __forceinline__ int crow(int r, int hi) { return (r & 3) + 8 * (r >> 2) + 4 * hi; }

__device__ __forceinline__ void partialSM(f32x16& p0, f32x16& p1, float& m_reg, float& mn, float& alpha) {
  constexpr float C = SCALE * 1.4426950408889634f;
  float pmax = p0[0]; for (int r = 1; r < 16; ++r) pmax = fmaxf(pmax, p0[r]); for (int r = 0; r < 16; ++r) pmax = fmaxf(pmax, p1[r]);
  { auto rr = __builtin_amdgcn_permlane32_swap(__float_as_uint(pmax), __float_as_uint(pmax), false, false);
    pmax = fmaxf(__uint_as_float(rr[0]), __uint_as_float(rr[1])); }
  if (__builtin_expect(__all(pmax - m_reg <= THR / SCALE), 1)) { mn = m_reg; alpha = 1.f; }
  else { mn = fmaxf(m_reg, pmax); alpha = __builtin_amdgcn_exp2f((m_reg - mn) * C); m_reg = mn; }
  float mnC = -mn * C;
  for (int r = 0; r < 16; ++r) p0[r] = fmaf(p0[r], C, mnC); for (int r = 0; r < 16; ++r) p1[r] = fmaf(p1[r], C, mnC);
  for (int r = 0; r < 16; ++r) p0[r] = __builtin_amdgcn_exp2f(p0[r]);
}
__device__ __forceinline__ void finishSM(f32x16& p0, f32x16& p1, float alpha, float& l_reg, bf16x8& pa0, bf16x8& pa1, bf16x8& pa2, bf16x8& pa3) {
  for (int r = 0; r < 16; ++r) p1[r] = __builtin_amdgcn_exp2f(p1[r]);
  float ps = 0; for (int r = 0; r < 16; ++r) ps += p0[r]; for (int r = 0; r < 16; ++r) ps += p1[r];
  { auto rr = __builtin_amdgcn_permlane32_swap(__float_as_uint(ps), __float_as_uint(ps), false, false);
    ps = __uint_as_float(rr[0]) + __uint_as_float(rr[1]); }
  l_reg = l_reg * alpha + ps;
#define PK4(P, BASE, OUT) do { unsigned a0 = cvt_pk_bf16(P[BASE + 0], P[BASE + 1]), a1 = cvt_pk_bf16(P[BASE + 2], P[BASE + 3]);   \
    unsigned b0 = cvt_pk_bf16(P[BASE + 4], P[BASE + 5]), b1 = cvt_pk_bf16(P[BASE + 6], P[BASE + 7]);                              \
    auto r0 = __builtin_amdgcn_permlane32_swap(a0, b0, false, false); auto r1 = __builtin_amdgcn_permlane32_swap(a1, b1, false, false); \
    u32x4 w = {r0[0], r1[0], r0[1], r1[1]}; OUT = *reinterpret_cast<bf16x8*>(&w); } while (0)
  PK4(p0, 0, pa0); PK4(p0, 8, pa1); PK4(p1, 0, pa2); PK4(p1, 8, pa3);
#undef PK4
}
__device__ __forceinline__ void qkt(f32x16& p0, f32x16& p1, const bf16_t* Ks, const bf16x8* qr, int r32, int hi) {
  p0 = f32x16{}; p1 = f32x16{};
  for (int d0 = 0; d0 < 8; ++d0) { int cb = (d0 * 16 + hi * 8) * 2;
    bf16x8 b0 = *reinterpret_cast<const bf16x8*>((const char*)Ks + KSWZ(r32, cb));
    bf16x8 b1 = *reinterpret_cast<const bf16x8*>((const char*)Ks + KSWZ(32 + r32, cb));
    p0 = __builtin_amdgcn_mfma_f32_32x32x16_bf16(b0, qr[d0], p0, 0, 0, 0);
    p1 = __builtin_amdgcn_mfma_f32_32x32x16_bf16(b1, qr[d0], p1, 0, 0, 0); }
}
__device__ __forceinline__ int v_st(int k, int c) { const int kk = (k & ~0xC) | ((k & 4) << 1) | ((k & 8) >> 1); return ((kk >> 3) * 4 + (c >> 5)) * 512 + ((kk & 7) * 32 + (c & 31)) * 2; }
__device__ __forceinline__ int v_rd_base(int lane) { return ((lane & 3) << 3) | (((lane >> 2) & 3) << 6) | (((lane >> 4) & 1) << 5) | (((lane >> 5) & 1) << 8); }
constexpr int v_rd_off(int d0, int ks, int half) { return d0 * 512 + ks * 4096 + half * 2048; }
template <int OFF> __device__ __forceinline__ s16x4 tr_read(int vb) {
  s16x4 r; asm volatile("ds_read_b64_tr_b16 %0, %1 offset:%2" : "=&v"(r) : "v"(vb), "i"(OFF) : "memory"); return r;
}
template <int D0> __device__ __forceinline__ void pv_one(f32x16& od, int vb, bf16x8 pa0, bf16x8 pa1, bf16x8 pa2, bf16x8 pa3) {
  const s16x4 l0 = tr_read<v_rd_off(D0, 0, 0)>(vb), h0 = tr_read<v_rd_off(D0, 0, 1)>(vb), l1 = tr_read<v_rd_off(D0, 1, 0)>(vb), h1 = tr_read<v_rd_off(D0, 1, 1)>(vb);
  const s16x4 l2 = tr_read<v_rd_off(D0, 2, 0)>(vb), h2 = tr_read<v_rd_off(D0, 2, 1)>(vb), l3 = tr_read<v_rd_off(D0, 3, 0)>(vb), h3 = tr_read<v_rd_off(D0, 3, 1)>(vb);
  asm volatile("s_waitcnt lgkmcnt(0)" ::: "memory"); SBAR();
#define PK(L, H) (bf16x8){L[0], L[1], L[2], L[3], H[0], H[1], H[2], H[3]}
  od = __builtin_amdgcn_mfma_f32_32x32x16_bf16(pa0, PK(l0, h0), od, 0, 0, 0);
  od = __builtin_amdgcn_mfma_f32_32x32x16_bf16(pa1, PK(l1, h1), od, 0, 0, 0);
  od = __builtin_amdgcn_mfma_f32_32x32x16_bf16(pa2, PK(l2, h2), od, 0, 0, 0);
  od = __builtin_amdgcn_mfma_f32_32x32x16_bf16(pa3, PK(l3, h3), od, 0, 0, 0);
#undef PK
}
__device__ __forceinline__ void pv_d0(f32x16* o, int vb, bf16x8 pa0, bf16x8 pa1, bf16x8 pa2, bf16x8 pa3) {
  pv_one<0>(o[0], vb, pa0, pa1, pa2, pa3); pv_one<1>(o[1], vb, pa0, pa1, pa2, pa3); pv_one<2>(o[2], vb, pa0, pa1, pa2, pa3); pv_one<3>(o[3], vb, pa0, pa1, pa2, pa3);
}

struct Job { const bf16_t* Q; const bf16_t* K; const bf16_t* V; bf16_t* O; int nt, mode, row_a, row_b, gr0, kstart; };
__device__ __forceinline__ int ufy(int v) { v = __builtin_amdgcn_readfirstlane(v); asm volatile("" : "+s"(v)); return v; }
template <class T> __device__ __forceinline__ T* ufyp(T* q) { unsigned long long a = (unsigned long long)q; unsigned lo = __builtin_amdgcn_readfirstlane((unsigned)a), hi = __builtin_amdgcn_readfirstlane((unsigned)(a >> 32)); asm volatile("" : "+s"(lo), "+s"(hi)); return (T*)(((unsigned long long)hi << 32) | lo); }
__device__ __forceinline__ void opaque(Job& J) { J.Q = ufyp(J.Q); J.K = ufyp(J.K); J.V = ufyp(J.V); J.O = ufyp(J.O); J.nt = ufy(J.nt); J.row_a = ufy(J.row_a); J.row_b = ufy(J.row_b); J.gr0 = ufy(J.gr0); J.kstart = ufy(J.kstart); }

template <int MODE> __device__ __forceinline__ void na_mask(f32x16& p0, f32x16& p1, const Job& J, int t, int wid, int r32, int hi, const float* rpb) {
  if (MODE == 1 && t >= 4) {
    const int r = J.gr0 + (wid >> 1), j = ((wid & 1) << 5) + r32, kr = J.kstart + t - 4;
    const int rs = min(max(r - 4, 0), 120), cs = min(max(j - 8, 0), 48);
    const bool rowok = (kr >= rs) && (kr < rs + 8);
    const int base = (kr - r + 7) * 31 - j + 15;
#pragma unroll
    for (int q = 0; q < 16; ++q) {
      const int c0 = crow(q, hi), c1 = c0 + 32;
      const bool in0 = rowok && ((unsigned)(c0 - cs) < 16u), in1 = rowok && ((unsigned)(c1 - cs) < 16u);
      const float b0 = rpb[in0 ? base + c0 : 0], b1 = rpb[in1 ? base + c1 : 0];
      p0[q] = in0 ? p0[q] + b0 : -1e30f; p1[q] = in1 ? p1[q] + b1 : -1e30f;
    }
  }
}

template <int MODE> __device__ __forceinline__ void attn_unit(const Job& J, char* lds) {
  int tz = threadIdx.x; asm volatile("" : "+v"(tz));
  const int tid = tz, wid = tid >> 6, lane = tid & 63, r32 = lane & 31, hi = lane >> 5;
  bf16_t* V_lds = (bf16_t*)lds; bf16_t* K_lds = (bf16_t*)(lds + 2 * SHM_V);
  float* ws = (float*)(lds + 2 * SHM_V + 2 * SHM_K) + wid * 64; float* li_l = ws; float* al_l = ws + 32;
  const float* rpb = (const float*)(lds + RPB_OFF);
  float m_reg = -1e30f, l_reg = 0; f32x16 o[4] = {}; bf16x8 qr[8];
  const bf16_t* Qw = J.Q + (long)(wid * QBLK + r32) * LDP + hi * 8;
#pragma unroll
  for (int d0 = 0; d0 < 8; ++d0) qr[d0] = *reinterpret_cast<const bf16x8*>(Qw + d0 * 16);
  const int sr = tid >> 4, sc = (tid & 15) * 8, vst0 = v_st(sr, sc), vst1 = v_st(32 + sr, sc);
  const int vb0 = (int)(uintptr_t)V_lds + v_rd_base(lane);
  struct { bf16x8 vs0, vs1, ks0, ks1; } sr_[2];
#define TROW(t) ((MODE == 1 && (t) >= 4) ? (J.row_b + 64 * ((t) - 4)) : (J.row_a + 64 * (t)))
#define SLOAD(i, t) do { const long _r0 = (long)(TROW(t) + sr) * LDP + sc; sr_[i].vs0 = *reinterpret_cast<const bf16x8*>(J.V + _r0); sr_[i].vs1 = *reinterpret_cast<const bf16x8*>(J.V + _r0 + 32L * LDP); \
    sr_[i].ks0 = *reinterpret_cast<const bf16x8*>(J.K + _r0); sr_[i].ks1 = *reinterpret_cast<const bf16x8*>(J.K + _r0 + 32L * LDP); } while (0)
#define SWRITE(b, i) do { *(bf16x8*)((char*)V_lds + (b) * SHM_V + vst0) = sr_[i].vs0;          \
    *(bf16x8*)((char*)V_lds + (b) * SHM_V + vst1) = sr_[i].vs1; int kc = sc * 2;               \
    *(bf16x8*)((char*)K_lds + (b) * SHM_K + KSWZ(sr, kc)) = sr_[i].ks0;                       \
    *(bf16x8*)((char*)K_lds + (b) * SHM_K + KSWZ(32 + sr, kc)) = sr_[i].ks1; } while (0)
#define SWAIT() asm volatile("s_waitcnt vmcnt(4)" ::: "memory")
#define RESC(a) do { if (__any((a) < 1.f)) { if (hi == 0) al_l[r32] = (a); asm volatile("s_waitcnt lgkmcnt(0)" ::: "memory"); \
    for (int d = 0; d < 4; ++d) for (int r = 0; r < 16; ++r) o[d][r] *= al_l[crow(r, hi)]; } } while (0)
  f32x16 pA0, pA1, pB0, pB1; float mnA, mnB, alA, alB; bf16x8 pa0, pa1, pa2, pa3; int NT = J.nt; asm volatile("" : "+s"(NT));
  constexpr int SE = 0, SO = 1;
  SLOAD(SE, 0); asm volatile("s_waitcnt vmcnt(0)" ::: "memory"); SWRITE(0, SE); __syncthreads();
  qkt(pA0, pA1, K_lds, qr, r32, hi); na_mask<MODE>(pA0, pA1, J, 0, wid, r32, hi, rpb); partialSM(pA0, pA1, m_reg, mnA, alA);
  SLOAD(SO, 1); if (2 < NT) SLOAD(SE, 2);
  SWAIT(); SWRITE(1, SO); __syncthreads();
#pragma unroll 1
  for (int j = 1; j + 1 < NT; j += 2) {
    SBAR(); qkt(pB0, pB1, (bf16_t*)((char*)K_lds + SHM_K), qr, r32, hi);
    finishSM(pA0, pA1, alA, l_reg, pa0, pa1, pa2, pa3); SBAR();
    SLOAD(SO, min(j + 2, NT - 1)); SBAR();
    pv_d0(o, vb0, pa0, pa1, pa2, pa3); na_mask<MODE>(pB0, pB1, J, j, wid, r32, hi, rpb); partialSM(pB0, pB1, m_reg, mnB, alB);
    __syncthreads(); SWAIT(); SWRITE(0, SE);
    RESC(alB); __syncthreads();
    SBAR(); qkt(pA0, pA1, K_lds, qr, r32, hi);
    finishSM(pB0, pB1, alB, l_reg, pa0, pa1, pa2, pa3); SBAR();
    if (j + 3 < NT) SLOAD(SE, j + 3); SBAR();
    pv_d0(o, vb0 + (int)SHM_V, pa0, pa1, pa2, pa3); na_mask<MODE>(pA0, pA1, J, j + 1, wid, r32, hi, rpb); partialSM(pA0, pA1, m_reg, mnA, alA);
    __syncthreads(); SWAIT(); SWRITE(1, SO);
    RESC(alA); __syncthreads();
  }
  SBAR(); qkt(pB0, pB1, (bf16_t*)((char*)K_lds + SHM_K), qr, r32, hi);
  finishSM(pA0, pA1, alA, l_reg, pa0, pa1, pa2, pa3); SBAR();
  pv_d0(o, vb0, pa0, pa1, pa2, pa3); na_mask<MODE>(pB0, pB1, J, NT - 1, wid, r32, hi, rpb); partialSM(pB0, pB1, m_reg, mnB, alB);
  __syncthreads(); RESC(alB);
  finishSM(pB0, pB1, alB, l_reg, pa0, pa1, pa2, pa3); SBAR();
  pv_d0(o, vb0 + (int)SHM_V, pa0, pa1, pa2, pa3);
  if (hi == 0) li_l[r32] = l_reg; asm volatile("s_waitcnt lgkmcnt(0)" ::: "memory");
  float rli[16];
#pragma unroll
  for (int r = 0; r < 16; ++r) rli[r] = __builtin_amdgcn_rcpf(li_l[crow(r, hi)]);
  bf16_t* Ow = J.O + (long)(wid * QBLK) * LDO;
#pragma unroll
  for (int r = 0; r < 16; ++r) { int orow = crow(r, hi);
    for (int d0 = 0; d0 < 4; ++d0) Ow[(long)orow * LDO + d0 * 32 + r32] = (bf16_t)(cvt_pk_bf16(o[d0][r] * rli[r], 0.f) & 0xffffu); }
  asm volatile("s_waitcnt vmcnt(0)" ::: "memory");
  __syncthreads();
#undef TROW
#undef SLOAD
#undef SWRITE
#undef SWAIT
#undef RESC
}

__device__ __forceinline__ void attn_unit_na(const Job& J, char* lds) {
  int tz = threadIdx.x; asm volatile("" : "+v"(tz));
  const int tid = tz, wid = tid >> 6, lane = tid & 63, r32 = lane & 31, hi = lane >> 5;
  bf16_t* V_lds = (bf16_t*)lds; bf16_t* K_lds = (bf16_t*)(lds + 2 * SHM_V);
  float* ws = (float*)(lds + 2 * SHM_V + 2 * SHM_K) + wid * 64; float* li_l = ws; float* al_l = ws + 32;
  const float* rpb = (const float*)(lds + RPB_OFF);
  float m_reg = -1e30f, l_reg = 0; f32x16 o[4] = {}; bf16x8 qr[8];
  const bf16_t* Qw = J.Q + (long)(wid * QBLK + r32) * LDP + hi * 8;
#pragma unroll
  for (int d0 = 0; d0 < 8; ++d0) qr[d0] = *reinterpret_cast<const bf16x8*>(Qw + d0 * 16);
  const int sr = tid >> 4, sc = (tid & 15) * 8, vst0 = v_st(sr, sc), vst1 = v_st(32 + sr, sc);
  const int vb0 = (int)(uintptr_t)V_lds + v_rd_base(lane);
  bf16x8 vs0, vs1, ks0, ks1;
#define TROW(t) (((t) >= 4) ? (J.row_b + 64 * ((t) - 4)) : (J.row_a + 64 * (t)))
#define SLOAD(t) do { const long _r0 = (long)(TROW(t) + sr) * LDP + sc; vs0 = *reinterpret_cast<const bf16x8*>(J.V + _r0); vs1 = *reinterpret_cast<const bf16x8*>(J.V + _r0 + 32L * LDP); \
    ks0 = *reinterpret_cast<const bf16x8*>(J.K + _r0); ks1 = *reinterpret_cast<const bf16x8*>(J.K + _r0 + 32L * LDP); } while (0)
#define SWRITE(b) do { *(bf16x8*)((char*)V_lds + (b) * SHM_V + vst0) = vs0; *(bf16x8*)((char*)V_lds + (b) * SHM_V + vst1) = vs1; int kc = sc * 2;               \
    *(bf16x8*)((char*)K_lds + (b) * SHM_K + KSWZ(sr, kc)) = ks0; *(bf16x8*)((char*)K_lds + (b) * SHM_K + KSWZ(32 + sr, kc)) = ks1; } while (0)
  SLOAD(0); asm volatile("s_waitcnt vmcnt(0)" ::: "memory"); SWRITE(0); __syncthreads();
  const int NT = J.nt;
#pragma unroll 1
  for (int t = 0; t < NT; ++t) {
    const int bsel = t & 1;
    if (t + 1 < NT) SLOAD(t + 1);
    bool active = true;
    if (t >= 4) { const int r = J.gr0 + (wid >> 1), kr = J.kstart + t - 4, rs = min(max(r - 4, 0), 120); active = (kr >= rs) && (kr < rs + 8); }
    if (active) {
    f32x16 p0, p1; float mn, al; bf16x8 pa0, pa1, pa2, pa3;
    qkt(p0, p1, (bf16_t*)((char*)K_lds + bsel * SHM_K), qr, r32, hi);
    na_mask<1>(p0, p1, J, t, wid, r32, hi, rpb);
    partialSM(p0, p1, m_reg, mn, al);
    if (__any(al < 1.f)) { if (hi == 0) al_l[r32] = al; asm volatile("s_waitcnt lgkmcnt(0)" ::: "memory");
      for (int d = 0; d < 4; ++d) for (int r = 0; r < 16; ++r) o[d][r] *= al_l[crow(r, hi)]; }
    finishSM(p0, p1, al, l_reg, pa0, pa1, pa2, pa3); SBAR();
    pv_d0(o, vb0 + bsel * (int)SHM_V, pa0, pa1, pa2, pa3);
    }
    if (t + 1 < NT) { asm volatile("s_waitcnt vmcnt(0)" ::: "memory"); SWRITE(bsel ^ 1); }
    __syncthreads();
  }
  if (hi == 0) li_l[r32] = l_reg; asm volatile("s_waitcnt lgkmcnt(0)" ::: "memory");
  float rli[16];
#pragma unroll
  for (int r = 0; r < 16; ++r) rli[r] = __builtin_amdgcn_rcpf(li_l[crow(r, hi)]);
  bf16_t* Ow = J.O + (long)(wid * QBLK) * LDO;
#pragma unroll
  for (int r = 0; r < 16; ++r) { int orow = crow(r, hi);
    for (int d0 = 0; d0 < 4; ++d0) Ow[(long)orow * LDO + d0 * 32 + r32] = (bf16_t)(cvt_pk_bf16(o[d0][r] * rli[r], 0.f) & 0xffffu); }
  asm volatile("s_waitcnt vmcnt(0)" ::: "memory");
  __syncthreads();
#undef TROW
#undef SLOAD
#undef SWRITE
}
}

struct Frame {
    const Params* p; unsigned char* ws; LAS unsigned char* lds; char* ldsg; int tid, lane, wave, bx, G;
};
__device__ __forceinline__ const float* inp(const Frame& F, int i) { i = __builtin_amdgcn_readfirstlane(i); asm volatile("" : "+s"(i)); return F.p->in[i]; }
__device__ __forceinline__ unsigned char* launder_ws(unsigned char* q) { unsigned long long a = (unsigned long long)q; unsigned lo = (unsigned)a, hi = (unsigned)(a >> 32); asm volatile("" : "+s"(lo), "+s"(hi)); return (unsigned char*)(((unsigned long long)hi << 32) | lo); }
__device__ __forceinline__ int launder_i(int v) { asm volatile("" : "+s"(v)); return v; }
#define FACC(name, type, off) __device__ __forceinline__ type* name(const Frame& F) { return (type*)(F.ws + (off)); }
FACC(fMOD, float, WS_MOD) FACC(fROPE, float, WS_ROPE) FACC(fWRT, float, WS_WRT) FACC(fAGG, f32x2, WS_AGG) FACC(fLDEST, int, WS_LDEST) FACC(fLW, float, WS_LW) FACC(fX, bf16_t, WS_X)
FACC(fHB, bf16_t, WS_HB) FACC(fHB8, unsigned char, WS_HB) FACC(fP, bf16_t, WS_P) FACC(fMIX, bf16_t, WS_MIX) FACC(fACT, unsigned char, WS_ACT) FACC(fY, unsigned char, WS_Y) FACC(fWIN, bf16_t, WS_WIN) FACC(fWOUT, bf16_t, WS_WOUT)
FACC(fLAB, u32x4, WS_LAB) FACC(fLRUW, bf16_t, WS_LRUW) FACC(fW1, unsigned char, WS_W1) FACC(fW2, unsigned char, WS_W2) FACC(fCNT, int, WS_CTL + CTL_CNT)

constexpr int P0_CV_L = 26304;
struct CvtDesc { const float* src; void* dst; int ldsrc, lddst, f8; };
__device__ __forceinline__ CvtDesc cvt_desc(const Frame& F, int l, int r) {
    CvtDesc d; d.f8 = 0;
    if (r < 1152) { const int kt = r / 72, nt = r % 72; d.src = inp(F, I_WIN) + ((size_t)l * 2048 + kt * 128) * INW + nt * 64; d.ldsrc = INW; d.dst = fWIN(F) + ((size_t)l * INW + nt * 64) * DM + kt * 128; d.lddst = DM; }
    else if (r < 1664) { r -= 1152; const int kt = r / 32, nt = r % 32; d.src = inp(F, I_WOUT) + ((size_t)l * 2048 + kt * 128) * DM + nt * 64; d.ldsrc = DM; d.dst = fWOUT(F) + ((size_t)l * DM + nt * 64) * DM + kt * 128; d.lddst = DM; }
    else if (r < 1664 + 16384) { r -= 1664; const int up = r >= 8192; r -= up * 8192; const int e = r >> 8, t = r & 255, kt = t >> 4, nt = t & 15, n0 = nt * 64;
        d.src = inp(F, up ? I_MWU : I_MWG) + ((size_t)(l * NEXP + e) * 2048 + kt * 128) * HID + n0; d.ldsrc = HID;
        const int drow = 256 * (n0 >> 7) + (n0 & 127) + up * 128; d.dst = fW1(F) + ((size_t)(l * NEXP + e) * 2048 + drow) * DM + kt * 128; d.lddst = DM; d.f8 = 1; }
    else if (r < 1664 + 24576) { r -= 1664 + 16384; const int e = r >> 8, t = r & 255, kt = t >> 5, nt = t & 31;
        d.src = inp(F, I_MWD) + ((size_t)(l * NEXP + e) * HID + kt * 128) * DM + nt * 64; d.ldsrc = DM; d.dst = fW2(F) + ((size_t)(l * NEXP + e) * DM + nt * 64) * HID + kt * 128; d.lddst = HID; d.f8 = 1; }
    else { r -= 1664 + 24576; const int mat = r >> 1, nt = r & 1, gate = mat >> 4, dd = (mat >> 3) & 1, n = mat & 7;
        d.src = inp(F, gate ? I_LRUWI : I_LRUWR) + ((size_t)((l * 2 + dd) * 8 + n) * 128) * 128 + nt * 64; d.ldsrc = 128;
        d.dst = fLRUW(F) + ((size_t)(((l * 2 + dd) * 8 + n) * 2 + gate) * 128 + nt * 64) * 128; d.lddst = 128; }
    return d;
}
__device__ __forceinline__ CvtDesc cvt_desc_g(const Frame& F, int g) {
    const int l = g >= P0_CV_L ? 1 : 0, sidx = g - l * P0_CV_L;
    const int r = sidx < 1664 ? sidx : (sidx < 1728 ? 26240 + (sidx - 1664) : sidx - 64);
    return cvt_desc(F, l, r);
}
__device__ __forceinline__ void cvt_run(const Frame& F, int first, int stride, int end, LAS float* T) {
    const int tid = F.tid, kk = tid >> 4, n4 = tid & 15, wv = tid >> 6, lane = tid & 63;
    if (first >= end) return;
    f32x4 v[4]; CvtDesc d = cvt_desc_g(F, first);
#pragma unroll
    for (int q = 0; q < 4; ++q) v[q] = __builtin_nontemporal_load((const f32x4*)(d.src + (size_t)(q * 32 + kk) * d.ldsrc + n4 * 4));
    int buf = 0;
#pragma unroll 1
    for (int r = first; r < end; r += stride, buf ^= 1) {
        LAS float* Tb = T + buf * (128 * 65);
#pragma unroll
        for (int q = 0; q < 4; ++q) { const int kr = q * 32 + kk; LAS float* w = Tb + kr * 65 + ((n4 * 4) ^ ((kr >> 4) << 2)); w[0] = v[q][0]; w[1] = v[q][1]; w[2] = v[q][2]; w[3] = v[q][3]; }
        const CvtDesc dc = d;
        if (r + stride < end) { d = cvt_desc_g(F, r + stride);
#pragma unroll
            for (int q = 0; q < 4; ++q) v[q] = __builtin_nontemporal_load((const f32x4*)(d.src + (size_t)(q * 32 + kk) * d.ldsrc + n4 * 4)); }
        __syncthreads();
        if (dc.f8) {
            const int nn = wv * 8 + (lane >> 3), k0 = (lane & 7) * 16; float x[16];
#pragma unroll
            for (int j = 0; j < 16; ++j) x[j] = Tb[(k0 + j) * 65 + (nn ^ ((k0 >> 4) << 2))] * 256.0f;
            *(u32x4*)((unsigned char*)dc.dst + (size_t)nn * dc.lddst + k0) = (u32x4){cvt_pk_fp8x4(x[0], x[1], x[2], x[3]), cvt_pk_fp8x4(x[4], x[5], x[6], x[7]), cvt_pk_fp8x4(x[8], x[9], x[10], x[11]), cvt_pk_fp8x4(x[12], x[13], x[14], x[15])};
        } else {
            const int rr = lane >> 4, k0 = (lane & 15) * 8;
#pragma unroll
            for (int i = 0; i < 2; ++i) { const int nn = wv * 8 + i * 4 + rr; float x[8];
#pragma unroll
                for (int j = 0; j < 8; ++j) x[j] = Tb[(k0 + j) * 65 + (nn ^ ((k0 >> 4) << 2))];
                *(u32x4*)((bf16_t*)dc.dst + (size_t)nn * dc.lddst + k0) = (u32x4){cvt_pk_bf16(x[0], x[1]), cvt_pk_bf16(x[2], x[3]), cvt_pk_bf16(x[4], x[5]), cvt_pk_bf16(x[6], x[7])}; }
        }
    }
    __syncthreads();
}
constexpr int CV_SMALL = 1728, CV_TOTAL = 2 * P0_CV_L;
constexpr int BG_T = 49152;
__device__ __forceinline__ int bg_claim(const Frame& F, int n) {
    LAS int* slot = (LAS int*)(F.lds + LDS_MISC + 256);
    __syncthreads();
    if (F.tid == 0) *slot = __hip_atomic_fetch_add((int*)(F.ws + WS_CTL + CTL_Q), n, __ATOMIC_RELAXED, __HIP_MEMORY_SCOPE_AGENT);
    __syncthreads();
    return *slot;
}
__device__ __forceinline__ void bg_fill(const Frame& F, int quota) {
    if (quota <= 0) return;
    const int g0 = bg_claim(F, quota); if (g0 >= CV_TOTAL) return;
    cvt_run(F, g0, 1, min(g0 + quota, CV_TOTAL), (LAS float*)(F.lds + BG_T));
}
__device__ __forceinline__ void bg_drain(const Frame& F, int target) {
    for (;;) { const int g0 = bg_claim(F, 6); if (g0 >= CV_TOTAL) break; cvt_run(F, g0, 1, min(g0 + 6, CV_TOTAL), (LAS float*)(F.lds + BG_T)); if (g0 + 6 >= target) break; }
}
constexpr int P0_ADA = 384, P0_RT = 96, P0_ROPE = 1, P0_UNITS = P0_ADA + P0_RT + P0_ROPE;
__device__ __forceinline__ void p0_prologue(const Frame& F) {
    const Params& p = *F.p; const int tid = F.tid;
    LAS float* sv = (LAS float*)F.lds;
    LAS float* part = (LAS float*)(F.lds + 24576);
    LAS float* T = (LAS float*)(F.lds + 49152);
    for (int i = tid; i < 3 * 2048; i += NTHR) { const float c = i < 4096 ? inp(F, I_C)[i] : inp(F, I_CCTX)[i - 4096]; sv[i] = c / (1.0f + __expf(-c)); }
    __syncthreads();
    for (int u = F.bx; u < P0_UNITS; u += F.G) {
        if (u < P0_ADA) {
            const int l = u / 192, col0 = (u % 192) * 64, c4 = tid & 15, ks = tid >> 4;
            const float* W = inp(F, I_ADAW) + ((size_t)l * 2048 + ks * 64) * 12288 + col0 + c4 * 4;
            f32x4 a0 = {0, 0, 0, 0}, a1 = a0, a2 = a0;
#pragma unroll 8
            for (int k = 0; k < 64; ++k) { const f32x4 w = __builtin_nontemporal_load((const f32x4*)(W + (size_t)k * 12288)); const float s0 = sv[ks * 64 + k], s1 = sv[2048 + ks * 64 + k], s2 = sv[4096 + ks * 64 + k];
                a0 += w * s0; a1 += w * s1; a2 += w * s2; }
#pragma unroll
            for (int j = 0; j < 4; ++j) { part[(ks * 3 + 0) * 64 + c4 * 4 + j] = a0[j]; part[(ks * 3 + 1) * 64 + c4 * 4 + j] = a1[j]; part[(ks * 3 + 2) * 64 + c4 * 4 + j] = a2[j]; }
            __syncthreads();
            if (tid < 192) { const int v = tid >> 6, c = tid & 63; float s = 0.f;
#pragma unroll
                for (int k = 0; k < 32; ++k) s += part[(k * 3 + v) * 64 + c];
                fMOD(F)[(size_t)(l * 3 + v) * 12288 + col0 + c] = s + inp(F, I_ADAB)[(size_t)l * 12288 + col0 + c]; }
            __syncthreads();
        } else if (u < P0_ADA + P0_RT) {
            const int q = u - P0_ADA, l = q / 48, j = q % 48; bf16_t* wrb = (bf16_t*)fWRT(F);
            for (int k = tid; k < 2048; k += NTHR) { const float v = j < 4 ? inp(F, I_RWG)[((size_t)l * 2048 + k) * 4 + j] : (j < 36 ? inp(F, I_RWE)[((size_t)l * 2048 + k) * 32 + (j - 4)] : 0.f);
                wrb[(size_t)(l * 48 + j) * 2048 + k] = (bf16_t)(cvt_pk_bf16(v, 0.f) & 0xffffu); }
        } else if (u < P0_ADA + P0_RT + P0_ROPE) {
            for (int i = tid; i < 4096; i += NTHR) { const int pos = i >> 5, f = i & 31; const double inv = exp(-9.210340371976184 * (double)f / 32.0); const double ang = (double)pos * inv;
                fROPE(F)[i] = (float)cos(ang); fROPE(F)[4096 + i] = (float)sin(ang); }
        }
    }
    __syncthreads();
    bg_drain(F, CV_SMALL);
}

__device__ __forceinline__ const float* mod_vec(const Frame& F, int l, int row) { const int b = row / TB, t = row - b * TB; return fMOD(F) + (size_t)(l * 3 + (t >= SEQ ? 2 : b)) * 12288; }
__device__ __forceinline__ void load_xrow(const Frame& F, int l, int row, f32x4 (&xv)[8]) {
    const Params& p = *F.p; const int lane = F.lane; const int b = row / TB, t = row - b * TB;
    if (l == 0) { const float* src = t >= SEQ ? inp(F, I_CTX) + ((size_t)b * CTXL + (t - SEQ)) * DM : inp(F, I_X) + ((size_t)b * SEQ + t) * DM;
#pragma unroll
        for (int j = 0; j < 8; ++j) xv[j] = *(const f32x4*)(src + j * 256 + lane * 4);
    } else { const bf16_t* xr = fX(F) + (size_t)row * DM; const float* g = mod_vec(F, l - 1, row) + 10240; const unsigned char* y0 = fY(F) + (size_t)row * 2 * DM; const unsigned char* y1 = y0 + DM;
#pragma unroll
        for (int j = 0; j < 8; ++j) { const int c = j * 256 + lane * 4; const u32x2 xw = *(const u32x2*)(xr + c); const f32x4 x = {bflo(xw.x), bfhi(xw.x), bflo(xw.y), bfhi(xw.y)}, gg = *(const f32x4*)(g + c);
            const unsigned a = *(const unsigned*)(y0 + c), bb = *(const unsigned*)(y1 + c);
            const f32x2 a0 = __builtin_amdgcn_cvt_pk_f32_fp8((int)a, false), a1 = __builtin_amdgcn_cvt_pk_f32_fp8((int)a, true), b0 = __builtin_amdgcn_cvt_pk_f32_fp8((int)bb, false), b1 = __builtin_amdgcn_cvt_pk_f32_fp8((int)bb, true);
            f32x4 y; y[0] = a0[0] + b0[0]; y[1] = a0[1] + b0[1]; y[2] = a1[0] + b1[0]; y[3] = a1[1] + b1[1]; xv[j] = x + gg * (y * 0.0625f); } }
}
__device__ __forceinline__ float row_rstd(const f32x4 (&xv)[8]) { float s = 0.f;
#pragma unroll
    for (int j = 0; j < 8; ++j) s += xv[j][0] * xv[j][0] + xv[j][1] * xv[j][1] + xv[j][2] * xv[j][2] + xv[j][3] * xv[j][3];
    s = wave_sum(s); return rsqrtf(s * (1.0f / DM) + EPS); }

__device__ __forceinline__ void n1_phase(const Frame& F, int l, bool dry) {
    const Params& p = *F.p; const int lane = F.lane;
    for (int row = F.bx * 8 + F.wave; row < MTOK; row += F.G * 8) {
        f32x4 xv[8]; load_xrow(F, l, row, xv);
        bf16_t* xo = (dry ? fP(F) : fX(F)) + (size_t)row * DM;
#pragma unroll
        for (int j = 0; j < 8; ++j) { u32x2 w; w.x = cvt_pk_bf16(xv[j][0], xv[j][1]); w.y = cvt_pk_bf16(xv[j][2], xv[j][3]); *(u32x2*)(xo + j * 256 + lane * 4) = w; }
        const float rstd = row_rstd(xv); const float* mv = mod_vec(F, l, row); const float* g = inp(F, I_N1G) + (size_t)l * DM; bf16_t* ho = (dry ? fMIX(F) : fHB(F)) + (size_t)row * DM;
#pragma unroll
        for (int j = 0; j < 8; ++j) { const int c = j * 256 + lane * 4; const f32x4 gg = *(const f32x4*)(g + c), sh = *(const f32x4*)(mv + c), sc = *(const f32x4*)(mv + 2048 + c);
            const f32x4 h = xv[j] * rstd * gg * (sc + 1.0f) + sh; u32x2 w; w.x = cvt_pk_bf16(h[0], h[1]); w.y = cvt_pk_bf16(h[2], h[3]); *(u32x2*)(ho + c) = w; }
    }
}
__device__ __forceinline__ void fin_phase(const Frame& F) {
    const Params& p = *F.p; const int lane = F.lane;
    for (int q = F.bx * 8 + F.wave; q < NB * SEQ; q += F.G * 8) {
        const int b = q / SEQ, t = q - b * SEQ, row = b * TB + t;
        f32x4 xv[8]; load_xrow(F, 2, row, xv);
        const float rstd = row_rstd(xv); const float* g = inp(F, I_FING); float* o = (float*)inp(F, I_OUT) + (size_t)q * DM;
#pragma unroll
        for (int j = 0; j < 8; ++j) { const int c = j * 256 + lane * 4; *(f32x4*)(o + c) = xv[j] * rstd * *(const f32x4*)(g + c); }
    }
}

constexpr int N2_T = 0, N2_TP = 2056, N2_RED = 16 * N2_TP * 2, N2_LG = N2_RED + 8 * 16 * 48 * 4, N2_CTL = N2_LG + 16 * 48 * 4;
__device__ __forceinline__ void n2_phase(const Frame& F, int l, bool dry) {
    const int lane = F.lane, tid = F.tid, wave = F.wave;
    LAS bf16_t* T = (LAS bf16_t*)(F.lds + N2_T); LAS float* RED = (LAS float*)(F.lds + N2_RED); LAS float* LG = (LAS float*)(F.lds + N2_LG);
    LAS int* lc = (LAS int*)(F.lds + N2_CTL);
    LAS int* gb = lc + 32;
    LAS int* ri = gb + 32;
    LAS float* rw = (LAS float*)(ri + 66 * 4);
    if (tid < 32) lc[tid] = 0;
    __syncthreads();
    const int r0 = F.bx * 66;
    const bf16_t* wrb = (const bf16_t*)fWRT(F) + (size_t)l * 48 * 2048;
    const float* g = inp(F, I_N2G) + (size_t)l * DM; const float* rbg = inp(F, I_RBG) + l * 4; const float* rbe = inp(F, I_RBE) + l * 32;
    u32x2 xraw[2][8];
#define N2_LOADX(ubv) do { _Pragma("unroll") for (int q2 = 0; q2 < 2; ++q2) { const int rr_ = wave * 2 + q2, row_ = r0 + (ubv) + rr_; const int t_ = row_ % TB; \
        const bool ok_ = ((ubv) + rr_ < 66) && !(l == 1 && t_ >= SEQ); const bf16_t* xr_ = fX(F) + (size_t)row_ * DM; \
        _Pragma("unroll") for (int j = 0; j < 8; ++j) xraw[q2][j] = ok_ ? *(const u32x2*)(xr_ + j * 256 + lane * 4) : (u32x2){0u, 0u}; } } while (0)
    N2_LOADX(0);
#pragma unroll 1
    for (int ub = 0; ub < 66; ub += 16) {
        const int nrow = min(16, 66 - ub);
#pragma unroll
        for (int q2 = 0; q2 < 2; ++q2) {
            const int rr = wave * 2 + q2;
            const int i = ub + rr, row = r0 + i; const int b = row / TB, t = row - b * TB;
            const bool ok = (rr < nrow) && !(l == 1 && t >= SEQ);
            if (ok) {
            f32x4 xv[8];
#pragma unroll
            for (int j = 0; j < 8; ++j) { const u32x2 xw = xraw[q2][j]; xv[j] = (f32x4){bflo(xw.x), bfhi(xw.x), bflo(xw.y), bfhi(xw.y)}; }
            const float rstd = row_rstd(xv); const float* mv = mod_vec(F, l, row); unsigned char* ho = fHB8(F) + (size_t)row * DM;
#pragma unroll
            for (int j = 0; j < 8; ++j) { const int c = j * 256 + lane * 4; const f32x4 gg = *(const f32x4*)(g + c), sh = *(const f32x4*)(mv + 6144 + c), sc = *(const f32x4*)(mv + 8192 + c);
                const f32x4 h = xv[j] * rstd * gg * (sc + 1.0f) + sh; u32x2 w; w.x = cvt_pk_bf16(h[0], h[1]); w.y = cvt_pk_bf16(h[2], h[3]); *(unsigned*)(ho + c) = cvt_pk_fp8x4_sat(h[0], h[1], h[2], h[3]); *(LAS u32x2*)(T + rr * N2_TP + c) = w; }
            }
        }
        if (ub + 16 < 66) N2_LOADX(ub + 16);
        __syncthreads();
        { const int fr = lane & 15, kq = lane >> 4;
          f32x4 acc[3] = {{0, 0, 0, 0}, {0, 0, 0, 0}, {0, 0, 0, 0}};
#pragma unroll
          for (int s = 0; s < 8; ++s) { const int k0 = (wave * 8 + s) * 32 + kq * 8;
              const bf16x8 tb = *(const LAS bf16x8*)(T + fr * N2_TP + k0);
#pragma unroll
              for (int t3 = 0; t3 < 3; ++t3) { const bf16x8 wa = *(const bf16x8*)(wrb + (size_t)(t3 * 16 + fr) * 2048 + k0); acc[t3] = __builtin_amdgcn_mfma_f32_16x16x32_bf16(wa, tb, acc[t3], 0, 0, 0); } }
#pragma unroll
          for (int t3 = 0; t3 < 3; ++t3) *(LAS f32x4*)(RED + (wave * 16 + fr) * 48 + t3 * 16 + kq * 4) = acc[t3]; }
        __syncthreads();
        for (int q = tid; q < 16 * 48; q += NTHR) { float s = 0.f;
#pragma unroll
            for (int w = 0; w < 8; ++w) s += RED[w * 768 + q];
            const int e = q % 48; LG[q] = s + (e < 4 ? rbg[e] : (e < 36 ? rbe[e - 4] : 0.f)); }
        __syncthreads();
        if (tid < nrow) {
            const int i = ub + tid, row = r0 + i; const int b = row / TB, t = row - b * TB;
            if (l == 1 && t >= SEQ) ri[i * 4] = -1;
            else {
                const LAS float* lg = LG + tid * 48;
                int gs = 0; float gm = lg[0];
#pragma unroll
                for (int k = 1; k < 4; ++k) if (lg[k] > gm) { gm = lg[k]; gs = k; }
                float den = 0.f;
#pragma unroll
                for (int k = 0; k < 4; ++k) den += __expf(lg[k] - gm);
                const float ggate = 1.0f / den;
                const LAS float* le = lg + 4 + gs * 8;
                int i0 = 0; float v0 = le[0];
#pragma unroll
                for (int k = 1; k < 8; ++k) if (le[k] > v0) { v0 = le[k]; i0 = k; }
                int i1 = -1; float v1 = -3.0e38f;
#pragma unroll
                for (int k = 0; k < 8; ++k) if (k != i0 && le[k] > v1) { v1 = le[k]; i1 = k; }
                const float e1 = __expf(v1 - v0), w0 = ggate / (1.0f + e1), w1 = ggate * e1 / (1.0f + e1);
                const int ex0 = gs * 8 + i0, ex1 = gs * 8 + i1;
                const int lp0 = __hip_atomic_fetch_add(lc + ex0, 1, __ATOMIC_RELAXED, __HIP_MEMORY_SCOPE_WORKGROUP), lp1 = __hip_atomic_fetch_add(lc + ex1, 1, __ATOMIC_RELAXED, __HIP_MEMORY_SCOPE_WORKGROUP);
                ri[i * 4 + 0] = ex0; ri[i * 4 + 1] = ex1; ri[i * 4 + 2] = lp0; ri[i * 4 + 3] = lp1; rw[i * 2] = w0; rw[i * 2 + 1] = w1;
            }
        }
    }
#undef N2_LOADX
    __syncthreads();
    if (dry) { __syncthreads(); return; }
    if (tid < 32) { const int c = lc[tid]; gb[tid] = c > 0 ? __hip_atomic_fetch_add(fCNT(F) + l * 32 + tid, c, __ATOMIC_RELAXED, __HIP_MEMORY_SCOPE_AGENT) : 0; }
    __syncthreads();
    if (tid < 66 && ri[tid * 4] >= 0) { const int row = r0 + tid;
#pragma unroll
        for (int k = 0; k < 2; ++k) { const int e = ri[tid * 4 + k]; const size_t pos = (size_t)e * CAP + gb[e] + ri[tid * 4 + 2 + k]; fLDEST(F)[pos] = row * 2 + k; fLW(F)[pos] = rw[tid * 2 + k]; } }
    __syncthreads();
}

__device__ __forceinline__ void qknorm_phase(const Frame& F, int l) {
    const Params& p = *F.p; const int lane = F.lane, li = lane & 15;
    const float* COS = fROPE(F); const float* SIN = fROPE(F) + 4096; const float* gq = inp(F, I_QNORM); const float* gk = inp(F, I_KNORM);
    for (int it = (F.bx * 8 + F.wave) * 4 + (lane >> 4); it < MTOK * 6; it += F.G * 32) {
        const int row = it / 6, slot = it - row * 6; const int col = slot < 4 ? C_QA + slot * 128 : C_KA + (slot - 4) * 128;
        const float* g = (slot < 4 ? gq : gk) + l * 128 + li * 8;
        bf16_t* ptr = fP(F) + (size_t)row * INW + col + li * 8;
        const u32x4 raw = *(const u32x4*)ptr;
        float v[8] = {bflo(raw.x), bfhi(raw.x), bflo(raw.y), bfhi(raw.y), bflo(raw.z), bfhi(raw.z), bflo(raw.w), bfhi(raw.w)};
        float ss = 0.f;
#pragma unroll
        for (int e = 0; e < 8; ++e) ss += v[e] * v[e];
        ss += __shfl_xor(ss, 1); ss += __shfl_xor(ss, 2); ss += __shfl_xor(ss, 4); ss += __shfl_xor(ss, 8);
        const float rstd = rsqrtf(ss * (1.0f / 128.0f) + EPS);
        const f32x4 g0 = *(const f32x4*)g, g1 = *(const f32x4*)(g + 4);
#pragma unroll
        for (int e = 0; e < 4; ++e) { v[e] = v[e] * rstd * g0[e]; v[4 + e] = v[4 + e] * rstd * g1[e]; }
        const int t = row % TB;
        float pr[8];
#pragma unroll
        for (int e = 0; e < 8; ++e) pr[e] = __shfl_xor(v[e], 4);
        if (t < SEQ) { const int half = (li >> 2) & 1, axis = li >> 3, pos = axis ? (t & 63) : (t >> 6); const int fb = pos * 32 + (li & 3) * 8;
#pragma unroll
            for (int e = 0; e < 8; ++e) { const float c = COS[fb + e], s = SIN[fb + e]; v[e] = half ? v[e] * c + pr[e] * s : v[e] * c - pr[e] * s; } }
        u32x4 w; w.x = cvt_pk_bf16(v[0], v[1]); w.y = cvt_pk_bf16(v[2], v[3]); w.z = cvt_pk_bf16(v[4], v[5]); w.w = cvt_pk_bf16(v[6], v[7]);
        *(u32x4*)ptr = w;
    }
}

template <int DIR> __device__ __forceinline__ void lru_scan(const f32x16 (&A)[2], f32x16 (&Bv)[2], float h_in, int hi, float& Atot, float& hend, bool want_h) {
    float GA[8], GB[8], PA[8], PB[8], hs[8];
#pragma unroll
    for (int j = 0; j < 8; ++j) { const int mt = j >> 2, rb = (j & 3) * 4; float Bc = 0.f, Ap = 1.f;
#pragma unroll
        for (int q = 0; q < 4; ++q) { const int e = DIR ? 3 - q : q; const float a = A[mt][rb + e], b = Bv[mt][rb + e]; Bc = a * Bc + b; Ap *= a; }
        GA[j] = Ap; GB[j] = Bc; PA[j] = __shfl_xor(Ap, 32); PB[j] = __shfl_xor(Bc, 32); }
    float h = h_in, at = 1.f;
#pragma unroll
    for (int q = 0; q < 8; ++q) { const int j = DIR ? 7 - q : q;
        const bool own_first = DIR ? (hi == 1) : (hi == 0);
        const float a0 = own_first ? GA[j] : PA[j], b0 = own_first ? GB[j] : PB[j], a1 = own_first ? PA[j] : GA[j], b1 = own_first ? PB[j] : GB[j];
        const float h0 = h, h1 = a0 * h0 + b0, h2 = a1 * h1 + b1; hs[j] = own_first ? h0 : h1; h = h2; at *= GA[j] * PA[j]; }
    Atot = at; hend = h;
    if (want_h) {
#pragma unroll
        for (int j = 0; j < 8; ++j) { const int mt = j >> 2, rb = (j & 3) * 4; float hc = hs[j];
#pragma unroll
            for (int q = 0; q < 4; ++q) { const int e = DIR ? 3 - q : q; hc = A[mt][rb + e] * hc + Bv[mt][rb + e]; Bv[mt][rb + e] = hc; } }
    }
}
constexpr int LRU_UCF = 0, LRU_UCB = 32768, LRU_HS = 51200, LRU_CAR = 116736, LRU_CW = 126464;
template <bool FINAL> __device__ __forceinline__ void lru_units(const Frame& F, int l) {
    int tz = threadIdx.x; asm volatile("" : "+v"(tz)); const int tid = tz, lane = tid & 63, wave = __builtin_amdgcn_readfirstlane(tid >> 6), r32 = lane & 31, hi = lane >> 5, d = wave >> 2, cg = wave & 3;
    LAS float* UCf = (LAS float*)(F.lds + LRU_UCF); LAS bf16_t* UCb = (LAS bf16_t*)(F.lds + LRU_UCB); LAS float* HS = (LAS float*)(F.lds + LRU_HS);
    LAS float* CAR = (LAS float*)(F.lds + LRU_CAR); LAS float* CW = (LAS float*)(F.lds + LRU_CW);
    const int nch = (FINAL && l == 1) ? SEQ / 64 : NCHUNK;
    const int nunits = NB * nch * 8;
    const int n = F.bx & 7;
    const int ch = n * 128 + cg * 32 + r32;
    const int q0 = F.bx >> 3;
    for (int i = tid; i < 640; i += NTHR) CW[i] = i < 512 ? inp(F, I_CONVW)[(size_t)l * 4096 + (i >> 7) * 1024 + n * 128 + (i & 127)] : inp(F, I_CONVB)[(size_t)l * 1024 + n * 128 + (i - 512)];
    if (FINAL) {
        const int cb_ = tid >> 8, cd = (tid >> 7) & 1, cl = tid & 127;
        const f32x2* ag = fAGG(F) + (size_t)((cb_ * 2 + cd) * NCHUNK) * 1024 + n * 128 + cl;
        float h = 0.f;
#pragma unroll 1
        for (int p0 = 0; p0 < NCHUNK; p0 += 12) {
            f32x2 ab[12];
#pragma unroll
            for (int j = 0; j < 12; ++j) { const int pp = p0 + j; const int cc = cd ? (NCHUNK - 1 - pp) : (pp + 128) % NCHUNK; ab[j] = ag[(size_t)cc * 1024]; }
#pragma unroll
            for (int j = 0; j < 12; ++j) { const int pp = p0 + j; const int cc = cd ? (NCHUNK - 1 - pp) : (pp + 128) % NCHUNK;
                if (cc < nch) { const int q = cb_ * nch + cc - q0; if (q >= 0 && (q & 31) == 0) CAR[((q >> 5) * 2 + cd) * 128 + cl] = h; }
                h = ab[j].x * h + ab[j].y; }
        }
    }
    bf16x8 Br[8], Bi[8];
    { const bf16_t* wb = fLRUW(F) + ((size_t)(((l * 2 + d) * 8 + n) * 2) * 128 + cg * 32 + r32) * 128 + hi * 8;
#pragma unroll
      for (int s = 0; s < 8; ++s) { Br[s] = *(const bf16x8*)(wb + s * 16); Bi[s] = *(const bf16x8*)(wb + 128 * 128 + s * 16); } }
    const float brv = -1.4426950409f * inp(F, I_LRUBR)[(l * 2 + d) * 1024 + ch], biv = -1.4426950409f * inp(F, I_LRUBI)[(l * 2 + d) * 1024 + ch];
    const float lam = inp(F, I_LAM)[(l * 2 + d) * 1024 + ch]; const float sp8 = -8.0f * 1.4426950409f * log1pf(__expf(-lam));
    const int tok = tid >> 3, ch0 = (tid & 7) * 16;
    u32x4 U[4][2];
#define LRU_LOADU(uu) do { const int q_ = (uu) >> 3, b_ = q_ / nch, c_ = q_ - b_ * nch; const int t_ = c_ * 64 + tok, lo_ = c_ >= 128 ? SEQ : 0, hi_ = c_ >= 128 ? TB : SEQ; \
        _Pragma("unroll") for (int i = 0; i < 4; ++i) { const int tt = t_ - 1 + i; if (tt >= lo_ && tt < hi_) { const bf16_t* up = fP(F) + ((size_t)(b_ * TB + tt)) * INW + C_UB + n * 128 + ch0; U[i][0] = *(const u32x4*)up; U[i][1] = *(const u32x4*)(up + 8); } \
            else { U[i][0] = (u32x4){0u, 0u, 0u, 0u}; U[i][1] = (u32x4){0u, 0u, 0u, 0u}; } } } while (0)
    if (F.bx < nunits) LRU_LOADU(F.bx);
    __syncthreads();
    int kk = 0;
#pragma unroll 1
    for (int u = F.bx; u < nunits; u += F.G, ++kk) {
        const int q = u >> 3, b = q / nch, c = q - b * nch;
        { float y[16];
#pragma unroll
          for (int j = 0; j < 16; j += 4) { const f32x4 bv = *(const LAS f32x4*)(CW + 512 + ch0 + j); y[j] = bv[0]; y[j + 1] = bv[1]; y[j + 2] = bv[2]; y[j + 3] = bv[3]; }
#pragma unroll
          for (int i = 0; i < 4; ++i) { const u32x4 u0 = U[i][0], u1 = U[i][1];
              const float uu[16] = {bflo(u0.x), bfhi(u0.x), bflo(u0.y), bfhi(u0.y), bflo(u0.z), bfhi(u0.z), bflo(u0.w), bfhi(u0.w), bflo(u1.x), bfhi(u1.x), bflo(u1.y), bfhi(u1.y), bflo(u1.z), bfhi(u1.z), bflo(u1.w), bfhi(u1.w)};
#pragma unroll
              for (int j = 0; j < 16; j += 4) { const f32x4 wv = *(const LAS f32x4*)(CW + i * 128 + ch0 + j); y[j] += wv[0] * uu[j]; y[j + 1] += wv[1] * uu[j + 1]; y[j + 2] += wv[2] * uu[j + 2]; y[j + 3] += wv[3] * uu[j + 3]; } }
#pragma unroll
          for (int j = 0; j < 16; j += 4) *(LAS f32x4*)(UCf + tok * 128 + ch0 + j) = (f32x4){y[j], y[j + 1], y[j + 2], y[j + 3]};
          LAS u32x4* ub = (LAS u32x4*)(UCb + tok * 136 + ch0);
          ub[0] = (u32x4){cvt_pk_bf16(y[0], y[1]), cvt_pk_bf16(y[2], y[3]), cvt_pk_bf16(y[4], y[5]), cvt_pk_bf16(y[6], y[7])};
          ub[1] = (u32x4){cvt_pk_bf16(y[8], y[9]), cvt_pk_bf16(y[10], y[11]), cvt_pk_bf16(y[12], y[13]), cvt_pk_bf16(y[14], y[15])}; }
        u32x4 g0 = {0u, 0u, 0u, 0u}, g1 = g0;
        const size_t row = (size_t)b * TB + c * 64 + tok;
        if (FINAL) { const bf16_t* gp = fP(F) + row * INW + C_GB + n * 128 + ch0; g0 = *(const u32x4*)gp; g1 = *(const u32x4*)(gp + 8); }
        if (u + F.G < nunits) LRU_LOADU(u + F.G);
        __syncthreads();
        f32x16 av[2] = {}, bv[2] = {};
#pragma unroll
        for (int s = 0; s < 8; ++s)
#pragma unroll
            for (int mt = 0; mt < 2; ++mt) { const bf16x8 a = *(const LAS bf16x8*)(UCb + (mt * 32 + r32) * 136 + s * 16 + hi * 8);
                av[mt] = __builtin_amdgcn_mfma_f32_32x32x16_bf16(a, Br[s], av[mt], 0, 0, 0); bv[mt] = __builtin_amdgcn_mfma_f32_32x32x16_bf16(a, Bi[s], bv[mt], 0, 0, 0); }
        u32x4* lab = fLAB(F) + ((size_t)(u * 8 + wave) * 8) * 64 + lane;
#pragma unroll
        for (int mt = 0; mt < 2; ++mt)
#pragma unroll
            for (int rg = 0; rg < 4; ++rg) { unsigned w4[4];
#pragma unroll
                for (int j = 0; j < 4; ++j) { const int r = rg * 4 + j; const int tk = mt * 32 + (r & 3) + 8 * (r >> 2) + 4 * hi; const float uc = UCf[tk * 128 + cg * 32 + r32];
                    const float e1 = __builtin_amdgcn_exp2f(fminf(fmaf(av[mt][r], -1.4426950409f, brv), 40.f)), e2 = __builtin_amdgcn_exp2f(fminf(fmaf(bv[mt][r], -1.4426950409f, biv), 40.f));
                    const float d1 = 1.0f + e1, d2 = 1.0f + e2, rc = __builtin_amdgcn_rcpf(d1 * d2); const float la = sp8 * (rc * d2); const float a = __builtin_amdgcn_exp2f(la);
                    const float bb = __builtin_amdgcn_sqrtf(fmaxf(fmaf(-a, a, 1.0f), 0.f)) * (rc * d1) * uc; av[mt][r] = a; bv[mt][r] = bb;
                    if (!FINAL) { const _Float16 hl = (_Float16)la; w4[j] = ((unsigned)__builtin_bit_cast(unsigned short, hl) << 16) | (cvt_pk_bf16(bb, 0.f) & 0xffffu); } }
                if (!FINAL) lab[(mt * 4 + rg) * 64] = (u32x4){w4[0], w4[1], w4[2], w4[3]}; }
        if (!FINAL) {
            float At, he;
            if (d == 0) lru_scan<0>(av, bv, 0.f, hi, At, he, false); else lru_scan<1>(av, bv, 0.f, hi, At, he, false);
            if (hi == 0) fAGG(F)[(size_t)((b * 2 + d) * NCHUNK + c) * 1024 + ch] = (f32x2){At, he};
            __syncthreads();
        } else {
            const float h_in = CAR[(kk * 2 + d) * 128 + cg * 32 + r32];
            float At, he;
            if (d == 0) lru_scan<0>(av, bv, h_in, hi, At, he, true); else lru_scan<1>(av, bv, h_in, hi, At, he, true);
#pragma unroll
            for (int mt = 0; mt < 2; ++mt)
#pragma unroll
                for (int r = 0; r < 16; ++r) { const int tk = mt * 32 + (r & 3) + 8 * (r >> 2) + 4 * hi; HS[(d * 64 + tk) * 128 + cg * 32 + r32] = bv[mt][r]; }
            __syncthreads();
            { const float gg[16] = {bflo(g0.x), bfhi(g0.x), bflo(g0.y), bfhi(g0.y), bflo(g0.z), bfhi(g0.z), bflo(g0.w), bfhi(g0.w), bflo(g1.x), bfhi(g1.x), bflo(g1.y), bfhi(g1.y), bflo(g1.z), bfhi(g1.z), bflo(g1.w), bfhi(g1.w)};
              float o[16];
#pragma unroll
              for (int j = 0; j < 16; ++j) o[j] = (HS[tok * 128 + ch0 + j] + HS[(64 + tok) * 128 + ch0 + j]) * gelu_tanh(gg[j]);
              u32x4* op = (u32x4*)(fMIX(F) + row * DM + 512 + n * 128 + ch0);
              op[0] = (u32x4){cvt_pk_bf16(o[0], o[1]), cvt_pk_bf16(o[2], o[3]), cvt_pk_bf16(o[4], o[5]), cvt_pk_bf16(o[6], o[7])};
              op[1] = (u32x4){cvt_pk_bf16(o[8], o[9]), cvt_pk_bf16(o[10], o[11]), cvt_pk_bf16(o[12], o[13]), cvt_pk_bf16(o[14], o[15])}; }
            __syncthreads();
        }
    }
#undef LRU_LOADU
}

__device__ __forceinline__ void lru_pass2(const Frame& F, int l) {
    int tz = threadIdx.x; asm volatile("" : "+v"(tz)); const int tid = tz, lane = tid & 63, wave = __builtin_amdgcn_readfirstlane(tid >> 6), r32 = lane & 31, hi = lane >> 5, d = wave >> 2, cg = wave & 3;
    LAS float* HS = (LAS float*)(F.lds + LRU_HS); LAS float* CAR = (LAS float*)(F.lds + LRU_CAR);
    const int nch = (l == 1) ? SEQ / 64 : NCHUNK;
    const int nunits = NB * nch * 8, n = F.bx & 7, q0 = F.bx >> 3;
    { const int cb_ = tid >> 8, cd = (tid >> 7) & 1, cl = tid & 127;
      const f32x2* ag = fAGG(F) + (size_t)((cb_ * 2 + cd) * NCHUNK) * 1024 + n * 128 + cl;
      float h = 0.f;
#pragma unroll 1
      for (int p0 = 0; p0 < NCHUNK; p0 += 12) {
          f32x2 ab[12];
#pragma unroll
          for (int j = 0; j < 12; ++j) { const int pp = p0 + j; const int cc = cd ? (NCHUNK - 1 - pp) : (pp + 128) % NCHUNK; ab[j] = ag[(size_t)cc * 1024]; }
#pragma unroll
          for (int j = 0; j < 12; ++j) { const int pp = p0 + j; const int cc = cd ? (NCHUNK - 1 - pp) : (pp + 128) % NCHUNK;
              if (cc < nch) { const int q = cb_ * nch + cc - q0; if (q >= 0 && (q & 31) == 0) CAR[((q >> 5) * 2 + cd) * 128 + cl] = h; }
              h = ab[j].x * h + ab[j].y; }
      } }
    const int tok = tid >> 3, ch0 = (tid & 7) * 16;
    u32x4 W[8];
#define LRU_LOADW(uu) do { const int q_ = (uu) >> 3, b_ = q_ / nch, c_ = q_ - b_ * nch; const u32x4* lab_ = fLAB(F) + ((size_t)(((b_ * NCHUNK + c_) * 8 + n) * 8 + wave) * 8) * 64 + lane; \
        _Pragma("unroll") for (int q8 = 0; q8 < 8; ++q8) W[q8] = lab_[q8 * 64]; } while (0)
    if (F.bx < nunits) LRU_LOADW(F.bx);
    __syncthreads();
    int kk = 0;
#pragma unroll 1
    for (int u = F.bx; u < nunits; u += F.G, ++kk) {
        const int q = u >> 3, b = q / nch, c = q - b * nch;
        f32x16 av[2], bv[2];
#pragma unroll
        for (int q8 = 0; q8 < 8; ++q8)
#pragma unroll
            for (int j = 0; j < 4; ++j) { const unsigned w = W[q8][j]; const int mt = q8 >> 2, r = (q8 & 3) * 4 + j;
                av[mt][r] = __builtin_amdgcn_exp2f((float)__builtin_bit_cast(_Float16, (unsigned short)(w >> 16))); bv[mt][r] = __uint_as_float(w << 16); }
        const size_t row = (size_t)b * TB + c * 64 + tok;
        const bf16_t* gp = fP(F) + row * INW + C_GB + n * 128 + ch0; const u32x4 g0 = *(const u32x4*)gp, g1 = *(const u32x4*)(gp + 8);
        if (u + F.G < nunits) LRU_LOADW(u + F.G);
        const float h_in = CAR[(kk * 2 + d) * 128 + cg * 32 + r32];
        float At, he;
        if (d == 0) lru_scan<0>(av, bv, h_in, hi, At, he, true); else lru_scan<1>(av, bv, h_in, hi, At, he, true);
#pragma unroll
        for (int mt = 0; mt < 2; ++mt)
#pragma unroll
            for (int r = 0; r < 16; ++r) { const int tk = mt * 32 + (r & 3) + 8 * (r >> 2) + 4 * hi; HS[(d * 64 + tk) * 128 + cg * 32 + r32] = bv[mt][r]; }
        __syncthreads();
        { const float gg[16] = {bflo(g0.x), bfhi(g0.x), bflo(g0.y), bfhi(g0.y), bflo(g0.z), bfhi(g0.z), bflo(g0.w), bfhi(g0.w), bflo(g1.x), bfhi(g1.x), bflo(g1.y), bfhi(g1.y), bflo(g1.z), bfhi(g1.z), bflo(g1.w), bfhi(g1.w)};
          float o[16];
#pragma unroll
          for (int j = 0; j < 16; ++j) o[j] = (HS[tok * 128 + ch0 + j] + HS[(64 + tok) * 128 + ch0 + j]) * gelu_tanh(gg[j]);
          u32x4* op = (u32x4*)(fMIX(F) + row * DM + 512 + n * 128 + ch0);
          op[0] = (u32x4){cvt_pk_bf16(o[0], o[1]), cvt_pk_bf16(o[2], o[3]), cvt_pk_bf16(o[4], o[5]), cvt_pk_bf16(o[6], o[7])};
          op[1] = (u32x4){cvt_pk_bf16(o[8], o[9]), cvt_pk_bf16(o[10], o[11]), cvt_pk_bf16(o[12], o[13]), cvt_pk_bf16(o[14], o[15])}; }
        __syncthreads();
    }
#undef LRU_LOADW
}

#ifndef ATT_REP_MODE
#define ATT_REP_MODE 7
#endif
__device__ __forceinline__ void attn_phase(const Frame& F, int l, int rep) {
    const int amode = rep ? ATT_REP_MODE : 7;
    const Params& p = *F.p; const int bx = F.bx;
    const int x = bx & 7, o = (bx >> 3) & 31;
#ifndef NA_SKIP
    if (amode & 2) {
        att::Job J; J.mode = 1;
        const int b = x >> 2, h = x & 3, rg = o;
        float* rp = (float*)(F.ldsg + att::RPB_OFF);
        for (int i = F.tid; i < 15 * 31; i += NTHR) rp[i] = inp(F, I_RPB)[(size_t)(l * 4 + h) * 465 + i] * (1.0f / att::SCALE);
        J.Q = fP(F) + ((size_t)b * TB + rg * 256) * INW + C_QN + h * 128; J.K = fP(F) + C_KN + h * 128; J.V = fP(F) + C_VN + h * 128;
        J.O = fMIX(F) + ((size_t)b * TB + rg * 256) * DM + 1536 + h * 128; J.nt = 16; J.row_a = b * TB + SEQ; J.gr0 = rg * 4;
        J.kstart = min(max(rg * 4 - 4, 0), 116); J.row_b = b * TB + J.kstart * 64;
        att::opaque(J); att::attn_unit_na(J, F.ldsg);
    }
#endif
#ifndef GQA_SKIP
    const int njobs = (amode & 1) ? ((l == 0 && bx < 16) ? 2 : 1) : 0;
#pragma unroll 1
    for (int k = 0; k < njobs; ++k) {
        att::Job J; J.mode = 0; J.row_b = 0; J.gr0 = 0; J.kstart = 0;
        int qc, kc, vc, oc, q0;
        if (k == 0) { const int b = x >> 2, kvh = (x >> 1) & 1, hq = kvh * 2 + (x & 1); q0 = b * TB + o * 256; qc = C_QA + hq * 128; kc = C_KA + kvh * 128; vc = C_VA + kvh * 128; oc = hq * 128; J.nt = TB / 64; J.row_a = b * TB; }
        else { const int b = bx >> 3, hh = bx & 7; q0 = b * TB + SEQ; J.nt = 4; J.row_a = q0;
            qc = hh < 4 ? C_QA + hh * 128 : C_QN + (hh - 4) * 128; kc = hh < 4 ? C_KA + (hh >> 1) * 128 : C_KN + (hh - 4) * 128; vc = hh < 4 ? C_VA + (hh >> 1) * 128 : C_VN + (hh - 4) * 128; oc = hh < 4 ? hh * 128 : 1536 + (hh - 4) * 128; }
        J.Q = fP(F) + (size_t)q0 * INW + qc; J.K = fP(F) + kc; J.V = fP(F) + vc; J.O = fMIX(F) + (size_t)q0 * DM + oc;
        att::opaque(J); att::attn_unit<0>(J, F.ldsg);
    }
#endif
#ifndef LRU2_SKIP
    if (amode & 4) lru_pass2(F, l);
#endif
}

__device__ __forceinline__ int moe_setup(const Frame& F, int l) {
    LAS int* tp = (LAS int*)(F.lds + LDS_MISC); LAS int* ud = (LAS int*)(F.lds + LDS_UD); LAS int* rows = (LAS int*)(F.lds + LDS_ROWS); LAS float* wts = (LAS float*)(F.lds + LDS_WTS);
    const int* cnt = fCNT(F) + l * 32;
    if (F.tid == 0) { int s = 0; for (int e = 0; e < NEXP; ++e) { tp[e] = s; s += (cnt[e] + 255) >> 8; } tp[NEXP] = s; }
    __syncthreads();
    const int total = tp[NEXP] * 8, cc = (F.bx % 8) * (F.G / 8) + F.bx / 8;
    if (F.tid < 8) { const int i = F.tid, L = i * F.G + cc; int e = -1, pn = 0, ml = 0, pm = 0, cv = 0;
        if (L < total) { e = 0; for (int j = 1; j < NEXP; ++j) e = (L >= tp[j] * 8) ? j : e; const int t0 = tp[e], te = tp[e + 1] - t0, rem = L - t0 * 8; pn = rem / te; ml = rem % te; pm = t0 + ml; cv = cnt[e]; }
        ud[i * 8 + 0] = e; ud[i * 8 + 1] = pn; ud[i * 8 + 2] = ml; ud[i * 8 + 3] = pm; ud[i * 8 + 4] = cv; }
    __syncthreads();
    for (int q = F.tid; q < 8 * 256; q += NTHR) { const int i = q >> 8, r = q & 255; const int e = ud[i * 8]; int d = -1; float w = 0.f;
        if (e >= 0) { const int idx = ud[i * 8 + 2] * 256 + r; if (idx < ud[i * 8 + 4]) { d = fLDEST(F)[e * CAP + idx]; w = fLW(F)[e * CAP + idx]; } }
        rows[q] = d; wts[q] = w; }
    __syncthreads();
    return total;
}

constexpr int N_PHASES = 18;
__global__ void __launch_bounds__(NTHR, 2) fwd_kernel(Params prm) {
    extern __shared__ __attribute__((aligned(16))) unsigned char lds_raw[];
    Frame F0; F0.p = &prm; F0.ws = nullptr; F0.lds = (LAS unsigned char*)lds_raw; F0.ldsg = (char*)lds_raw;
    F0.tid = threadIdx.x; F0.lane = F0.tid & 63; F0.wave = __builtin_amdgcn_readfirstlane(F0.tid >> 6); F0.bx = blockIdx.x; F0.G = gridDim.x;
    if (threadIdx.x < 4) ((LAS unsigned*)(F0.lds + LDS_BARW))[threadIdx.x] = 0u;
    __syncthreads();
    const int lo = prm.ph_lo, hi = prm.ph_hi;
    if (hi - lo > 1) (void)xcd_barrier_post((unsigned*)inp(F0, I_WS), (volatile LAS unsigned*)(F0.lds + LDS_BARW));
#ifndef BG_ON
#define BG_ON 1
#endif
#define DENSE_SHORT(nwg) ((((nwg) + F.G - 1) / F.G) - (((nwg) - F.bx + F.G - 1) / F.G))
#ifndef PH_MASK
#define PH_MASK 0xFFu
#endif
#define IN(k) (lo <= (k) && (k) < hi && ((PH_MASK >> ((k) == 0 ? 0 : (k) == 17 ? 0 : (((k) - 1) % 8))) & 1u))
#define GRIDBAR() do { XcdBarrier bar_; bar_.bar = (unsigned*)inp(F0, I_WS); bar_.x = xb_xcc_id(); bar_.st = (volatile LAS unsigned*)((LAS unsigned char*)lds_raw + LDS_BARW); xcd_barrier(bar_); } while (0)
#define SEAM(k) do { if (IN(k) && (IN((k) + 1) || rep_ + 1 < REPS(k))) GRIDBAR(); } while (0)
#ifndef DUP_PH
#define DUP_PH -1
#endif
#define REPS(k) (((k) == 0 ? 8 : (k) == 17 ? 9 : ((k) - 1) % 8) == DUP_PH ? 2 : 1)
#define PHASE_BEGIN(lv) Frame F; F.p = &prm; F.lds = (LAS unsigned char*)lds_raw; F.ldsg = (char*)lds_raw; F.ws = (unsigned char*)inp(F, I_WS); const int l = launder_i(lv); (void)l; { int tz_ = threadIdx.x; asm volatile("" : "+v"(tz_)); F.tid = tz_; F.lane = tz_ & 63; F.wave = __builtin_amdgcn_readfirstlane(tz_ >> 6); F.bx = launder_i(blockIdx.x); F.G = launder_i(gridDim.x); }
    if (IN(0)) for (int rep_ = 0; rep_ < REPS(0); ++rep_) { PHASE_BEGIN(0) p0_prologue(F); SEAM(0); }
#pragma unroll 1
    for (int l0 = 0; l0 < 2; ++l0) {
        const int pb = 1 + 8 * l0;
        if (IN(pb + 0)) for (int rep_ = 0; rep_ < REPS(pb + 0); ++rep_) { PHASE_BEGIN(l0) n1_phase(F, l, rep_ != 0); if (!rep_ && l == 1) bg_drain(F, P0_CV_L + CV_SMALL); SEAM(pb + 0); }
        if (IN(pb + 1)) for (int rep_ = 0; rep_ < REPS(pb + 1); ++rep_) { PHASE_BEGIN(l0)
            pg8::DenseOrder S; S.init(fHB(F), fWIN(F) + (size_t)l * INW * DM, MTOK / 256, INW / 256, DM * 2, F.G, F.bx, 0);
            pg8::EpiP E{fP(F)};
            pg8::gemm_phase<pg8::EpiP, pg8::DenseOrder, false, false>(F.lds, DM * 2, S, E);
            if (BG_ON && !rep_) bg_fill(F, DENSE_SHORT((MTOK / 256) * (INW / 256)) * 30);
            SEAM(pb + 1);
        }
        if (IN(pb + 2)) for (int rep_ = 0; rep_ < REPS(pb + 2); ++rep_) { PHASE_BEGIN(l0) if (!rep_) qknorm_phase(F, l); lru_units<false>(F, l); if (BG_ON && !rep_) bg_fill(F, F.bx >= 64 ? 4 : 0); SEAM(pb + 2); }
        if (IN(pb + 3)) for (int rep_ = 0; rep_ < REPS(pb + 3); ++rep_) { PHASE_BEGIN(l0) attn_phase(F, l, rep_); if (BG_ON && !rep_ && l == 0) bg_fill(F, (F.bx >= 16 ? 6 : 0) + (F.bx >= 64 ? 6 : 0)); SEAM(pb + 3); }
        if (IN(pb + 4)) for (int rep_ = 0; rep_ < REPS(pb + 4); ++rep_) { PHASE_BEGIN(l0)
            pg8::DenseOrder S; S.init(fMIX(F), fWOUT(F) + (size_t)l * DM * DM, l == 0 ? MTOK / 256 : NB * SEQ / 256, DM / 256, DM * 2, F.G, F.bx, l == 0 ? 0 : 1);
            pg8::EpiResid E{fX(F), fMOD(F) + (size_t)l * 3 * 12288, rep_ ? 0.0f : 1.0f};
            pg8::gemm_phase<pg8::EpiResid, pg8::DenseOrder, false, false>(F.lds, DM * 2, S, E);
            if (BG_ON && !rep_ && l == 0) bg_fill(F, DENSE_SHORT((MTOK / 256) * (DM / 256)) * 28);
            SEAM(pb + 4);
        }
        if (IN(pb + 5)) for (int rep_ = 0; rep_ < REPS(pb + 5); ++rep_) { PHASE_BEGIN(l0) n2_phase(F, l, rep_ != 0); if (!rep_) bg_drain(F, l == 0 ? P0_CV_L : CV_TOTAL); SEAM(pb + 5); }
        if (IN(pb + 6)) for (int rep_ = 0; rep_ < REPS(pb + 6); ++rep_) { PHASE_BEGIN(l0)
            const int mtotal = moe_setup(F, l);
            pg8::MoeOrder S; S.ud = (const LAS int*)(F.lds + LDS_UD); S.rows = (const LAS int*)(F.lds + LDS_ROWS); S.pitch = DM; S.A = (const char*)fHB8(F); S.Bt = (const char*)(fW1(F) + (size_t)l * NEXP * 2048 * DM);
            S.bstride = (size_t)2048 * DM; S.gather = 1;
            pg8::EpiSwiglu E{fACT(F)};
            pg8::gemm_phase<pg8::EpiSwiglu, pg8::MoeOrder, true, true>(F.lds, DM, S, E);
            if (BG_ON && !rep_ && l == 0) { const int cc = (F.bx % 8) * (F.G / 8) + F.bx / 8; bg_fill(F, (((mtotal + F.G - 1) / F.G) - ((mtotal - cc + F.G - 1) / F.G)) * 18); }
            SEAM(pb + 6);
        }
        if (IN(pb + 7)) for (int rep_ = 0; rep_ < REPS(pb + 7); ++rep_) { PHASE_BEGIN(l0)
            const int mtotal = moe_setup(F, l);
            pg8::MoeOrder S; S.ud = (const LAS int*)(F.lds + LDS_UD); S.rows = (const LAS int*)(F.lds + LDS_ROWS); S.pitch = HID; S.A = (const char*)fACT(F); S.Bt = (const char*)(fW2(F) + (size_t)l * NEXP * DM * HID);
            S.bstride = (size_t)DM * HID; S.gather = 0;
            pg8::EpiScatter E{fY(F), (const LAS int*)(F.lds + LDS_ROWS), (const LAS float*)(F.lds + LDS_WTS)};
            pg8::gemm_phase<pg8::EpiScatter, pg8::MoeOrder, false, true>(F.lds, HID, S, E);
            if (BG_ON && !rep_ && l == 0) { const int cc = (F.bx % 8) * (F.G / 8) + F.bx / 8; bg_fill(F, (((mtotal + F.G - 1) / F.G) - ((mtotal - cc + F.G - 1) / F.G)) * 12); }
            SEAM(pb + 7);
        }
    }
    if (IN(17)) for (int rep_ = 0; rep_ < REPS(17); ++rep_) { PHASE_BEGIN(2) fin_phase(F); if (rep_ + 1 < REPS(17)) GRIDBAR(); }
#undef IN
#undef SEAM
}

extern "C" void kernel_launch(void* const* d_in, const int* in_sizes, int n_in, void* d_out, int out_size, void* d_ws, size_t ws_size, hipStream_t stream) {
    static int ok = 0;
    if (ok == 0) {
        if (n_in != 28 || out_size != NB * SEQ * DM || ws_size < WS_END) { fprintf(stderr, "kernel_launch: shape mismatch: n_in %d out %d ws %zu (need %zu)\n", n_in, out_size, ws_size, (size_t)WS_END); ok = -1; return; }
        if (hipFuncSetAttribute((const void*)fwd_kernel, hipFuncAttributeMaxDynamicSharedMemorySize, LDS_BYTES) != hipSuccess) { fprintf(stderr, "kernel_launch: hipFuncSetAttribute failed\n"); ok = -1; return; }
        int per_cu = 0;
        if (hipOccupancyMaxActiveBlocksPerMultiprocessor(&per_cu, (const void*)fwd_kernel, NTHR, LDS_BYTES) != hipSuccess || per_cu < 1) fprintf(stderr, "kernel_launch: occupancy query says %d blocks per CU\n", per_cu);
        (void)hipGetLastError();
        ok = 1;
    }
    if (ok < 0) return;
    (void)hipMemsetAsync((char*)d_ws + WS_CTL, 0, CTL_BYTES, stream);
    Params prm{};
    for (int i = 0; i < 28; ++i) prm.in[i] = (const float*)d_in[i];
    prm.in[I_OUT] = (const float*)d_out; prm.in[I_WS] = (const float*)d_ws;
#if MK_N_LAUNCHES == 1
    prm.ph_lo = 0; prm.ph_hi = N_PHASES;
    hipLaunchKernelGGL(fwd_kernel, dim3(GRID), dim3(NTHR), LDS_BYTES, stream, prm);
#else
    for (int k = 0; k < N_PHASES; ++k) { prm.ph_lo = k; prm.ph_hi = k + 1; hipLaunchKernelGGL(fwd_kernel, dim3(GRID), dim3(NTHR), LDS_BYTES, stream, prm); }
#endif
    const hipError_t le = hipPeekAtLastError();
    if (le != hipSuccess) fprintf(stderr, "kernel_launch: launch failed: %s\n", hipGetErrorName(le));
}
```

```cpp
#include <hip/hip_runtime.h>
#include <stdint.h>
#include <stdio.h>

#ifndef MK_N_LAUNCHES
#define MK_N_LAUNCHES 1
#endif

#define LAS __attribute__((address_space(3)))
typedef unsigned short bf16_t;
typedef short bf16x8 __attribute__((ext_vector_type(8)));
typedef short s16x4 __attribute__((ext_vector_type(4)));
typedef float f32x2 __attribute__((ext_vector_type(2)));
typedef float f32x4 __attribute__((ext_vector_type(4)));
typedef float f32x16 __attribute__((ext_vector_type(16)));
typedef unsigned u32x2 __attribute__((ext_vector_type(2)));
typedef unsigned u32x4 __attribute__((ext_vector_type(4)));

constexpr int DM = 2048, NB = 2, SEQ = 8192, CTXL = 256, TB = SEQ + CTXL, MTOK = NB * TB;
constexpr int INW = 4608;
constexpr int C_QA = 0, C_KA = 512, C_VA = 768, C_UB = 1024, C_GB = 2048, C_QN = 3072, C_KN = 3584, C_VN = 4096;
constexpr int NEXP = 32, HID = 1024, CAP = MTOK, NCHUNK = TB / 64;
constexpr int PMAX = 2 * MTOK + NEXP * 256;
constexpr float EPS = 1e-6f;
constexpr int NTHR = 512;
constexpr int GRID = 256;

constexpr size_t al256(size_t x) { return (x + 255) / 256 * 256; }
constexpr size_t WS_CTL = 0, CTL_BYTES = 65536;
constexpr size_t CTL_CNT = 16384, CTL_Q = 20480;
constexpr size_t WS_MOD = WS_CTL + CTL_BYTES;
constexpr size_t WS_ROPE = WS_MOD + al256((size_t)2 * 3 * 12288 * 4);
constexpr size_t WS_WRT = WS_ROPE + 32768;
constexpr size_t WS_AGG = WS_WRT + al256((size_t)2 * 36 * 2048 * 4);
constexpr size_t WS_LDEST = WS_AGG + al256((size_t)2 * 2 * NCHUNK * 1024 * 8);
constexpr size_t WS_LW = WS_LDEST + al256((size_t)NEXP * CAP * 4);
constexpr size_t WS_X = WS_LW + al256((size_t)NEXP * CAP * 4);
constexpr size_t WS_HB = WS_X + al256((size_t)MTOK * DM * 4);
constexpr size_t WS_P = WS_HB + al256((size_t)MTOK * DM * 2);
constexpr size_t WS_MIX = WS_P + al256((size_t)MTOK * INW * 2);
constexpr size_t WS_ACT = WS_MIX + al256((size_t)MTOK * DM * 2);
constexpr size_t WS_Y = WS_ACT + al256((size_t)PMAX * HID * 2);
constexpr size_t WS_LAB = WS_Y + al256((size_t)MTOK * 2 * DM * 2);
constexpr size_t WS_WIN = WS_LAB + al256((size_t)NB * NCHUNK * 8 * 8 * 8 * 64 * 16);
constexpr size_t WS_WOUT = WS_WIN + al256((size_t)2 * INW * DM * 2);
constexpr size_t WS_LRUW = WS_WOUT + al256((size_t)2 * DM * DM * 2);
constexpr size_t WS_W1 = WS_LRUW + al256((size_t)2 * 2 * 8 * 2 * 128 * 128 * 2);
constexpr size_t WS_W2 = WS_W1 + al256((size_t)2 * NEXP * 2048 * DM);
constexpr size_t WS_END = WS_W2 + al256((size_t)2 * NEXP * DM * HID);

constexpr int LDS_STAGE = 131072;
constexpr int LDS_BARW = LDS_STAGE;
constexpr int LDS_MISC = LDS_STAGE + 64;
constexpr int LDS_UD = LDS_STAGE + 512;
constexpr int LDS_ROWS = LDS_STAGE + 1024;
constexpr int LDS_WTS = LDS_ROWS + 8192;
constexpr int LDS_BYTES = LDS_WTS + 8192;

struct Params { const float* in[30]; int ph_lo, ph_hi; };
enum { I_X = 0, I_C, I_CTX, I_CCTX, I_ADAW, I_ADAB, I_N1G, I_N2G, I_WIN, I_WOUT, I_QNORM, I_KNORM, I_CONVW, I_CONVB, I_LRUWR, I_LRUBR, I_LRUWI, I_LRUBI, I_LAM, I_RPB,
       I_RWG, I_RBG, I_RWE, I_RBE, I_MWG, I_MWU, I_MWD, I_FING, I_OUT, I_WS };

__device__ __forceinline__ unsigned cvt_pk_bf16(float lo, float hi) { unsigned r; asm volatile("v_cvt_pk_bf16_f32 %0, %1, %2" : "=v"(r) : "v"(lo), "v"(hi)); return r; }
__device__ __forceinline__ unsigned cvt_pk_fp8x4(float a, float b, float c, float d) { int w = 0; w = __builtin_amdgcn_cvt_pk_fp8_f32(a, b, w, false); w = __builtin_amdgcn_cvt_pk_fp8_f32(c, d, w, true); return (unsigned)w; }
__device__ __forceinline__ unsigned cvt_pk_fp8x4_sat(float a, float b, float c, float d) {
    return cvt_pk_fp8x4(__builtin_amdgcn_fmed3f(a, -448.f, 448.f), __builtin_amdgcn_fmed3f(b, -448.f, 448.f), __builtin_amdgcn_fmed3f(c, -448.f, 448.f), __builtin_amdgcn_fmed3f(d, -448.f, 448.f)); }
__device__ __forceinline__ float bflo(unsigned w) { return __uint_as_float(w << 16); }
__device__ __forceinline__ float bfhi(unsigned w) { return __uint_as_float(w & 0xffff0000u); }
__device__ __forceinline__ float wave_sum(float v) {
#pragma unroll
    for (int o = 32; o >= 1; o >>= 1) v += __shfl_xor(v, o);
    return v;
}
__device__ __forceinline__ float sigmoidf_(float x) { return __builtin_amdgcn_rcpf(1.0f + __expf(-x)); }
__device__ __forceinline__ float gelu_tanh(float x) { const float z = 0.7978845608028654f * (x + 0.044715f * x * x * x); const float e = __expf(2.0f * z); const float th = 1.0f - 2.0f * __builtin_amdgcn_rcpf(e + 1.0f); return 0.5f * x * (1.0f + th); }

#define XB_TMO      128
#define XB_XCNT(j)  (256  + 64 * (j))
#define XB_XSUB(j)  (1280 + 64 * (j))
#define XB_XGEN(j)  (2304 + 64 * (j))
#define XB_TOP      3328
#define XB_TOPGEN   3392
#define XCD_BAR_WORDS 3456
#define XB_SPIN_CAP (1u << 18)
__device__ __forceinline__ unsigned xb_ld(unsigned* p)              { return __hip_atomic_load(p, __ATOMIC_RELAXED, __HIP_MEMORY_SCOPE_AGENT); }
__device__ __forceinline__ unsigned xb_add(unsigned* p, unsigned v) { return __hip_atomic_fetch_add(p, v, __ATOMIC_RELAXED, __HIP_MEMORY_SCOPE_AGENT); }
__device__ __forceinline__ unsigned xb_xcc_id() { return (unsigned)__builtin_amdgcn_s_getreg((3 << 11) | 20) & 0xFu; }
#define XB_SPIN(cond, bar) do { unsigned _sp = 0; while (cond) { __builtin_amdgcn_s_sleep(1); \
    if ((++_sp & 255u) == 0u) { if (xb_ld(&(bar)[XB_TMO])) break; if (_sp > XB_SPIN_CAP) { atomicAdd(&(bar)[XB_TMO], 1u); break; } } } } while (0)
struct XcdBarrier { unsigned* bar; unsigned x; volatile LAS unsigned* st; };
__device__ __forceinline__ XcdBarrier xcd_barrier_post(unsigned* bar, volatile LAS unsigned* st) {
    XcdBarrier b; b.bar = bar; b.x = xb_xcc_id(); b.st = st;
    if (threadIdx.x == 0) (void)xb_add(&bar[XB_XCNT(b.x)], 1u);
    return b;
}
__device__ __forceinline__ void xcd_barrier_complete(unsigned* bar, unsigned x, unsigned& nloc, unsigned& nx) {
    const unsigned G = gridDim.x * gridDim.y * gridDim.z;
    unsigned sum, cnt, mine, sp = 0u;
    for (;;) {
        sum = 0u; cnt = 0u; mine = 0u;
#pragma unroll
        for (unsigned j = 0; j < 16; ++j) { const unsigned c = xb_ld(&bar[XB_XCNT(j)]); sum += c; cnt += (c > 0u) ? 1u : 0u; mine = (j == x) ? c : mine; }
        if (sum == G) break;
        __builtin_amdgcn_s_sleep(1);
        if ((++sp & 255u) == 0u) { if (xb_ld(&bar[XB_TMO])) break; if (sp > XB_SPIN_CAP) { atomicAdd(&bar[XB_TMO], 1u); break; } }
    }
    nloc = mine > 0u ? mine : 1u; nx = cnt > 0u ? cnt : 1u;
}
__device__ __forceinline__ void xcd_barrier(const XcdBarrier& b) {
    asm volatile("s_waitcnt vmcnt(0)" ::: "memory");
    __syncthreads();
    if (threadIdx.x == 0) {
        unsigned* bar = b.bar;
        __builtin_amdgcn_s_waitcnt(0);
        unsigned nloc = b.st[0], nx = b.st[1];
        if (nloc == 0u) { xcd_barrier_complete(bar, b.x, nloc, nx); b.st[0] = nloc; b.st[1] = nx; }
        const unsigned old = xb_add(&bar[XB_XSUB(b.x)], 1u);
        const unsigned gen = old / nloc;
        if (old + 1u == (gen + 1u) * nloc) {
            __builtin_amdgcn_fence(__ATOMIC_RELEASE, "agent");
            asm volatile("s_waitcnt vmcnt(0)" ::: "memory");
            const unsigned og = xb_add(&bar[XB_TOP], 1u);
            const unsigned tg = og / nx;
            if (og + 1u == (tg + 1u) * nx) xb_add(&bar[XB_TOPGEN], 1u);
            else XB_SPIN(xb_ld(&bar[XB_TOPGEN]) == tg, bar);
            __builtin_amdgcn_fence(__ATOMIC_ACQUIRE, "agent");
            xb_add(&bar[XB_XGEN(b.x)], 1u);
            asm volatile("s_waitcnt vmcnt(0)" ::: "memory");
        } else {
            XB_SPIN(xb_ld(&bar[XB_XGEN(b.x)]) == gen, bar);
            __builtin_amdgcn_fence(__ATOMIC_ACQUIRE, "agent");
            asm volatile("s_waitcnt vmcnt(0)" ::: "memory");
        }
    }
    __syncthreads();
}

namespace pg8 {
constexpr int BM = 256, BK = 64, HALF = 128, HTB = HALF * BK * 2, STAGE_BYTES = 8 * HTB, NXCD = 8, WGM = 8;
__device__ __forceinline__ int lds_byte(int r, int c) { const int st = (r >> 4) * 2 + (c >> 5), rr = r & 15, cc = c & 31, ob = rr * 64 + cc * 2; return st * 1024 + (ob ^ (((ob >> 9) & 1) << 5)); }
__device__ __forceinline__ void stage_rc(int b, int& R, int& C) { const int st = b / 1024, sb = b % 1024, swz = sb ^ (((sb >> 9) & 1) << 5); R = (st >> 1) * 16 + swz / 64; C = (st & 1) * 32 + (swz % 64) / 2; }
__device__ __forceinline__ int perm32(int rho) { const int n = rho >> 4, i = rho & 15; return 8 * (i >> 2) + 4 * n + (i & 3); }

struct Unit { int pm, pn, e, ml, cntv, ui; const char* A; const char* B; };

struct DenseOrder {
    int nM, nN, nwg, G, c, pitch, skip32; const char* A; const char* Bt;
    __device__ void init(const void* A_, const void* Bt_, int nM_, int nN_, int pitch_, int G_, int c_, int skip32_) { A = (const char*)A_; Bt = (const char*)Bt_; nM = nM_; nN = nN_; pitch = pitch_; nwg = nM * nN; G = G_; c = c_; skip32 = skip32_; }
    __device__ __forceinline__ bool next(int i, Unit& u) const {
        const long L = (long)i * G + c; if (L >= nwg) return false;
        int wgid = (int)L; { const int q = nwg / NXCD, r = nwg % NXCD, xcd = wgid % NXCD, off = wgid / NXCD; wgid = (xcd < r ? xcd * (q + 1) : r * (q + 1) + (xcd - r) * q) + off; }
        const int nig = WGM * nN, gid = wgid / nig, fm = gid * WGM, gsz = (nM - fm) < WGM ? (nM - fm) : WGM;
        int pm = fm + ((wgid % nig) % gsz); u.pn = (wgid % nig) / gsz; if (skip32) pm += pm >> 5; u.pm = pm; u.e = 0; u.ml = 0; u.cntv = 0; u.ui = 0;
        u.A = A + (size_t)pm * 256 * pitch; u.B = Bt + (size_t)u.pn * 256 * pitch; return true;
    }
    __device__ __forceinline__ unsigned grow(const Unit&, int) const { return 0u; }
};
struct MoeOrder {
    const LAS int* ud; const LAS int* rows; int pitch; const char* A; const char* Bt; size_t bstride; int gather;
    __device__ __forceinline__ bool next(int i, Unit& u) const {
        if (i >= 8) return false;
        const int e = __builtin_amdgcn_readfirstlane(ud[i * 8 + 0]); if (e < 0) return false;
        u.e = e; u.pn = __builtin_amdgcn_readfirstlane(ud[i * 8 + 1]); u.ml = __builtin_amdgcn_readfirstlane(ud[i * 8 + 2]); u.pm = __builtin_amdgcn_readfirstlane(ud[i * 8 + 3]); u.cntv = __builtin_amdgcn_readfirstlane(ud[i * 8 + 4]); u.ui = i;
        u.A = gather ? A : A + (size_t)u.pm * 256 * pitch; u.B = Bt + (size_t)e * bstride + (size_t)u.pn * 256 * pitch; return true;
    }
    __device__ __forceinline__ unsigned grow(const Unit& u, int r) const { const int d = rows[u.ui * 256 + r]; return d >= 0 ? (unsigned)(d >> 1) : 0u; }
};

typedef int i32x8 __attribute__((ext_vector_type(8)));
typedef int i32x4_ __attribute__((ext_vector_type(4)));
template <class Epi, class Sched, bool GATHER, bool FP8>
__device__ __forceinline__ void gemm_phase(LAS unsigned char* lds, const int pitch, const Sched& S, const Epi& E) {
    int tz = threadIdx.x; asm volatile("" : "+v"(tz));
    const int tid = tz, wid = __builtin_amdgcn_readfirstlane(tid >> 6), lane = tid & 63, wr = wid >> 2, wc = wid & 3, fr = lane & 15, fq = lane >> 4;
    const int nt = pitch / 128;
    unsigned voffA[2], voffB[2];
#pragma unroll
    for (int i = 0; i < 2; ++i) { int R, C; stage_rc(tid * 16 + i * 8192, R, C); const int Rb = Epi::PERM ? ((R & ~31) + perm32(R & 31)) : R;
        voffA[i] = (unsigned)(R * pitch + C * 2); voffB[i] = (unsigned)(Rb * pitch + C * 2); }
    const size_t kstep = (size_t)(BK * 2);
    const size_t hstep = (size_t)HALF * pitch;
    const unsigned ldsw = (unsigned)wid * 1024u;
    const int aoff = lds_byte(wr * 64 + fr, fq * 8), boff = lds_byte(wc * 32 + fr, fq * 8);
#define PG8_SA(b, h) (((b) * 2 + (h)) * HTB)
#define PG8_SB(b, h) ((4 + (b) * 2 + (h)) * HTB)
#define PG8_STAGE(bufoff, gbase, voff) do { _Pragma("unroll") for (int _i = 0; _i < 2; ++_i) \
        __builtin_amdgcn_global_load_lds((const unsigned*)((const char*)(gbase) + (voff)[_i]), (LAS unsigned*)(lds + (bufoff) + ldsw + _i * 8192), 16, 0, 0); } while (0)
#define PG8_STAGE_A(bufoff, gbase, h, nx) do { if (GATHER) { unsigned _v[2]; _v[0] = (nx) ? nG[h][0] : gA[h][0]; _v[1] = (nx) ? nG[h][1] : gA[h][1]; PG8_STAGE(bufoff, gbase, _v); } \
        else PG8_STAGE(bufoff, (gbase) + (h) * hstep, voffA); } while (0)
#define PG8_RD(off) (*(const LAS i32x4_*)(lds + (off)))
#define PG8_LDA(dst, b, h) do { _Pragma("unroll") for (int m = 0; m < 4; ++m) dst[m] = __builtin_shufflevector(PG8_RD(PG8_SA(b, h) + aoff + m * 2048), PG8_RD(PG8_SA(b, h) + aoff + m * 2048 + 1024), 0, 1, 2, 3, 4, 5, 6, 7); } while (0)
#define PG8_LDB(dst, b, h) do { _Pragma("unroll") for (int n = 0; n < 2; ++n) dst[n] = __builtin_shufflevector(PG8_RD(PG8_SB(b, h) + boff + n * 2048), PG8_RD(PG8_SB(b, h) + boff + n * 2048 + 1024), 0, 1, 2, 3, 4, 5, 6, 7); } while (0)
#define PG8_LO(x) __builtin_bit_cast(bf16x8, __builtin_shufflevector(x, x, 0, 1, 2, 3))
#define PG8_HI(x) __builtin_bit_cast(bf16x8, __builtin_shufflevector(x, x, 4, 5, 6, 7))
#define PG8_MMA(ai, bj, At, Bt) do { __builtin_amdgcn_s_setprio(1); \
        if (FP8) { _Pragma("unroll") for (int m = 0; m < 4; ++m) _Pragma("unroll") for (int n = 0; n < 2; ++n) \
            asm volatile("v_mfma_scale_f32_16x16x128_f8f6f4 %0, %1, %2, %0, %3, %3 op_sel_hi:[0,0,0]" : "+v"(acc[ai][bj][m][n]) : "v"(Bt[n]), "v"(At[m]), "v"(sc1)); } \
        else { _Pragma("unroll") for (int m = 0; m < 4; ++m) _Pragma("unroll") for (int n = 0; n < 2; ++n) { \
            acc[ai][bj][m][n] = __builtin_amdgcn_mfma_f32_16x16x32_bf16(PG8_LO(Bt[n]), PG8_LO(At[m]), acc[ai][bj][m][n], 0, 0, 0); \
            acc[ai][bj][m][n] = __builtin_amdgcn_mfma_f32_16x16x32_bf16(PG8_HI(Bt[n]), PG8_HI(At[m]), acc[ai][bj][m][n], 0, 0, 0); } } \
        __builtin_amdgcn_s_setprio(0); } while (0)
#define PG8_WAIT_V(n) asm volatile("s_waitcnt vmcnt(" #n ")" ::: "memory")
#define PG8_WAIT_L(n) asm volatile("s_waitcnt lgkmcnt(" #n ")" ::: "memory")
#define PG8_BAR __builtin_amdgcn_s_barrier()
#define PG8_SCHED __builtin_amdgcn_sched_barrier(0)
    Unit cur, nxt; int ui = 0;
    if (!S.next(0, cur)) return;
    unsigned gA[2][2] = {{0u, 0u}, {0u, 0u}}, nG[2][2] = {{0u, 0u}, {0u, 0u}};
    if (GATHER) {
#pragma unroll
        for (int h = 0; h < 2; ++h)
#pragma unroll
            for (int i = 0; i < 2; ++i) { int R, C; stage_rc(tid * 16 + i * 8192, R, C); gA[h][i] = S.grow(cur, h * HALF + R) * (unsigned)pitch + (unsigned)C * 2u; }
    }
    f32x4 acc[2][2][4][2];
#pragma unroll
    for (int a = 0; a < 2; ++a)
#pragma unroll
        for (int b = 0; b < 2; ++b)
#pragma unroll
            for (int m = 0; m < 4; ++m)
#pragma unroll
                for (int n = 0; n < 2; ++n) acc[a][b][m][n] = (f32x4){0.f, 0.f, 0.f, 0.f};
    i32x8 At[4], B0[2], B1[2];
    int sc1 = 0x7F7F7F7F; asm volatile("" : "+v"(sc1));
    const char* cA = cur.A; const char* cB = cur.B;
    PG8_STAGE(PG8_SB(0, 0), cB, voffB); PG8_STAGE_A(PG8_SA(0, 0), cA, 0, false); PG8_STAGE(PG8_SB(0, 1), cB + hstep, voffB); PG8_STAGE_A(PG8_SA(0, 1), cA, 1, false);
    if (wr == 1) PG8_BAR;
    PG8_WAIT_V(4); PG8_BAR;
    PG8_STAGE(PG8_SB(1, 0), cB + kstep, voffB); PG8_STAGE_A(PG8_SA(1, 0), cA + kstep, 0, false); PG8_STAGE(PG8_SB(1, 1), cB + hstep + kstep, voffB);
    PG8_WAIT_V(6); PG8_BAR;
    for (;;) {
        const bool has_next = S.next(ui + 1, nxt);
        const char* nA = has_next ? nxt.A : cA; const char* nB = has_next ? nxt.B : cB;
        if (GATHER) {
#pragma unroll
            for (int h = 0; h < 2; ++h)
#pragma unroll
                for (int i = 0; i < 2; ++i) { int tg = threadIdx.x; asm volatile("" : "+v"(tg)); int R, C; stage_rc(tg * 16 + i * 8192, R, C); nG[h][i] = has_next ? S.grow(nxt, h * HALF + R) * (unsigned)pitch + (unsigned)C * 2u : gA[h][i]; }
        }
#pragma unroll 1
        for (int t = 0; t < nt; t += 2) {
            const bool last = (t == nt - 2);
            const char* a1 = cA + (size_t)(t + 1) * kstep;
            const char* a2 = last ? nA : cA + (size_t)(t + 2) * kstep; const char* b2 = last ? nB : cB + (size_t)(t + 2) * kstep;
            const char* a3 = a2 + kstep; const char* b3 = b2 + kstep;
            PG8_LDB(B0, 0, 0); PG8_SCHED; PG8_LDA(At, 0, 0); PG8_STAGE_A(PG8_SA(1, 1), a1, 1, false);
            PG8_WAIT_L(8); PG8_BAR; PG8_WAIT_L(0); PG8_MMA(0, 0, At, B0); PG8_BAR; PG8_SCHED;
            PG8_LDB(B1, 0, 1); PG8_STAGE(PG8_SB(0, 0), b2, voffB);
            PG8_BAR; PG8_WAIT_L(0); PG8_MMA(0, 1, At, B1); PG8_BAR;
            PG8_LDA(At, 0, 1); PG8_STAGE_A(PG8_SA(0, 0), a2, 0, last);
            PG8_BAR; PG8_WAIT_L(0); PG8_MMA(1, 0, At, B0); PG8_BAR; PG8_SCHED;
            PG8_STAGE(PG8_SB(0, 1), b2 + hstep, voffB);
            PG8_WAIT_V(6); PG8_BAR; PG8_MMA(1, 1, At, B1); PG8_BAR;
            PG8_LDB(B0, 1, 0); PG8_SCHED; PG8_LDA(At, 1, 0); PG8_STAGE_A(PG8_SA(0, 1), a2, 1, last);
            PG8_WAIT_L(8); PG8_BAR; PG8_WAIT_L(0); PG8_MMA(0, 0, At, B0); PG8_BAR; PG8_SCHED;
            PG8_LDB(B1, 1, 1); PG8_STAGE(PG8_SB(1, 0), b3, voffB);
            PG8_BAR; PG8_WAIT_L(0); PG8_MMA(0, 1, At, B1); PG8_BAR;
            PG8_LDA(At, 1, 1); PG8_STAGE_A(PG8_SA(1, 0), a3, 0, last);
            PG8_BAR; PG8_WAIT_L(0); PG8_MMA(1, 0, At, B0); PG8_BAR; PG8_SCHED;
            PG8_STAGE(PG8_SB(1, 1), b3 + hstep, voffB);
            PG8_WAIT_V(6); PG8_BAR; PG8_MMA(1, 1, At, B1); PG8_BAR;
        }
        if (FP8) asm volatile("s_nop 15\n\ts_nop 15\n\ts_nop 15" ::: "memory");
        { int te = threadIdx.x; asm volatile("" : "+v"(te)); const int le = te & 63; E(acc, cur, wr, wc, le & 15, le >> 4); }
        if (!has_next) break;
#pragma unroll
        for (int a = 0; a < 2; ++a)
#pragma unroll
            for (int b = 0; b < 2; ++b)
#pragma unroll
                for (int m = 0; m < 4; ++m)
#pragma unroll
                    for (int n = 0; n < 2; ++n) acc[a][b][m][n] = (f32x4){0.f, 0.f, 0.f, 0.f};
        cur = nxt; cA = nA; cB = nB; ++ui;
        if (GATHER) {
#pragma unroll
            for (int h = 0; h < 2; ++h)
#pragma unroll
                for (int i = 0; i < 2; ++i) gA[h][i] = nG[h][i];
        }
    }
    PG8_WAIT_V(0);
    if (wr == 0) PG8_BAR;
    PG8_BAR;
#undef PG8_SA
#undef PG8_SB
#undef PG8_STAGE
#undef PG8_STAGE_A
#undef PG8_LDA
#undef PG8_LDB
#undef PG8_MMA
#undef PG8_RD
#undef PG8_LO
#undef PG8_HI
#undef PG8_WAIT_V
#undef PG8_WAIT_L
#undef PG8_BAR
#undef PG8_SCHED
}

struct EpiP {
    static constexpr bool PERM = true;
    bf16_t* O;
    __device__ __forceinline__ void operator()(const f32x4 (&acc)[2][2][4][2], const Unit& u, int wr, int wc, int fr, int fq) const {
        const int row0 = u.pm * BM + wr * 64 + fr, col0 = u.pn * BM + wc * 32 + 8 * fq;
#pragma unroll
        for (int ai = 0; ai < 2; ++ai)
#pragma unroll
            for (int m = 0; m < 4; ++m) { bf16_t* rowp = O + (size_t)(row0 + ai * HALF + m * 16) * INW + col0;
#pragma unroll
                for (int bj = 0; bj < 2; ++bj) { const f32x4 v0 = acc[ai][bj][m][0], v1 = acc[ai][bj][m][1];
                    u32x4 w; w.x = cvt_pk_bf16(v0[0], v0[1]); w.y = cvt_pk_bf16(v0[2], v0[3]); w.z = cvt_pk_bf16(v1[0], v1[1]); w.w = cvt_pk_bf16(v1[2], v1[3]);
                    *(u32x4*)(rowp + bj * HALF) = w; } }
    }
};
struct EpiResid {
    static constexpr bool PERM = true;
    bf16_t* X; const float* mod; float scale;
    __device__ __forceinline__ void operator()(const f32x4 (&acc)[2][2][4][2], const Unit& u, int wr, int wc, int fr, int fq) const {
        const int row0 = u.pm * BM + wr * 64 + fr, col0 = u.pn * BM + wc * 32 + 8 * fq;
        const int sel = (u.pm % 33 == 32) ? 2 : u.pm / 33;
        const float* gv = mod + sel * 12288 + 4096;
        f32x4 g[2][2];
#pragma unroll
        for (int bj = 0; bj < 2; ++bj)
#pragma unroll
            for (int n = 0; n < 2; ++n) g[bj][n] = *(const f32x4*)(gv + col0 + bj * HALF + n * 4) * scale;
#pragma unroll
        for (int ai = 0; ai < 2; ++ai)
#pragma unroll
            for (int m = 0; m < 4; ++m) { bf16_t* rowp = X + (size_t)(row0 + ai * HALF + m * 16) * DM + col0;
#pragma unroll
                for (int bj = 0; bj < 2; ++bj) { u32x4* q = (u32x4*)(rowp + bj * HALF); const u32x4 xw = *q;
                    const f32x4 v0 = (f32x4){bflo(xw.x), bfhi(xw.x), bflo(xw.y), bfhi(xw.y)} + g[bj][0] * acc[ai][bj][m][0], v1 = (f32x4){bflo(xw.z), bfhi(xw.z), bflo(xw.w), bfhi(xw.w)} + g[bj][1] * acc[ai][bj][m][1];
                    u32x4 w; w.x = cvt_pk_bf16(v0[0], v0[1]); w.y = cvt_pk_bf16(v0[2], v0[3]); w.z = cvt_pk_bf16(v1[0], v1[1]); w.w = cvt_pk_bf16(v1[2], v1[3]); *q = w; } }
    }
};
struct EpiSwiglu {
    static constexpr bool PERM = true;
    unsigned char* ACT;
    __device__ __forceinline__ void operator()(const f32x4 (&acc)[2][2][4][2], const Unit& u, int wr, int wc, int fr, int fq) const {
        const int row0 = u.pm * BM + wr * 64 + fr, col0 = u.pn * HALF + wc * 32 + 8 * fq;
#pragma unroll
        for (int ai = 0; ai < 2; ++ai)
#pragma unroll
            for (int m = 0; m < 4; ++m) { unsigned char* rowp = ACT + (size_t)(row0 + ai * HALF + m * 16) * HID + col0;
                float o[8];
#pragma unroll
                for (int n = 0; n < 2; ++n)
#pragma unroll
                    for (int j = 0; j < 4; ++j) { const float g = acc[ai][0][m][n][j] * 0.00390625f, up = acc[ai][1][m][n][j] * 0.00390625f; o[n * 4 + j] = g * sigmoidf_(g) * up; }
                u32x2 w; w.x = cvt_pk_fp8x4_sat(o[0], o[1], o[2], o[3]); w.y = cvt_pk_fp8x4_sat(o[4], o[5], o[6], o[7]);
                *(u32x2*)rowp = w; }
    }
};
struct EpiScatter {
    static constexpr bool PERM = true;
    unsigned char* Y; const LAS int* rows; const LAS float* wts;
    __device__ __forceinline__ void operator()(const f32x4 (&acc)[2][2][4][2], const Unit& u, int wr, int wc, int fr, int fq) const {
        const int r0 = wr * 64 + fr, col0 = u.pn * BM + wc * 32 + 8 * fq;
#pragma unroll
        for (int ai = 0; ai < 2; ++ai)
#pragma unroll
            for (int m = 0; m < 4; ++m) { const int r = r0 + ai * HALF + m * 16; const int dest = rows[u.ui * 256 + r];
                if (dest >= 0) { const float w_ = wts[u.ui * 256 + r] * 0.0625f; unsigned char* rowp = Y + (size_t)dest * DM + col0;
#pragma unroll
                    for (int bj = 0; bj < 2; ++bj) { const f32x4 v0 = acc[ai][bj][m][0] * w_, v1 = acc[ai][bj][m][1] * w_;
                        u32x2 w; w.x = cvt_pk_fp8x4_sat(v0[0], v0[1], v0[2], v0[3]); w.y = cvt_pk_fp8x4_sat(v1[0], v1[1], v1[2], v1[3]);
                        *(u32x2*)(rowp + bj * HALF) = w; } } }
    }
};
}

namespace att {
constexpr int D = 128, NW = 8, QBLK = 32, KVBLK = 64;
constexpr float SCALE = 0.088388347648318440f;
constexpr float THR = 8.f;
constexpr int LDP = INW;
constexpr int LDO = DM;
constexpr size_t SHM_V = KVBLK * D * 2, SHM_K = KVBLK * D * 2, SHM_ATTN = 2 * SHM_V + 2 * SHM_K + NW * 64 * 4;
constexpr int RPB_OFF = (int)SHM_ATTN;
#define KSWZ(row, colB) ((row) * 256 + ((colB) ^ (((row) & 7) << 4)))
#define SBAR() __builtin_amdgcn_sched_barrier(0)
__device__ __forceinline__ int crow(int r, int hi) { return (r & 3) + 8 * (r >> 2) + 4 * hi; }

__device__ __forceinline__ void partialSM(f32x16& p0, f32x16& p1, float& m_reg, float& mn, float& alpha) {
  constexpr float C = SCALE * 1.4426950408889634f;
  float pmax = p0[0]; for (int r = 1; r < 16; ++r) pmax = fmaxf(pmax, p0[r]); for (int r = 0; r < 16; ++r) pmax = fmaxf(pmax, p1[r]);
  { auto rr = __builtin_amdgcn_permlane32_swap(__float_as_uint(pmax), __float_as_uint(pmax), false, false);
    pmax = fmaxf(__uint_as_float(rr[0]), __uint_as_float(rr[1])); }
  if (__builtin_expect(__all(pmax - m_reg <= THR / SCALE), 1)) { mn = m_reg; alpha = 1.f; }
  else { mn = fmaxf(m_reg, pmax); alpha = __builtin_amdgcn_exp2f((m_reg - mn) * C); m_reg = mn; }
  float mnC = -mn * C;
  for (int r = 0; r < 16; ++r) p0[r] = fmaf(p0[r], C, mnC); for (int r = 0; r < 16; ++r) p1[r] = fmaf(p1[r], C, mnC);
  for (int r = 0; r < 16; ++r) p0[r] = __builtin_amdgcn_exp2f(p0[r]);
}
__device__ __forceinline__ void finishSM(f32x16& p0, f32x16& p1, float alpha, float& l_reg, bf16x8& pa0, bf16x8& pa1, bf16x8& pa2, bf16x8& pa3) {
  for (int r = 0; r < 16; ++r) p1[r] = __builtin_amdgcn_exp2f(p1[r]);
  float ps = 0; for (int r = 0; r < 16; ++r) ps += p0[r]; for (int r = 0; r < 16; ++r) ps += p1[r];
  { auto rr = __builtin_amdgcn_permlane32_swap(__float_as_uint(ps), __float_as_uint(ps), false, false);
    ps = __uint_as_float(rr[0]) + __uint_as_float(rr[1]); }
  l_reg = l_reg * alpha + ps;
#define PK4(P, BASE, OUT) do { unsigned a0 = cvt_pk_bf16(P[BASE + 0], P[BASE + 1]), a1 = cvt_pk_bf16(P[BASE + 2], P[BASE + 3]);   \
    unsigned b0 = cvt_pk_bf16(P[BASE + 4], P[BASE + 5]), b1 = cvt_pk_bf16(P[BASE + 6], P[BASE + 7]);                              \
    auto r0 = __builtin_amdgcn_permlane32_swap(a0, b0, false, false); auto r1 = __builtin_amdgcn_permlane32_swap(a1, b1, false, false); \
    u32x4 w = {r0[0], r1[0], r0[1], r1[1]}; OUT = *reinterpret_cast<bf16x8*>(&w); } while (0)
  PK4(p0, 0, pa0); PK4(p0, 8, pa1); PK4(p1, 0, pa2); PK4(p1, 8, pa3);
#undef PK4
}
__device__ __forceinline__ void qkt(f32x16& p0, f32x16& p1, const bf16_t* Ks, const bf16x8* qr, int r32, int hi) {
  p0 = f32x16{}; p1 = f32x16{};
  for (int d0 = 0; d0 < 8; ++d0) { int cb = (d0 * 16 + hi * 8) * 2;
    bf16x8 b0 = *reinterpret_cast<const bf16x8*>((const char*)Ks + KSWZ(r32, cb));
    bf16x8 b1 = *reinterpret_cast<const bf16x8*>((const char*)Ks + KSWZ(32 + r32, cb));
    p0 = __builtin_amdgcn_mfma_f32_32x32x16_bf16(b0, qr[d0], p0, 0, 0, 0);
    p1 = __builtin_amdgcn_mfma_f32_32x32x16_bf16(b1, qr[d0], p1, 0, 0, 0); }
}
__device__ __forceinline__ int v_st(int k, int c) { const int kk = (k & ~0xC) | ((k & 4) << 1) | ((k & 8) >> 1); return ((kk >> 3) * 4 + (c >> 5)) * 512 + ((kk & 7) * 32 + (c & 31)) * 2; }
__device__ __forceinline__ int v_rd_base(int lane) { return ((lane & 3) << 3) | (((lane >> 2) & 3) << 6) | (((lane >> 4) & 1) << 5) | (((lane >> 5) & 1) << 8); }
constexpr int v_rd_off(int d0, int ks, int half) { return d0 * 512 + ks * 4096 + half * 2048; }
template <int OFF> __device__ __forceinline__ s16x4 tr_read(int vb) {
  s16x4 r; asm volatile("ds_read_b64_tr_b16 %0, %1 offset:%2" : "=&v"(r) : "v"(vb), "i"(OFF) : "memory"); return r;
}
template <int D0> __device__ __forceinline__ void pv_one(f32x16& od, int vb, bf16x8 pa0, bf16x8 pa1, bf16x8 pa2, bf16x8 pa3) {
  const s16x4 l0 = tr_read<v_rd_off(D0, 0, 0)>(vb), h0 = tr_read<v_rd_off(D0, 0, 1)>(vb), l1 = tr_read<v_rd_off(D0, 1, 0)>(vb), h1 = tr_read<v_rd_off(D0, 1, 1)>(vb);
  const s16x4 l2 = tr_read<v_rd_off(D0, 2, 0)>(vb), h2 = tr_read<v_rd_off(D0, 2, 1)>(vb), l3 = tr_read<v_rd_off(D0, 3, 0)>(vb), h3 = tr_read<v_rd_off(D0, 3, 1)>(vb);
  asm volatile("s_waitcnt lgkmcnt(0)" ::: "memory"); SBAR();
#define PK(L, H) (bf16x8){L[0], L[1], L[2], L[3], H[0], H[1], H[2], H[3]}
  od = __builtin_amdgcn_mfma_f32_32x32x16_bf16(pa0, PK(l0, h0), od, 0, 0, 0);
  od = __builtin_amdgcn_mfma_f32_32x32x16_bf16(pa1, PK(l1, h1), od, 0, 0, 0);
  od = __builtin_amdgcn_mfma_f32_32x32x16_bf16(pa2, PK(l2, h2), od, 0, 0, 0);
  od = __builtin_amdgcn_mfma_f32_32x32x16_bf16(pa3, PK(l3, h3), od, 0, 0, 0);
#undef PK
}
__device__ __forceinline__ void pv_d0(f32x16* o, int vb, bf16x8 pa0, bf16x8 pa1, bf16x8 pa2, bf16x8 pa3) {
  pv_one<0>(o[0], vb, pa0, pa1, pa2, pa3); pv_one<1>(o[1], vb, pa0, pa1, pa2, pa3); pv_one<2>(o[2], vb, pa0, pa1, pa2, pa3); pv_one<3>(o[3], vb, pa0, pa1, pa2, pa3);
}

struct Job { const bf16_t* Q; const bf16_t* K; const bf16_t* V; bf16_t* O; int nt, mode, row_a, row_b, gr0, kstart; };
__device__ __forceinline__ int ufy(int v) { v = __builtin_amdgcn_readfirstlane(v); asm volatile("" : "+s"(v)); return v; }
template <class T> __device__ __forceinline__ T* ufyp(T* q) { unsigned long long a = (unsigned long long)q; unsigned lo = __builtin_amdgcn_readfirstlane((unsigned)a), hi = __builtin_amdgcn_readfirstlane((unsigned)(a >> 32)); asm volatile("" : "+s"(lo), "+s"(hi)); return (T*)(((unsigned long long)hi << 32) | lo); }
__device__ __forceinline__ void opaque(Job& J) { J.Q = ufyp(J.Q); J.K = ufyp(J.K); J.V = ufyp(J.V); J.O = ufyp(J.O); J.nt = ufy(J.nt); J.row_a = ufy(J.row_a); J.row_b = ufy(J.row_b); J.gr0 = ufy(J.gr0); J.kstart = ufy(J.kstart); }

template <int MODE> __device__ __forceinline__ void na_mask(f32x16& p0, f32x16& p1, const Job& J, int t, int wid, int r32, int hi, const float* rpb) {
  if (MODE == 1 && t >= 4) {
    const int r = J.gr0 + (wid >> 1), j = ((wid & 1) << 5) + r32, kr = J.kstart + t - 4;
    const int rs = min(max(r - 4, 0), 120), cs = min(max(j - 8, 0), 48);
    const bool rowok = (kr >= rs) && (kr < rs + 8);
    const int base = (kr - r + 7) * 31 - j + 15;
#pragma unroll
    for (int q = 0; q < 16; ++q) {
      const int c0 = crow(q, hi), c1 = c0 + 32;
      const bool in0 = rowok && ((unsigned)(c0 - cs) < 16u), in1 = rowok && ((unsigned)(c1 - cs) < 16u);
      const float b0 = rpb[in0 ? base + c0 : 0], b1 = rpb[in1 ? base + c1 : 0];
      p0[q] = in0 ? p0[q] + b0 : -1e30f; p1[q] = in1 ? p1[q] + b1 : -1e30f;
    }
  }
}

template <int MODE> __device__ __forceinline__ void attn_unit(const Job& J, char* lds) {
  int tz = threadIdx.x; asm volatile("" : "+v"(tz));
  const int tid = tz, wid = tid >> 6, lane = tid & 63, r32 = lane & 31, hi = lane >> 5;
  bf16_t* V_lds = (bf16_t*)lds; bf16_t* K_lds = (bf16_t*)(lds + 2 * SHM_V);
  float* ws = (float*)(lds + 2 * SHM_V + 2 * SHM_K) + wid * 64; float* li_l = ws; float* al_l = ws + 32;
  const float* rpb = (const float*)(lds + RPB_OFF);
  float m_reg = -1e30f, l_reg = 0; f32x16 o[4] = {}; bf16x8 qr[8];
  const bf16_t* Qw = J.Q + (long)(wid * QBLK + r32) * LDP + hi * 8;
#pragma unroll
  for (int d0 = 0; d0 < 8; ++d0) qr[d0] = *reinterpret_cast<const bf16x8*>(Qw + d0 * 16);
  const int sr = tid >> 4, sc = (tid & 15) * 8, vst0 = v_st(sr, sc), vst1 = v_st(32 + sr, sc);
  const int vb0 = (int)(uintptr_t)V_lds + v_rd_base(lane);
  struct { bf16x8 vs0, vs1, ks0, ks1; } sr_[2];
#define TROW(t) ((MODE == 1 && (t) >= 4) ? (J.row_b + 64 * ((t) - 4)) : (J.row_a + 64 * (t)))
#define SLOAD(i, t) do { const long _r0 = (long)(TROW(t) + sr) * LDP + sc; sr_[i].vs0 = *reinterpret_cast<const bf16x8*>(J.V + _r0); sr_[i].vs1 = *reinterpret_cast<const bf16x8*>(J.V + _r0 + 32L * LDP); \
    sr_[i].ks0 = *reinterpret_cast<const bf16x8*>(J.K + _r0); sr_[i].ks1 = *reinterpret_cast<const bf16x8*>(J.K + _r0 + 32L * LDP); } while (0)
#define SWRITE(b, i) do { *(bf16x8*)((char*)V_lds + (b) * SHM_V + vst0) = sr_[i].vs0;          \
    *(bf16x8*)((char*)V_lds + (b) * SHM_V + vst1) = sr_[i].vs1; int kc = sc * 2;               \
    *(bf16x8*)((char*)K_lds + (b) * SHM_K + KSWZ(sr, kc)) = sr_[i].ks0;                       \
    *(bf16x8*)((char*)K_lds + (b) * SHM_K + KSWZ(32 + sr, kc)) = sr_[i].ks1; } while (0)
#define SWAIT() asm volatile("s_waitcnt vmcnt(4)" ::: "memory")
#define RESC(a) do { if (__any((a) < 1.f)) { if (hi == 0) al_l[r32] = (a); asm volatile("s_waitcnt lgkmcnt(0)" ::: "memory"); \
    for (int d = 0; d < 4; ++d) for (int r = 0; r < 16; ++r) o[d][r] *= al_l[crow(r, hi)]; } } while (0)
  f32x16 pA0, pA1, pB0, pB1; float mnA, mnB, alA, alB; bf16x8 pa0, pa1, pa2, pa3; int NT = J.nt; asm volatile("" : "+s"(NT));
  constexpr int SE = 0, SO = 1;
  SLOAD(SE, 0); asm volatile("s_waitcnt vmcnt(0)" ::: "memory"); SWRITE(0, SE); __syncthreads();
  qkt(pA0, pA1, K_lds, qr, r32, hi); na_mask<MODE>(pA0, pA1, J, 0, wid, r32, hi, rpb); partialSM(pA0, pA1, m_reg, mnA, alA);
  SLOAD(SO, 1); if (2 < NT) SLOAD(SE, 2);
  SWAIT(); SWRITE(1, SO); __syncthreads();
#pragma unroll 1
  for (int j = 1; j + 1 < NT; j += 2) {
    SBAR(); qkt(pB0, pB1, (bf16_t*)((char*)K_lds + SHM_K), qr, r32, hi);
    finishSM(pA0, pA1, alA, l_reg, pa0, pa1, pa2, pa3); SBAR();
    SLOAD(SO, min(j + 2, NT - 1)); SBAR();
    pv_d0(o, vb0, pa0, pa1, pa2, pa3); na_mask<MODE>(pB0, pB1, J, j, wid, r32, hi, rpb); partialSM(pB0, pB1, m_reg, mnB, alB);
    __syncthreads(); SWAIT(); SWRITE(0, SE);
    RESC(alB); __syncthreads();
    SBAR(); qkt(pA0, pA1, K_lds, qr, r32, hi);
    finishSM(pB0, pB1, alB, l_reg, pa0, pa1, pa2, pa3); SBAR();
    if (j + 3 < NT) SLOAD(SE, j + 3); SBAR();
    pv_d0(o, vb0 + (int)SHM_V, pa0, pa1, pa2, pa3); na_mask<MODE>(pA0, pA1, J, j + 1, wid, r32, hi, rpb); partialSM(pA0, pA1, m_reg, mnA, alA);
    __syncthreads(); SWAIT(); SWRITE(1, SO);
    RESC(alA); __syncthreads();
  }
  SBAR(); qkt(pB0, pB1, (bf16_t*)((char*)K_lds + SHM_K), qr, r32, hi);
  finishSM(pA0, pA1, alA, l_reg, pa0, pa1, pa2, pa3); SBAR();
  pv_d0(o, vb0, pa0, pa1, pa2, pa3); na_mask<MODE>(pB0, pB1, J, NT - 1, wid, r32, hi, rpb); partialSM(pB0, pB1, m_reg, mnB, alB);
  __syncthreads(); RESC(alB);
  finishSM(pB0, pB1, alB, l_reg, pa0, pa1, pa2, pa3); SBAR();
  pv_d0(o, vb0 + (int)SHM_V, pa0, pa1, pa2, pa3);
  if (hi == 0) li_l[r32] = l_reg; asm volatile("s_waitcnt lgkmcnt(0)" ::: "memory");
  float rli[16];
#pragma unroll
  for (int r = 0; r < 16; ++r) rli[r] = __builtin_amdgcn_rcpf(li_l[crow(r, hi)]);
  bf16_t* Ow = J.O + (long)(wid * QBLK) * LDO;
#pragma unroll
  for (int r = 0; r < 16; ++r) { int orow = crow(r, hi);
    for (int d0 = 0; d0 < 4; ++d0) Ow[(long)orow * LDO + d0 * 32 + r32] = (bf16_t)(cvt_pk_bf16(o[d0][r] * rli[r], 0.f) & 0xffffu); }
  asm volatile("s_waitcnt vmcnt(0)" ::: "memory");
  __syncthreads();
#undef TROW
#undef SLOAD
#undef SWRITE
#undef SWAIT
#undef RESC
}

__device__ __forceinline__ void attn_unit_na(const Job& J, char* lds) {
  int tz = threadIdx.x; asm volatile("" : "+v"(tz));
  const int tid = tz, wid = tid >> 6, lane = tid & 63, r32 = lane & 31, hi = lane >> 5;
  bf16_t* V_lds = (bf16_t*)lds; bf16_t* K_lds = (bf16_t*)(lds + 2 * SHM_V);
  float* ws = (float*)(lds + 2 * SHM_V + 2 * SHM_K) + wid * 64; float* li_l = ws; float* al_l = ws + 32;
  const float* rpb = (const float*)(lds + RPB_OFF);
  float m_reg = -1e30f, l_reg = 0; f32x16 o[4] = {}; bf16x8 qr[8];
  const bf16_t* Qw = J.Q + (long)(wid * QBLK + r32) * LDP + hi * 8;
#pragma unroll
  for (int d0 = 0; d0 < 8; ++d0) qr[d0] = *reinterpret_cast<const bf16x8*>(Qw + d0 * 16);
  const int sr = tid >> 4, sc = (tid & 15) * 8, vst0 = v_st(sr, sc), vst1 = v_st(32 + sr, sc);
  const int vb0 = (int)(uintptr_t)V_lds + v_rd_base(lane);
  bf16x8 vs0, vs1, ks0, ks1;
#define TROW(t) (((t) >= 4) ? (J.row_b + 64 * ((t) - 4)) : (J.row_a + 64 * (t)))
#define SLOAD(t) do { const long _r0 = (long)(TROW(t) + sr) * LDP + sc; vs0 = *reinterpret_cast<const bf16x8*>(J.V + _r0); vs1 = *reinterpret_cast<const bf16x8*>(J.V + _r0 + 32L * LDP); \
    ks0 = *reinterpret_cast<const bf16x8*>(J.K + _r0); ks1 = *reinterpret_cast<const bf16x8*>(J.K + _r0 + 32L * LDP); } while (0)
#define SWRITE(b) do { *(bf16x8*)((char*)V_lds + (b) * SHM_V + vst0) = vs0; *(bf16x8*)((char*)V_lds + (b) * SHM_V + vst1) = vs1; int kc = sc * 2;               \
    *(bf16x8*)((char*)K_lds + (b) * SHM_K + KSWZ(sr, kc)) = ks0; *(bf16x8*)((char*)K_lds + (b) * SHM_K + KSWZ(32 + sr, kc)) = ks1; } while (0)
  SLOAD(0); asm volatile("s_waitcnt vmcnt(0)" ::: "memory"); SWRITE(0); __syncthreads();
  const int NT = J.nt;
#pragma unroll 1
  for (int t = 0; t < NT; ++t) {
    const int bsel = t & 1;
    if (t + 1 < NT) SLOAD(t + 1);
    bool active = true;
    if (t >= 4) { const int r = J.gr0 + (wid >> 1), kr = J.kstart + t - 4, rs = min(max(r - 4, 0), 120); active = (kr >= rs) && (kr < rs + 8); }
    if (active) {
    f32x16 p0, p1; float mn, al; bf16x8 pa0, pa1, pa2, pa3;
    qkt(p0, p1, (bf16_t*)((char*)K_lds + bsel * SHM_K), qr, r32, hi);
    na_mask<1>(p0, p1, J, t, wid, r32, hi, rpb);
    partialSM(p0, p1, m_reg, mn, al);
    if (__any(al < 1.f)) { if (hi == 0) al_l[r32] = al; asm volatile("s_waitcnt lgkmcnt(0)" ::: "memory");
      for (int d = 0; d < 4; ++d) for (int r = 0; r < 16; ++r) o[d][r] *= al_l[crow(r, hi)]; }
    finishSM(p0, p1, al, l_reg, pa0, pa1, pa2, pa3); SBAR();
    pv_d0(o, vb0 + bsel * (int)SHM_V, pa0, pa1, pa2, pa3);
    }
    if (t + 1 < NT) { asm volatile("s_waitcnt vmcnt(0)" ::: "memory"); SWRITE(bsel ^ 1); }
    __syncthreads();
  }
  if (hi == 0) li_l[r32] = l_reg; asm volatile("s_waitcnt lgkmcnt(0)" ::: "memory");
  float rli[16];
#pragma unroll
  for (int r = 0; r < 16; ++r) rli[r] = __builtin_amdgcn_rcpf(li_l[crow(r, hi)]);
  bf16_t* Ow = J.O + (long)(wid * QBLK) * LDO;
#pragma unroll
  for (int r = 0; r < 16; ++r) { int orow = crow(r, hi);
    for (int d0 = 0; d0 < 4; ++d0) Ow[(long)orow * LDO + d0 * 32 + r32] = (bf16_t)(cvt_pk_bf16(o[d0][r] * rli[r], 0.f) & 0xffffu); }
  asm volatile("s_waitcnt vmcnt(0)" ::: "memory");
  __syncthreads();
#undef TROW
#undef SLOAD
#undef SWRITE
}
}

struct Frame {
    const Params* p; unsigned char* ws; LAS unsigned char* lds; char* ldsg; int tid, lane, wave, bx, G;
};
__device__ __forceinline__ const float* inp(const Frame& F, int i) { i = __builtin_amdgcn_readfirstlane(i); asm volatile("" : "+s"(i)); return F.p->in[i]; }
__device__ __forceinline__ unsigned char* launder_ws(unsigned char* q) { unsigned long long a = (unsigned long long)q; unsigned lo = (unsigned)a, hi = (unsigned)(a >> 32); asm volatile("" : "+s"(lo), "+s"(hi)); return (unsigned char*)(((unsigned long long)hi << 32) | lo); }
__device__ __forceinline__ int launder_i(int v) { asm volatile("" : "+s"(v)); return v; }
#define FACC(name, type, off) __device__ __forceinline__ type* name(const Frame& F) { return (type*)(F.ws + (off)); }
FACC(fMOD, float, WS_MOD) FACC(fROPE, float, WS_ROPE) FACC(fWRT, float, WS_WRT) FACC(fAGG, f32x2, WS_AGG) FACC(fLDEST, int, WS_LDEST) FACC(fLW, float, WS_LW) FACC(fX, bf16_t, WS_X)
FACC(fHB, bf16_t, WS_HB) FACC(fHB8, unsigned char, WS_HB) FACC(fP, bf16_t, WS_P) FACC(fMIX, bf16_t, WS_MIX) FACC(fACT, unsigned char, WS_ACT) FACC(fY, unsigned char, WS_Y) FACC(fWIN, bf16_t, WS_WIN) FACC(fWOUT, bf16_t, WS_WOUT)
FACC(fLAB, u32x4, WS_LAB) FACC(fLRUW, bf16_t, WS_LRUW) FACC(fW1, unsigned char, WS_W1) FACC(fW2, unsigned char, WS_W2) FACC(fCNT, int, WS_CTL + CTL_CNT)

constexpr int P0_CV_L = 26304;
struct CvtDesc { const float* src; void* dst; int ldsrc, lddst, f8; };
__device__ __forceinline__ CvtDesc cvt_desc(const Frame& F, int l, int r) {
    CvtDesc d; d.f8 = 0;
    if (r < 1152) { const int kt = r / 72, nt = r % 72; d.src = inp(F, I_WIN) + ((size_t)l * 2048 + kt * 128) * INW + nt * 64; d.ldsrc = INW; d.dst = fWIN(F) + ((size_t)l * INW + nt * 64) * DM + kt * 128; d.lddst = DM; }
    else if (r < 1664) { r -= 1152; const int kt = r / 32, nt = r % 32; d.src = inp(F, I_WOUT) + ((size_t)l * 2048 + kt * 128) * DM + nt * 64; d.ldsrc = DM; d.dst = fWOUT(F) + ((size_t)l * DM + nt * 64) * DM + kt * 128; d.lddst = DM; }
    else if (r < 1664 + 16384) { r -= 1664; const int up = r >= 8192; r -= up * 8192; const int e = r >> 8, t = r & 255, kt = t >> 4, nt = t & 15, n0 = nt * 64;
        d.src = inp(F, up ? I_MWU : I_MWG) + ((size_t)(l * NEXP + e) * 2048 + kt * 128) * HID + n0; d.ldsrc = HID;
        const int drow = 256 * (n0 >> 7) + (n0 & 127) + up * 128; d.dst = fW1(F) + ((size_t)(l * NEXP + e) * 2048 + drow) * DM + kt * 128; d.lddst = DM; d.f8 = 1; }
    else if (r < 1664 + 24576) { r -= 1664 + 16384; const int e = r >> 8, t = r & 255, kt = t >> 5, nt = t & 31;
        d.src = inp(F, I_MWD) + ((size_t)(l * NEXP + e) * HID + kt * 128) * DM + nt * 64; d.ldsrc = DM; d.dst = fW2(F) + ((size_t)(l * NEXP + e) * DM + nt * 64) * HID + kt * 128; d.lddst = HID; d.f8 = 1; }
    else { r -= 1664 + 24576; const int mat = r >> 1, nt = r & 1, gate = mat >> 4, dd = (mat >> 3) & 1, n = mat & 7;
        d.src = inp(F, gate ? I_LRUWI : I_LRUWR) + ((size_t)((l * 2 + dd) * 8 + n) * 128) * 128 + nt * 64; d.ldsrc = 128;
        d.dst = fLRUW(F) + ((size_t)(((l * 2 + dd) * 8 + n) * 2 + gate) * 128 + nt * 64) * 128; d.lddst = 128; }
    return d;
}
__device__ __forceinline__ CvtDesc cvt_desc_g(const Frame& F, int g) {
    const int l = g >= P0_CV_L ? 1 : 0, sidx = g - l * P0_CV_L;
    const int r = sidx < 1664 ? sidx : (sidx < 1728 ? 26240 + (sidx - 1664) : sidx - 64);
    return cvt_desc(F, l, r);
}
__device__ __forceinline__ void cvt_run(const Frame& F, int first, int stride, int end, LAS float* T) {
    const int tid = F.tid, kk = tid >> 4, n4 = tid & 15, wv = tid >> 6, lane = tid & 63;
    if (first >= end) return;
    f32x4 v[4]; CvtDesc d = cvt_desc_g(F, first);
#pragma unroll
    for (int q = 0; q < 4; ++q) v[q] = __builtin_nontemporal_load((const f32x4*)(d.src + (size_t)(q * 32 + kk) * d.ldsrc + n4 * 4));
    int buf = 0;
#pragma unroll 1
    for (int r = first; r < end; r += stride, buf ^= 1) {
        LAS float* Tb = T + buf * (128 * 65);
#pragma unroll
        for (int q = 0; q < 4; ++q) { const int kr = q * 32 + kk; LAS float* w = Tb + kr * 65 + ((n4 * 4) ^ ((kr >> 4) << 2)); w[0] = v[q][0]; w[1] = v[q][1]; w[2] = v[q][2]; w[3] = v[q][3]; }
        const CvtDesc dc = d;
        if (r + stride < end) { d = cvt_desc_g(F, r + stride);
#pragma unroll
            for (int q = 0; q < 4; ++q) v[q] = __builtin_nontemporal_load((const f32x4*)(d.src + (size_t)(q * 32 + kk) * d.ldsrc + n4 * 4)); }
        __syncthreads();
        if (dc.f8) {
            const int nn = wv * 8 + (lane >> 3), k0 = (lane & 7) * 16; float x[16];
#pragma unroll
            for (int j = 0; j < 16; ++j) x[j] = Tb[(k0 + j) * 65 + (nn ^ ((k0 >> 4) << 2))] * 256.0f;
            *(u32x4*)((unsigned char*)dc.dst + (size_t)nn * dc.lddst + k0) = (u32x4){cvt_pk_fp8x4(x[0], x[1], x[2], x[3]), cvt_pk_fp8x4(x[4], x[5], x[6], x[7]), cvt_pk_fp8x4(x[8], x[9], x[10], x[11]), cvt_pk_fp8x4(x[12], x[13], x[14], x[15])};
        } else {
            const int rr = lane >> 4, k0 = (lane & 15) * 8;
#pragma unroll
            for (int i = 0; i < 2; ++i) { const int nn = wv * 8 + i * 4 + rr; float x[8];
#pragma unroll
                for (int j = 0; j < 8; ++j) x[j] = Tb[(k0 + j) * 65 + (nn ^ ((k0 >> 4) << 2))];
                *(u32x4*)((bf16_t*)dc.dst + (size_t)nn * dc.lddst + k0) = (u32x4){cvt_pk_bf16(x[0], x[1]), cvt_pk_bf16(x[2], x[3]), cvt_pk_bf16(x[4], x[5]), cvt_pk_bf16(x[6], x[7])}; }
        }
    }
    __syncthreads();
}
constexpr int CV_SMALL = 1728, CV_TOTAL = 2 * P0_CV_L;
constexpr int BG_T = 49152;
__device__ __forceinline__ int bg_claim(const Frame& F, int n) {
    LAS int* slot = (LAS int*)(F.lds + LDS_MISC + 256);
    __syncthreads();
    if (F.tid == 0) *slot = __hip_atomic_fetch_add((int*)(F.ws + WS_CTL + CTL_Q), n, __ATOMIC_RELAXED, __HIP_MEMORY_SCOPE_AGENT);
    __syncthreads();
    return *slot;
}
__device__ __forceinline__ void bg_fill(const Frame& F, int quota) {
    if (quota <= 0) return;
    const int g0 = bg_claim(F, quota); if (g0 >= CV_TOTAL) return;
    cvt_run(F, g0, 1, min(g0 + quota, CV_TOTAL), (LAS float*)(F.lds + BG_T));
}
__device__ __forceinline__ void bg_drain(const Frame& F, int target) {
    for (;;) { const int g0 = bg_claim(F, 6); if (g0 >= CV_TOTAL) break; cvt_run(F, g0, 1, min(g0 + 6, CV_TOTAL), (LAS float*)(F.lds + BG_T)); if (g0 + 6 >= target) break; }
}
constexpr int P0_ADA = 384, P0_RT = 96, P0_ROPE = 1, P0_UNITS = P0_ADA + P0_RT + P0_ROPE;
__device__ __forceinline__ void p0_prologue(const Frame& F) {
    const Params& p = *F.p; const int tid = F.tid;
    LAS float* sv = (LAS float*)F.lds;
    LAS float* part = (LAS float*)(F.lds + 24576);
    LAS float* T = (LAS float*)(F.lds + 49152);
    for (int i = tid; i < 3 * 2048; i += NTHR) { const float c = i < 4096 ? inp(F, I_C)[i] : inp(F, I_CCTX)[i - 4096]; sv[i] = c / (1.0f + __expf(-c)); }
    __syncthreads();
    for (int u = F.bx; u < P0_UNITS; u += F.G) {
        if (u < P0_ADA) {
            const int l = u / 192, col0 = (u % 192) * 64, c4 = tid & 15, ks = tid >> 4;
            const float* W = inp(F, I_ADAW) + ((size_t)l * 2048 + ks * 64) * 12288 + col0 + c4 * 4;
            f32x4 a0 = {0, 0, 0, 0}, a1 = a0, a2 = a0;
#pragma unroll 8
            for (int k = 0; k < 64; ++k) { const f32x4 w = __builtin_nontemporal_load((const f32x4*)(W + (size_t)k * 12288)); const float s0 = sv[ks * 64 + k], s1 = sv[2048 + ks * 64 + k], s2 = sv[4096 + ks * 64 + k];
                a0 += w * s0; a1 += w * s1; a2 += w * s2; }
#pragma unroll
            for (int j = 0; j < 4; ++j) { part[(ks * 3 + 0) * 64 + c4 * 4 + j] = a0[j]; part[(ks * 3 + 1) * 64 + c4 * 4 + j] = a1[j]; part[(ks * 3 + 2) * 64 + c4 * 4 + j] = a2[j]; }
            __syncthreads();
            if (tid < 192) { const int v = tid >> 6, c = tid & 63; float s = 0.f;
#pragma unroll
                for (int k = 0; k < 32; ++k) s += part[(k * 3 + v) * 64 + c];
                fMOD(F)[(size_t)(l * 3 + v) * 12288 + col0 + c] = s + inp(F, I_ADAB)[(size_t)l * 12288 + col0 + c]; }
            __syncthreads();
        } else if (u < P0_ADA + P0_RT) {
            const int q = u - P0_ADA, l = q / 48, j = q % 48; bf16_t* wrb = (bf16_t*)fWRT(F);
            for (int k = tid; k < 2048; k += NTHR) { const float v = j < 4 ? inp(F, I_RWG)[((size_t)l * 2048 + k) * 4 + j] : (j < 36 ? inp(F, I_RWE)[((size_t)l * 2048 + k) * 32 + (j - 4)] : 0.f);
                wrb[(size_t)(l * 48 + j) * 2048 + k] = (bf16_t)(cvt_pk_bf16(v, 0.f) & 0xffffu); }
        } else if (u < P0_ADA + P0_RT + P0_ROPE) {
            for (int i = tid; i < 4096; i += NTHR) { const int pos = i >> 5, f = i & 31; const double inv = exp(-9.210340371976184 * (double)f / 32.0); const double ang = (double)pos * inv;
                fROPE(F)[i] = (float)cos(ang); fROPE(F)[4096 + i] = (float)sin(ang); }
        }
    }
    __syncthreads();
    bg_drain(F, CV_SMALL);
}

__device__ __forceinline__ const float* mod_vec(const Frame& F, int l, int row) { const int b = row / TB, t = row - b * TB; return fMOD(F) + (size_t)(l * 3 + (t >= SEQ ? 2 : b)) * 12288; }
typedef u32x4 RowRaw[8];
__device__ __forceinline__ void load_raw(const Frame& F, int l, int row, RowRaw& r) {
    const int lane = F.lane; const int b = row / TB, t = row - b * TB;
    if (l == 0) { const float* src = t >= SEQ ? inp(F, I_CTX) + ((size_t)b * CTXL + (t - SEQ)) * DM : inp(F, I_X) + ((size_t)b * SEQ + t) * DM;
#pragma unroll
        for (int j = 0; j < 8; ++j) r[j] = *(const u32x4*)(src + j * 256 + lane * 4);
    } else { const bf16_t* xr = fX(F) + (size_t)row * DM; const unsigned char* y0 = fY(F) + (size_t)row * 2 * DM; const unsigned char* y1 = y0 + DM;
#pragma unroll
        for (int j = 0; j < 8; ++j) { const int c = j * 256 + lane * 4; const u32x2 xw = *(const u32x2*)(xr + c); r[j] = (u32x4){xw.x, xw.y, *(const unsigned*)(y0 + c), *(const unsigned*)(y1 + c)}; } }
}
__device__ __forceinline__ void finish_raw(const Frame& F, int l, int row, const RowRaw& r, f32x4 (&xv)[8]) {
    const int lane = F.lane;
    if (l == 0) {
#pragma unroll
        for (int j = 0; j < 8; ++j) xv[j] = __builtin_bit_cast(f32x4, r[j]);
    } else { const float* g = mod_vec(F, l - 1, row) + 10240;
#pragma unroll
        for (int j = 0; j < 8; ++j) { const int c = j * 256 + lane * 4; const f32x4 x = {bflo(r[j].x), bfhi(r[j].x), bflo(r[j].y), bfhi(r[j].y)}, gg = *(const f32x4*)(g + c);
            const unsigned a = r[j].z, bb = r[j].w;
            const f32x2 a0 = __builtin_amdgcn_cvt_pk_f32_fp8((int)a, false), a1 = __builtin_amdgcn_cvt_pk_f32_fp8((int)a, true), b0 = __builtin_amdgcn_cvt_pk_f32_fp8((int)bb, false), b1 = __builtin_amdgcn_cvt_pk_f32_fp8((int)bb, true);
            f32x4 y; y[0] = a0[0] + b0[0]; y[1] = a0[1] + b0[1]; y[2] = a1[0] + b1[0]; y[3] = a1[1] + b1[1]; xv[j] = x + gg * (y * 0.0625f); } }
}
__device__ __forceinline__ float row_rstd(const f32x4 (&xv)[8]) { float s = 0.f;
#pragma unroll
    for (int j = 0; j < 8; ++j) s += xv[j][0] * xv[j][0] + xv[j][1] * xv[j][1] + xv[j][2] * xv[j][2] + xv[j][3] * xv[j][3];
    s = wave_sum(s); return rsqrtf(s * (1.0f / DM) + EPS); }

__device__ __forceinline__ void n1_phase(const Frame& F, int l, bool dry) {
    const int lane = F.lane, stride = F.G * 8;
    int row = F.bx * 8 + F.wave; RowRaw cur, nxt;
    if (row < MTOK) load_raw(F, l, row, cur);
#pragma unroll 1
    for (; row < MTOK; row += stride) {
        const bool hn = row + stride < MTOK;
        if (hn) load_raw(F, l, row + stride, nxt);
        f32x4 xv[8]; finish_raw(F, l, row, cur, xv);
        bf16_t* xo = (dry ? fP(F) : fX(F)) + (size_t)row * DM;
#pragma unroll
        for (int j = 0; j < 8; ++j) { u32x2 w; w.x = cvt_pk_bf16(xv[j][0], xv[j][1]); w.y = cvt_pk_bf16(xv[j][2], xv[j][3]); *(u32x2*)(xo + j * 256 + lane * 4) = w; }
        const float rstd = row_rstd(xv); const float* mv = mod_vec(F, l, row); const float* g = inp(F, I_N1G) + (size_t)l * DM; bf16_t* ho = (dry ? fMIX(F) : fHB(F)) + (size_t)row * DM;
#pragma unroll
        for (int j = 0; j < 8; ++j) { const int c = j * 256 + lane * 4; const f32x4 gg = *(const f32x4*)(g + c), sh = *(const f32x4*)(mv + c), sc = *(const f32x4*)(mv + 2048 + c);
            const f32x4 h = xv[j] * rstd * gg * (sc + 1.0f) + sh; u32x2 w; w.x = cvt_pk_bf16(h[0], h[1]); w.y = cvt_pk_bf16(h[2], h[3]); *(u32x2*)(ho + c) = w; }
#pragma unroll
        for (int j = 0; j < 8; ++j) cur[j] = nxt[j];
    }
}
__device__ __forceinline__ void fin_phase(const Frame& F) {
    const int lane = F.lane, stride = F.G * 8;
    int q = F.bx * 8 + F.wave; RowRaw cur, nxt;
#define FIN_ROW(qq) (((qq) / SEQ) * TB + ((qq) % SEQ))
    if (q < NB * SEQ) load_raw(F, 2, FIN_ROW(q), cur);
#pragma unroll 1
    for (; q < NB * SEQ; q += stride) {
        const bool hn = q + stride < NB * SEQ;
        if (hn) load_raw(F, 2, FIN_ROW(q + stride), nxt);
        f32x4 xv[8]; finish_raw(F, 2, FIN_ROW(q), cur, xv);
        const float rstd = row_rstd(xv); const float* g = inp(F, I_FING); float* o = (float*)inp(F, I_OUT) + (size_t)q * DM;
#pragma unroll
        for (int j = 0; j < 8; ++j) { const int c = j * 256 + lane * 4; *(f32x4*)(o + c) = xv[j] * rstd * *(const f32x4*)(g + c); }
#pragma unroll
        for (int j = 0; j < 8; ++j) cur[j] = nxt[j];
    }
#undef FIN_ROW
}

constexpr int N2_T = 0, N2_TP = 2056, N2_RED = 16 * N2_TP * 2, N2_LG = N2_RED + 8 * 16 * 48 * 4, N2_CTL = N2_LG + 16 * 48 * 4;
__device__ __forceinline__ void n2_phase(const Frame& F, int l, bool dry) {
    const int lane = F.lane, tid = F.tid, wave = F.wave;
    LAS bf16_t* T = (LAS bf16_t*)(F.lds + N2_T); LAS float* RED = (LAS float*)(F.lds + N2_RED); LAS float* LG = (LAS float*)(F.lds + N2_LG);
    LAS int* lc = (LAS int*)(F.lds + N2_CTL);
    LAS int* gb = lc + 32;
    LAS int* ri = gb + 32;
    LAS float* rw = (LAS float*)(ri + 66 * 4);
    if (tid < 32) lc[tid] = 0;
    __syncthreads();
    const int r0 = F.bx * 66;
    const bf16_t* wrb = (const bf16_t*)fWRT(F) + (size_t)l * 48 * 2048;
    const float* g = inp(F, I_N2G) + (size_t)l * DM; const float* rbg = inp(F, I_RBG) + l * 4; const float* rbe = inp(F, I_RBE) + l * 32;
    u32x2 xraw[2][8];
#define N2_LOADX(ubv) do { _Pragma("unroll") for (int q2 = 0; q2 < 2; ++q2) { const int rr_ = wave * 2 + q2, row_ = r0 + (ubv) + rr_; const int t_ = row_ % TB; \
        const bool ok_ = ((ubv) + rr_ < 66) && !(l == 1 && t_ >= SEQ); const bf16_t* xr_ = fX(F) + (size_t)row_ * DM; \
        _Pragma("unroll") for (int j = 0; j < 8; ++j) xraw[q2][j] = ok_ ? *(const u32x2*)(xr_ + j * 256 + lane * 4) : (u32x2){0u, 0u}; } } while (0)
    N2_LOADX(0);
#pragma unroll 1
    for (int ub = 0; ub < 66; ub += 16) {
        const int nrow = min(16, 66 - ub);
#pragma unroll
        for (int q2 = 0; q2 < 2; ++q2) {
            const int rr = wave * 2 + q2;
            const int i = ub + rr, row = r0 + i; const int b = row / TB, t = row - b * TB;
            const bool ok = (rr < nrow) && !(l == 1 && t >= SEQ);
            if (ok) {
            f32x4 xv[8];
#pragma unroll
            for (int j = 0; j < 8; ++j) { const u32x2 xw = xraw[q2][j]; xv[j] = (f32x4){bflo(xw.x), bfhi(xw.x), bflo(xw.y), bfhi(xw.y)}; }
            const float rstd = row_rstd(xv); const float* mv = mod_vec(F, l, row); unsigned char* ho = fHB8(F) + (size_t)row * DM;
#pragma unroll
            for (int j = 0; j < 8; ++j) { const int c = j * 256 + lane * 4; const f32x4 gg = *(const f32x4*)(g + c), sh = *(const f32x4*)(mv + 6144 + c), sc = *(const f32x4*)(mv + 8192 + c);
                const f32x4 h = xv[j] * rstd * gg * (sc + 1.0f) + sh; u32x2 w; w.x = cvt_pk_bf16(h[0], h[1]); w.y = cvt_pk_bf16(h[2], h[3]); *(unsigned*)(ho + c) = cvt_pk_fp8x4_sat(h[0], h[1], h[2], h[3]); *(LAS u32x2*)(T + rr * N2_TP + c) = w; }
            }
        }
        if (ub + 16 < 66) N2_LOADX(ub + 16);
        __syncthreads();
        { const int fr = lane & 15, kq = lane >> 4;
          f32x4 acc[3] = {{0, 0, 0, 0}, {0, 0, 0, 0}, {0, 0, 0, 0}};
#pragma unroll
          for (int s = 0; s < 8; ++s) { const int k0 = (wave * 8 + s) * 32 + kq * 8;
              const bf16x8 tb = *(const LAS bf16x8*)(T + fr * N2_TP + k0);
#pragma unroll
              for (int t3 = 0; t3 < 3; ++t3) { const bf16x8 wa = *(const bf16x8*)(wrb + (size_t)(t3 * 16 + fr) * 2048 + k0); acc[t3] = __builtin_amdgcn_mfma_f32_16x16x32_bf16(wa, tb, acc[t3], 0, 0, 0); } }
#pragma unroll
          for (int t3 = 0; t3 < 3; ++t3) *(LAS f32x4*)(RED + (wave * 16 + fr) * 48 + t3 * 16 + kq * 4) = acc[t3]; }
        __syncthreads();
        for (int q = tid; q < 16 * 48; q += NTHR) { float s = 0.f;
#pragma unroll
            for (int w = 0; w < 8; ++w) s += RED[w * 768 + q];
            const int e = q % 48; LG[q] = s + (e < 4 ? rbg[e] : (e < 36 ? rbe[e - 4] : 0.f)); }
        __syncthreads();
        if (tid < nrow) {
            const int i = ub + tid, row = r0 + i; const int b = row / TB, t = row - b * TB;
            if (l == 1 && t >= SEQ) ri[i * 4] = -1;
            else {
                const LAS float* lg = LG + tid * 48;
                int gs = 0; float gm = lg[0];
#pragma unroll
                for (int k = 1; k < 4; ++k) if (lg[k] > gm) { gm = lg[k]; gs = k; }
                float den = 0.f;
#pragma unroll
                for (int k = 0; k < 4; ++k) den += __expf(lg[k] - gm);
                const float ggate = 1.0f / den;
                const LAS float* le = lg + 4 + gs * 8;
                int i0 = 0; float v0 = le[0];
#pragma unroll
                for (int k = 1; k < 8; ++k) if (le[k] > v0) { v0 = le[k]; i0 = k; }
                int i1 = -1; float v1 = -3.0e38f;
#pragma unroll
                for (int k = 0; k < 8; ++k) if (k != i0 && le[k] > v1) { v1 = le[k]; i1 = k; }
                const float e1 = __expf(v1 - v0), w0 = ggate / (1.0f + e1), w1 = ggate * e1 / (1.0f + e1);
                const int ex0 = gs * 8 + i0, ex1 = gs * 8 + i1;
                const int lp0 = __hip_atomic_fetch_add(lc + ex0, 1, __ATOMIC_RELAXED, __HIP_MEMORY_SCOPE_WORKGROUP), lp1 = __hip_atomic_fetch_add(lc + ex1, 1, __ATOMIC_RELAXED, __HIP_MEMORY_SCOPE_WORKGROUP);
                ri[i * 4 + 0] = ex0; ri[i * 4 + 1] = ex1; ri[i * 4 + 2] = lp0; ri[i * 4 + 3] = lp1; rw[i * 2] = w0; rw[i * 2 + 1] = w1;
            }
        }
    }
#undef N2_LOADX
    __syncthreads();
    if (dry) { __syncthreads(); return; }
    if (tid < 32) { const int c = lc[tid]; gb[tid] = c > 0 ? __hip_atomic_fetch_add(fCNT(F) + l * 32 + tid, c, __ATOMIC_RELAXED, __HIP_MEMORY_SCOPE_AGENT) : 0; }
    __syncthreads();
    if (tid < 66 && ri[tid * 4] >= 0) { const int row = r0 + tid;
#pragma unroll
        for (int k = 0; k < 2; ++k) { const int e = ri[tid * 4 + k]; const size_t pos = (size_t)e * CAP + gb[e] + ri[tid * 4 + 2 + k]; fLDEST(F)[pos] = row * 2 + k; fLW(F)[pos] = rw[tid * 2 + k]; } }
    __syncthreads();
}

__device__ __forceinline__ void qknorm_phase(const Frame& F, int l) {
    const Params& p = *F.p; const int lane = F.lane, li = lane & 15;
    const float* COS = fROPE(F); const float* SIN = fROPE(F) + 4096; const float* gq = inp(F, I_QNORM); const float* gk = inp(F, I_KNORM);
    for (int it = (F.bx * 8 + F.wave) * 4 + (lane >> 4); it < MTOK * 6; it += F.G * 32) {
        const int row = it / 6, slot = it - row * 6; const int col = slot < 4 ? C_QA + slot * 128 : C_KA + (slot - 4) * 128;
        const float* g = (slot < 4 ? gq : gk) + l * 128 + li * 8;
        bf16_t* ptr = fP(F) + (size_t)row * INW + col + li * 8;
        const u32x4 raw = *(const u32x4*)ptr;
        float v[8] = {bflo(raw.x), bfhi(raw.x), bflo(raw.y), bfhi(raw.y), bflo(raw.z), bfhi(raw.z), bflo(raw.w), bfhi(raw.w)};
        float ss = 0.f;
#pragma unroll
        for (int e = 0; e < 8; ++e) ss += v[e] * v[e];
        ss += __shfl_xor(ss, 1); ss += __shfl_xor(ss, 2); ss += __shfl_xor(ss, 4); ss += __shfl_xor(ss, 8);
        const float rstd = rsqrtf(ss * (1.0f / 128.0f) + EPS);
        const f32x4 g0 = *(const f32x4*)g, g1 = *(const f32x4*)(g + 4);
#pragma unroll
        for (int e = 0; e < 4; ++e) { v[e] = v[e] * rstd * g0[e]; v[4 + e] = v[4 + e] * rstd * g1[e]; }
        const int t = row % TB;
        float pr[8];
#pragma unroll
        for (int e = 0; e < 8; ++e) pr[e] = __shfl_xor(v[e], 4);
        if (t < SEQ) { const int half = (li >> 2) & 1, axis = li >> 3, pos = axis ? (t & 63) : (t >> 6); const int fb = pos * 32 + (li & 3) * 8;
#pragma unroll
            for (int e = 0; e < 8; ++e) { const float c = COS[fb + e], s = SIN[fb + e]; v[e] = half ? v[e] * c + pr[e] * s : v[e] * c - pr[e] * s; } }
        u32x4 w; w.x = cvt_pk_bf16(v[0], v[1]); w.y = cvt_pk_bf16(v[2], v[3]); w.z = cvt_pk_bf16(v[4], v[5]); w.w = cvt_pk_bf16(v[6], v[7]);
        *(u32x4*)ptr = w;
    }
}

template <int DIR> __device__ __forceinline__ void lru_scan(const f32x16 (&A)[2], f32x16 (&Bv)[2], float h_in, int hi, float& Atot, float& hend, bool want_h) {
    float GA[8], GB[8], PA[8], PB[8], hs[8];
#pragma unroll
    for (int j = 0; j < 8; ++j) { const int mt = j >> 2, rb = (j & 3) * 4; float Bc = 0.f, Ap = 1.f;
#pragma unroll
        for (int q = 0; q < 4; ++q) { const int e = DIR ? 3 - q : q; const float a = A[mt][rb + e], b = Bv[mt][rb + e]; Bc = a * Bc + b; Ap *= a; }
        GA[j] = Ap; GB[j] = Bc; PA[j] = __shfl_xor(Ap, 32); PB[j] = __shfl_xor(Bc, 32); }
    float h = h_in, at = 1.f;
#pragma unroll
    for (int q = 0; q < 8; ++q) { const int j = DIR ? 7 - q : q;
        const bool own_first = DIR ? (hi == 1) : (hi == 0);
        const float a0 = own_first ? GA[j] : PA[j], b0 = own_first ? GB[j] : PB[j], a1 = own_first ? PA[j] : GA[j], b1 = own_first ? PB[j] : GB[j];
        const float h0 = h, h1 = a0 * h0 + b0, h2 = a1 * h1 + b1; hs[j] = own_first ? h0 : h1; h = h2; at *= GA[j] * PA[j]; }
    Atot = at; hend = h;
    if (want_h) {
#pragma unroll
        for (int j = 0; j < 8; ++j) { const int mt = j >> 2, rb = (j & 3) * 4; float hc = hs[j];
#pragma unroll
            for (int q = 0; q < 4; ++q) { const int e = DIR ? 3 - q : q; hc = A[mt][rb + e] * hc + Bv[mt][rb + e]; Bv[mt][rb + e] = hc; } }
    }
}
constexpr int LRU_UCF = 0, LRU_UCB = 32768, LRU_HS = 51200, LRU_CAR = 116736, LRU_CW = 126464;
template <bool FINAL> __device__ __forceinline__ void lru_units(const Frame& F, int l) {
    int tz = threadIdx.x; asm volatile("" : "+v"(tz)); const int tid = tz, lane = tid & 63, wave = __builtin_amdgcn_readfirstlane(tid >> 6), r32 = lane & 31, hi = lane >> 5, d = wave >> 2, cg = wave & 3;
    LAS float* UCf = (LAS float*)(F.lds + LRU_UCF); LAS bf16_t* UCb = (LAS bf16_t*)(F.lds + LRU_UCB); LAS float* HS = (LAS float*)(F.lds + LRU_HS);
    LAS float* CAR = (LAS float*)(F.lds + LRU_CAR); LAS float* CW = (LAS float*)(F.lds + LRU_CW);
    const int nch = (FINAL && l == 1) ? SEQ / 64 : NCHUNK;
    const int nunits = NB * nch * 8;
    const int n = F.bx & 7;
    const int ch = n * 128 + cg * 32 + r32;
    const int q0 = F.bx >> 3;
    for (int i = tid; i < 640; i += NTHR) CW[i] = i < 512 ? inp(F, I_CONVW)[(size_t)l * 4096 + (i >> 7) * 1024 + n * 128 + (i & 127)] : inp(F, I_CONVB)[(size_t)l * 1024 + n * 128 + (i - 512)];
    if (FINAL) {
        const int cb_ = tid >> 8, cd = (tid >> 7) & 1, cl = tid & 127;
        const f32x2* ag = fAGG(F) + (size_t)((cb_ * 2 + cd) * NCHUNK) * 1024 + n * 128 + cl;
        float h = 0.f;
#pragma unroll 1
        for (int p0 = 0; p0 < NCHUNK; p0 += 12) {
            f32x2 ab[12];
#pragma unroll
            for (int j = 0; j < 12; ++j) { const int pp = p0 + j; const int cc = cd ? (NCHUNK - 1 - pp) : (pp + 128) % NCHUNK; ab[j] = ag[(size_t)cc * 1024]; }
#pragma unroll
            for (int j = 0; j < 12; ++j) { const int pp = p0 + j; const int cc = cd ? (NCHUNK - 1 - pp) : (pp + 128) % NCHUNK;
                if (cc < nch) { const int q = cb_ * nch + cc - q0; if (q >= 0 && (q & 31) == 0) CAR[((q >> 5) * 2 + cd) * 128 + cl] = h; }
                h = ab[j].x * h + ab[j].y; }
        }
    }
    bf16x8 Br[8], Bi[8];
    { const bf16_t* wb = fLRUW(F) + ((size_t)(((l * 2 + d) * 8 + n) * 2) * 128 + cg * 32 + r32) * 128 + hi * 8;
#pragma unroll
      for (int s = 0; s < 8; ++s) { Br[s] = *(const bf16x8*)(wb + s * 16); Bi[s] = *(const bf16x8*)(wb + 128 * 128 + s * 16); } }
    const float brv = -1.4426950409f * inp(F, I_LRUBR)[(l * 2 + d) * 1024 + ch], biv = -1.4426950409f * inp(F, I_LRUBI)[(l * 2 + d) * 1024 + ch];
    const float lam = inp(F, I_LAM)[(l * 2 + d) * 1024 + ch]; const float sp8 = -8.0f * 1.4426950409f * log1pf(__expf(-lam));
    const int tok = tid >> 3, ch0 = (tid & 7) * 16;
    u32x4 U[4][2];
#define LRU_LOADU(uu) do { const int q_ = (uu) >> 3, b_ = q_ / nch, c_ = q_ - b_ * nch; const int t_ = c_ * 64 + tok, lo_ = c_ >= 128 ? SEQ : 0, hi_ = c_ >= 128 ? TB : SEQ; \
        _Pragma("unroll") for (int i = 0; i < 4; ++i) { const int tt = t_ - 1 + i; if (tt >= lo_ && tt < hi_) { const bf16_t* up = fP(F) + ((size_t)(b_ * TB + tt)) * INW + C_UB + n * 128 + ch0; U[i][0] = *(const u32x4*)up; U[i][1] = *(const u32x4*)(up + 8); } \
            else { U[i][0] = (u32x4){0u, 0u, 0u, 0u}; U[i][1] = (u32x4){0u, 0u, 0u, 0u}; } } } while (0)
    if (F.bx < nunits) LRU_LOADU(F.bx);
    __syncthreads();
    int kk = 0;
#pragma unroll 1
    for (int u = F.bx; u < nunits; u += F.G, ++kk) {
        const int q = u >> 3, b = q / nch, c = q - b * nch;
        { float y[16];
#pragma unroll
          for (int j = 0; j < 16; j += 4) { const f32x4 bv = *(const LAS f32x4*)(CW + 512 + ch0 + j); y[j] = bv[0]; y[j + 1] = bv[1]; y[j + 2] = bv[2]; y[j + 3] = bv[3]; }
#pragma unroll
          for (int i = 0; i < 4; ++i) { const u32x4 u0 = U[i][0], u1 = U[i][1];
              const float uu[16] = {bflo(u0.x), bfhi(u0.x), bflo(u0.y), bfhi(u0.y), bflo(u0.z), bfhi(u0.z), bflo(u0.w), bfhi(u0.w), bflo(u1.x), bfhi(u1.x), bflo(u1.y), bfhi(u1.y), bflo(u1.z), bfhi(u1.z), bflo(u1.w), bfhi(u1.w)};
#pragma unroll
              for (int j = 0; j < 16; j += 4) { const f32x4 wv = *(const LAS f32x4*)(CW + i * 128 + ch0 + j); y[j] += wv[0] * uu[j]; y[j + 1] += wv[1] * uu[j + 1]; y[j + 2] += wv[2] * uu[j + 2]; y[j + 3] += wv[3] * uu[j + 3]; } }
#pragma unroll
          for (int j = 0; j < 16; j += 4) *(LAS f32x4*)(UCf + tok * 128 + ch0 + j) = (f32x4){y[j], y[j + 1], y[j + 2], y[j + 3]};
          LAS u32x4* ub = (LAS u32x4*)(UCb + tok * 136 + ch0);
          ub[0] = (u32x4){cvt_pk_bf16(y[0], y[1]), cvt_pk_bf16(y[2], y[3]), cvt_pk_bf16(y[4], y[5]), cvt_pk_bf16(y[6], y[7])};
          ub[1] = (u32x4){cvt_pk_bf16(y[8], y[9]), cvt_pk_bf16(y[10], y[11]), cvt_pk_bf16(y[12], y[13]), cvt_pk_bf16(y[14], y[15])}; }
        u32x4 g0 = {0u, 0u, 0u, 0u}, g1 = g0;
        const size_t row = (size_t)b * TB + c * 64 + tok;
        if (FINAL) { const bf16_t* gp = fP(F) + row * INW + C_GB + n * 128 + ch0; g0 = *(const u32x4*)gp; g1 = *(const u32x4*)(gp + 8); }
        if (u + F.G < nunits) LRU_LOADU(u + F.G);
        __syncthreads();
        f32x16 av[2] = {}, bv[2] = {};
#pragma unroll
        for (int s = 0; s < 8; ++s)
#pragma unroll
            for (int mt = 0; mt < 2; ++mt) { const bf16x8 a = *(const LAS bf16x8*)(UCb + (mt * 32 + r32) * 136 + s * 16 + hi * 8);
                av[mt] = __builtin_amdgcn_mfma_f32_32x32x16_bf16(a, Br[s], av[mt], 0, 0, 0); bv[mt] = __builtin_amdgcn_mfma_f32_32x32x16_bf16(a, Bi[s], bv[mt], 0, 0, 0); }
        u32x4* lab = fLAB(F) + ((size_t)(u * 8 + wave) * 8) * 64 + lane;
#pragma unroll
        for (int mt = 0; mt < 2; ++mt)
#pragma unroll
            for (int rg = 0; rg < 4; ++rg) { unsigned w4[4];
#pragma unroll
                for (int j = 0; j < 4; ++j) { const int r = rg * 4 + j; const int tk = mt * 32 + (r & 3) + 8 * (r >> 2) + 4 * hi; const float uc = UCf[tk * 128 + cg * 32 + r32];
                    const float e1 = __builtin_amdgcn_exp2f(fminf(fmaf(av[mt][r], -1.4426950409f, brv), 40.f)), e2 = __builtin_amdgcn_exp2f(fminf(fmaf(bv[mt][r], -1.4426950409f, biv), 40.f));
                    const float d1 = 1.0f + e1, d2 = 1.0f + e2, rc = __builtin_amdgcn_rcpf(d1 * d2); const float la = sp8 * (rc * d2); const float a = __builtin_amdgcn_exp2f(la);
                    const float bb = __builtin_amdgcn_sqrtf(fmaxf(fmaf(-a, a, 1.0f), 0.f)) * (rc * d1) * uc; av[mt][r] = a; bv[mt][r] = bb;
                    if (!FINAL) { const _Float16 hl = (_Float16)la; w4[j] = ((unsigned)__builtin_bit_cast(unsigned short, hl) << 16) | (cvt_pk_bf16(bb, 0.f) & 0xffffu); } }
                if (!FINAL) lab[(mt * 4 + rg) * 64] = (u32x4){w4[0], w4[1], w4[2], w4[3]}; }
        if (!FINAL) {
            float At, he;
            if (d == 0) lru_scan<0>(av, bv, 0.f, hi, At, he, false); else lru_scan<1>(av, bv, 0.f, hi, At, he, false);
            if (hi == 0) fAGG(F)[(size_t)((b * 2 + d) * NCHUNK + c) * 1024 + ch] = (f32x2){At, he};
            __syncthreads();
        } else {
            const float h_in = CAR[(kk * 2 + d) * 128 + cg * 32 + r32];
            float At, he;
            if (d == 0) lru_scan<0>(av, bv, h_in, hi, At, he, true); else lru_scan<1>(av, bv, h_in, hi, At, he, true);
#pragma unroll
            for (int mt = 0; mt < 2; ++mt)
#pragma unroll
                for (int r = 0; r < 16; ++r) { const int tk = mt * 32 + (r & 3) + 8 * (r >> 2) + 4 * hi; HS[(d * 64 + tk) * 128 + cg * 32 + r32] = bv[mt][r]; }
            __syncthreads();
            { const float gg[16] = {bflo(g0.x), bfhi(g0.x), bflo(g0.y), bfhi(g0.y), bflo(g0.z), bfhi(g0.z), bflo(g0.w), bfhi(g0.w), bflo(g1.x), bfhi(g1.x), bflo(g1.y), bfhi(g1.y), bflo(g1.z), bfhi(g1.z), bflo(g1.w), bfhi(g1.w)};
              float o[16];
#pragma unroll
              for (int j = 0; j < 16; ++j) o[j] = (HS[tok * 128 + ch0 + j] + HS[(64 + tok) * 128 + ch0 + j]) * gelu_tanh(gg[j]);
              u32x4* op = (u32x4*)(fMIX(F) + row * DM + 512 + n * 128 + ch0);
              op[0] = (u32x4){cvt_pk_bf16(o[0], o[1]), cvt_pk_bf16(o[2], o[3]), cvt_pk_bf16(o[4], o[5]), cvt_pk_bf16(o[6], o[7])};
              op[1] = (u32x4){cvt_pk_bf16(o[8], o[9]), cvt_pk_bf16(o[10], o[11]), cvt_pk_bf16(o[12], o[13]), cvt_pk_bf16(o[14], o[15])}; }
            __syncthreads();
        }
    }
#undef LRU_LOADU
}

__device__ __forceinline__ void lru_pass2(const Frame& F, int l) {
    int tz = threadIdx.x; asm volatile("" : "+v"(tz)); const int tid = tz, lane = tid & 63, wave = __builtin_amdgcn_readfirstlane(tid >> 6), r32 = lane & 31, hi = lane >> 5, d = wave >> 2, cg = wave & 3;
    LAS float* HS = (LAS float*)(F.lds + LRU_HS); LAS float* CAR = (LAS float*)(F.lds + LRU_CAR);
    const int nch = (l == 1) ? SEQ / 64 : NCHUNK;
    const int nunits = NB * nch * 8, n = F.bx & 7, q0 = F.bx >> 3;
    { const int cb_ = tid >> 8, cd = (tid >> 7) & 1, cl = tid & 127;
      const f32x2* ag = fAGG(F) + (size_t)((cb_ * 2 + cd) * NCHUNK) * 1024 + n * 128 + cl;
      float h = 0.f;
#pragma unroll 1
      for (int p0 = 0; p0 < NCHUNK; p0 += 12) {
          f32x2 ab[12];
#pragma unroll
          for (int j = 0; j < 12; ++j) { const int pp = p0 + j; const int cc = cd ? (NCHUNK - 1 - pp) : (pp + 128) % NCHUNK; ab[j] = ag[(size_t)cc * 1024]; }
#pragma unroll
          for (int j = 0; j < 12; ++j) { const int pp = p0 + j; const int cc = cd ? (NCHUNK - 1 - pp) : (pp + 128) % NCHUNK;
              if (cc < nch) { const int q = cb_ * nch + cc - q0; if (q >= 0 && (q & 31) == 0) CAR[((q >> 5) * 2 + cd) * 128 + cl] = h; }
              h = ab[j].x * h + ab[j].y; }
      } }
    const int tok = tid >> 3, ch0 = (tid & 7) * 16;
    u32x4 W[8];
#define LRU_LOADW(uu) do { const int q_ = (uu) >> 3, b_ = q_ / nch, c_ = q_ - b_ * nch; const u32x4* lab_ = fLAB(F) + ((size_t)(((b_ * NCHUNK + c_) * 8 + n) * 8 + wave) * 8) * 64 + lane; \
        _Pragma("unroll") for (int q8 = 0; q8 < 8; ++q8) W[q8] = lab_[q8 * 64]; } while (0)
    if (F.bx < nunits) LRU_LOADW(F.bx);
    __syncthreads();
    int kk = 0;
#pragma unroll 1
    for (int u = F.bx; u < nunits; u += F.G, ++kk) {
        const int q = u >> 3, b = q / nch, c = q - b * nch;
        f32x16 av[2], bv[2];
#pragma unroll
        for (int q8 = 0; q8 < 8; ++q8)
#pragma unroll
            for (int j = 0; j < 4; ++j) { const unsigned w = W[q8][j]; const int mt = q8 >> 2, r = (q8 & 3) * 4 + j;
                av[mt][r] = __builtin_amdgcn_exp2f((float)__builtin_bit_cast(_Float16, (unsigned short)(w >> 16))); bv[mt][r] = __uint_as_float(w << 16); }
        const size_t row = (size_t)b * TB + c * 64 + tok;
        const bf16_t* gp = fP(F) + row * INW + C_GB + n * 128 + ch0; const u32x4 g0 = *(const u32x4*)gp, g1 = *(const u32x4*)(gp + 8);
        if (u + F.G < nunits) LRU_LOADW(u + F.G);
        const float h_in = CAR[(kk * 2 + d) * 128 + cg * 32 + r32];
        float At, he;
        if (d == 0) lru_scan<0>(av, bv, h_in, hi, At, he, true); else lru_scan<1>(av, bv, h_in, hi, At, he, true);
#pragma unroll
        for (int mt = 0; mt < 2; ++mt)
#pragma unroll
            for (int r = 0; r < 16; ++r) { const int tk = mt * 32 + (r & 3) + 8 * (r >> 2) + 4 * hi; HS[(d * 64 + tk) * 128 + cg * 32 + r32] = bv[mt][r]; }
        __syncthreads();
        { const float gg[16] = {bflo(g0.x), bfhi(g0.x), bflo(g0.y), bfhi(g0.y), bflo(g0.z), bfhi(g0.z), bflo(g0.w), bfhi(g0.w), bflo(g1.x), bfhi(g1.x), bflo(g1.y), bfhi(g1.y), bflo(g1.z), bfhi(g1.z), bflo(g1.w), bfhi(g1.w)};
          float o[16];
#pragma unroll
          for (int j = 0; j < 16; ++j) o[j] = (HS[tok * 128 + ch0 + j] + HS[(64 + tok) * 128 + ch0 + j]) * gelu_tanh(gg[j]);
          u32x4* op = (u32x4*)(fMIX(F) + row * DM + 512 + n * 128 + ch0);
          op[0] = (u32x4){cvt_pk_bf16(o[0], o[1]), cvt_pk_bf16(o[2], o[3]), cvt_pk_bf16(o[4], o[5]), cvt_pk_bf16(o[6], o[7])};
          op[1] = (u32x4){cvt_pk_bf16(o[8], o[9]), cvt_pk_bf16(o[10], o[11]), cvt_pk_bf16(o[12], o[13]), cvt_pk_bf16(o[14], o[15])}; }
        __syncthreads();
    }
#undef LRU_LOADW
}

#ifndef ATT_REP_MODE
#define ATT_REP_MODE 7
#endif
__device__ __forceinline__ void attn_phase(const Frame& F, int l, int rep) {
    const int amode = rep ? ATT_REP_MODE : 7;
    const Params& p = *F.p; const int bx = F.bx;
    const int x = bx & 7, o = (bx >> 3) & 31;
#ifndef NA_SKIP
    if (amode & 2) {
        att::Job J; J.mode = 1;
        const int b = x >> 2, h = x & 3, rg = o;
        float* rp = (float*)(F.ldsg + att::RPB_OFF);
        for (int i = F.tid; i < 15 * 31; i += NTHR) rp[i] = inp(F, I_RPB)[(size_t)(l * 4 + h) * 465 + i] * (1.0f / att::SCALE);
        J.Q = fP(F) + ((size_t)b * TB + rg * 256) * INW + C_QN + h * 128; J.K = fP(F) + C_KN + h * 128; J.V = fP(F) + C_VN + h * 128;
        J.O = fMIX(F) + ((size_t)b * TB + rg * 256) * DM + 1536 + h * 128; J.nt = 16; J.row_a = b * TB + SEQ; J.gr0 = rg * 4;
        J.kstart = min(max(rg * 4 - 4, 0), 116); J.row_b = b * TB + J.kstart * 64;
        att::opaque(J); att::attn_unit_na(J, F.ldsg);
    }
#endif
#ifndef GQA_SKIP
    const int njobs = (amode & 1) ? ((l == 0 && bx < 16) ? 2 : 1) : 0;
#pragma unroll 1
    for (int k = 0; k < njobs; ++k) {
        att::Job J; J.mode = 0; J.row_b = 0; J.gr0 = 0; J.kstart = 0;
        int qc, kc, vc, oc, q0;
        if (k == 0) { const int b = x >> 2, kvh = (x >> 1) & 1, hq = kvh * 2 + (x & 1); q0 = b * TB + o * 256; qc = C_QA + hq * 128; kc = C_KA + kvh * 128; vc = C_VA + kvh * 128; oc = hq * 128; J.nt = TB / 64; J.row_a = b * TB; }
        else { const int b = bx >> 3, hh = bx & 7; q0 = b * TB + SEQ; J.nt = 4; J.row_a = q0;
            qc = hh < 4 ? C_QA + hh * 128 : C_QN + (hh - 4) * 128; kc = hh < 4 ? C_KA + (hh >> 1) * 128 : C_KN + (hh - 4) * 128; vc = hh < 4 ? C_VA + (hh >> 1) * 128 : C_VN + (hh - 4) * 128; oc = hh < 4 ? hh * 128 : 1536 + (hh - 4) * 128; }
        J.Q = fP(F) + (size_t)q0 * INW + qc; J.K = fP(F) + kc; J.V = fP(F) + vc; J.O = fMIX(F) + (size_t)q0 * DM + oc;
        att::opaque(J); att::attn_unit<0>(J, F.ldsg);
    }
#endif
#ifndef LRU2_SKIP
    if (amode & 4) lru_pass2(F, l);
#endif
}

__device__ __forceinline__ int moe_setup(const Frame& F, int l) {
    LAS int* tp = (LAS int*)(F.lds + LDS_MISC); LAS int* ud = (LAS int*)(F.lds + LDS_UD); LAS int* rows = (LAS int*)(F.lds + LDS_ROWS); LAS float* wts = (LAS float*)(F.lds + LDS_WTS);
    const int* cnt = fCNT(F) + l * 32;
    if (F.tid == 0) { int s = 0; for (int e = 0; e < NEXP; ++e) { tp[e] = s; s += (cnt[e] + 255) >> 8; } tp[NEXP] = s; }
    __syncthreads();
    const int total = tp[NEXP] * 8, cc = (F.bx % 8) * (F.G / 8) + F.bx / 8;
    if (F.tid < 8) { const int i = F.tid, L = i * F.G + cc; int e = -1, pn = 0, ml = 0, pm = 0, cv = 0;
        if (L < total) { e = 0; for (int j = 1; j < NEXP; ++j) e = (L >= tp[j] * 8) ? j : e; const int t0 = tp[e], te = tp[e + 1] - t0, rem = L - t0 * 8; pn = rem / te; ml = rem % te; pm = t0 + ml; cv = cnt[e]; }
        ud[i * 8 + 0] = e; ud[i * 8 + 1] = pn; ud[i * 8 + 2] = ml; ud[i * 8 + 3] = pm; ud[i * 8 + 4] = cv; }
    __syncthreads();
    for (int q = F.tid; q < 8 * 256; q += NTHR) { const int i = q >> 8, r = q & 255; const int e = ud[i * 8]; int d = -1; float w = 0.f;
        if (e >= 0) { const int idx = ud[i * 8 + 2] * 256 + r; if (idx < ud[i * 8 + 4]) { d = fLDEST(F)[e * CAP + idx]; w = fLW(F)[e * CAP + idx]; } }
        rows[q] = d; wts[q] = w; }
    __syncthreads();
    return total;
}

constexpr int N_PHASES = 18;
__global__ void __launch_bounds__(NTHR, 2) fwd_kernel(Params prm) {
    extern __shared__ __attribute__((aligned(16))) unsigned char lds_raw[];
    Frame F0; F0.p = &prm; F0.ws = nullptr; F0.lds = (LAS unsigned char*)lds_raw; F0.ldsg = (char*)lds_raw;
    F0.tid = threadIdx.x; F0.lane = F0.tid & 63; F0.wave = __builtin_amdgcn_readfirstlane(F0.tid >> 6); F0.bx = blockIdx.x; F0.G = gridDim.x;
    if (threadIdx.x < 4) ((LAS unsigned*)(F0.lds + LDS_BARW))[threadIdx.x] = 0u;
    __syncthreads();
    const int lo = prm.ph_lo, hi = prm.ph_hi;
    if (hi - lo > 1) (void)xcd_barrier_post((unsigned*)inp(F0, I_WS), (volatile LAS unsigned*)(F0.lds + LDS_BARW));
#ifndef BG_ON
#define BG_ON 1
#endif
#define DENSE_SHORT(nwg) ((((nwg) + F.G - 1) / F.G) - (((nwg) - F.bx + F.G - 1) / F.G))
#ifndef PH_MASK
#define PH_MASK 0xFFu
#endif
#define IN(k) (lo <= (k) && (k) < hi && ((PH_MASK >> ((k) == 0 ? 0 : (k) == 17 ? 0 : (((k) - 1) % 8))) & 1u))
#define GRIDBAR() do { XcdBarrier bar_; bar_.bar = (unsigned*)inp(F0, I_WS); bar_.x = xb_xcc_id(); bar_.st = (volatile LAS unsigned*)((LAS unsigned char*)lds_raw + LDS_BARW); xcd_barrier(bar_); } while (0)
#define SEAM(k) do { if (IN(k) && (IN((k) + 1) || rep_ + 1 < REPS(k))) GRIDBAR(); } while (0)
#ifndef DUP_PH
#define DUP_PH -1
#endif
#define REPS(k) (((k) == 0 ? 8 : (k) == 17 ? 9 : ((k) - 1) % 8) == DUP_PH ? 2 : 1)
#define PHASE_BEGIN(lv) Frame F; F.p = &prm; F.lds = (LAS unsigned char*)lds_raw; F.ldsg = (char*)lds_raw; F.ws = (unsigned char*)inp(F, I_WS); const int l = launder_i(lv); (void)l; { int tz_ = threadIdx.x; asm volatile("" : "+v"(tz_)); F.tid = tz_; F.lane = tz_ & 63; F.wave = __builtin_amdgcn_readfirstlane(tz_ >> 6); F.bx = launder_i(blockIdx.x); F.G = launder_i(gridDim.x); }
    if (IN(0)) for (int rep_ = 0; rep_ < REPS(0); ++rep_) { PHASE_BEGIN(0) p0_prologue(F); SEAM(0); }
#pragma unroll 1
    for (int l0 = 0; l0 < 2; ++l0) {
        const int pb = 1 + 8 * l0;
        if (IN(pb + 0)) for (int rep_ = 0; rep_ < REPS(pb + 0); ++rep_) { PHASE_BEGIN(l0) n1_phase(F, l, rep_ != 0); if (!rep_ && l == 1) bg_drain(F, P0_CV_L + CV_SMALL); SEAM(pb + 0); }
        if (IN(pb + 1)) for (int rep_ = 0; rep_ < REPS(pb + 1); ++rep_) { PHASE_BEGIN(l0)
            pg8::DenseOrder S; S.init(fHB(F), fWIN(F) + (size_t)l * INW * DM, MTOK / 256, INW / 256, DM * 2, F.G, F.bx, 0);
            pg8::EpiP E{fP(F)};
            pg8::gemm_phase<pg8::EpiP, pg8::DenseOrder, false, false>(F.lds, DM * 2, S, E);
            if (BG_ON && !rep_) bg_fill(F, DENSE_SHORT((MTOK / 256) * (INW / 256)) * 30);
            SEAM(pb + 1);
        }
        if (IN(pb + 2)) for (int rep_ = 0; rep_ < REPS(pb + 2); ++rep_) { PHASE_BEGIN(l0) if (!rep_) qknorm_phase(F, l); lru_units<false>(F, l); if (BG_ON && !rep_) bg_fill(F, F.bx >= 64 ? 4 : 0); SEAM(pb + 2); }
        if (IN(pb + 3)) for (int rep_ = 0; rep_ < REPS(pb + 3); ++rep_) { PHASE_BEGIN(l0) attn_phase(F, l, rep_); if (BG_ON && !rep_ && l == 0) bg_fill(F, (F.bx >= 16 ? 6 : 0) + (F.bx >= 64 ? 6 : 0)); SEAM(pb + 3); }
        if (IN(pb + 4)) for (int rep_ = 0; rep_ < REPS(pb + 4); ++rep_) { PHASE_BEGIN(l0)
            pg8::DenseOrder S; S.init(fMIX(F), fWOUT(F) + (size_t)l * DM * DM, l == 0 ? MTOK / 256 : NB * SEQ / 256, DM / 256, DM * 2, F.G, F.bx, l == 0 ? 0 : 1);
            pg8::EpiResid E{fX(F), fMOD(F) + (size_t)l * 3 * 12288, rep_ ? 0.0f : 1.0f};
            pg8::gemm_phase<pg8::EpiResid, pg8::DenseOrder, false, false>(F.lds, DM * 2, S, E);
            if (BG_ON && !rep_ && l == 0) bg_fill(F, DENSE_SHORT((MTOK / 256) * (DM / 256)) * 28);
            SEAM(pb + 4);
        }
        if (IN(pb + 5)) for (int rep_ = 0; rep_ < REPS(pb + 5); ++rep_) { PHASE_BEGIN(l0) n2_phase(F, l, rep_ != 0); if (!rep_) bg_drain(F, l == 0 ? P0_CV_L : CV_TOTAL); SEAM(pb + 5); }
        if (IN(pb + 6)) for (int rep_ = 0; rep_ < REPS(pb + 6); ++rep_) { PHASE_BEGIN(l0)
            const int mtotal = moe_setup(F, l);
            pg8::MoeOrder S; S.ud = (const LAS int*)(F.lds + LDS_UD); S.rows = (const LAS int*)(F.lds + LDS_ROWS); S.pitch = DM; S.A = (const char*)fHB8(F); S.Bt = (const char*)(fW1(F) + (size_t)l * NEXP * 2048 * DM);
            S.bstride = (size_t)2048 * DM; S.gather = 1;
            pg8::EpiSwiglu E{fACT(F)};
            pg8::gemm_phase<pg8::EpiSwiglu, pg8::MoeOrder, true, true>(F.lds, DM, S, E);
            if (BG_ON && !rep_ && l == 0) { const int cc = (F.bx % 8) * (F.G / 8) + F.bx / 8; bg_fill(F, (((mtotal + F.G - 1) / F.G) - ((mtotal - cc + F.G - 1) / F.G)) * 18); }
            SEAM(pb + 6);
        }
        if (IN(pb + 7)) for (int rep_ = 0; rep_ < REPS(pb + 7); ++rep_) { PHASE_BEGIN(l0)
            const int mtotal = moe_setup(F, l);
            pg8::MoeOrder S; S.ud = (const LAS int*)(F.lds + LDS_UD); S.rows = (const LAS int*)(F.lds + LDS_ROWS); S.pitch = HID; S.A = (const char*)fACT(F); S.Bt = (const char*)(fW2(F) + (size_t)l * NEXP * DM * HID);
            S.bstride = (size_t)DM * HID; S.gather = 0;
            pg8::EpiScatter E{fY(F), (const LAS int*)(F.lds + LDS_ROWS), (const LAS float*)(F.lds + LDS_WTS)};
            pg8::gemm_phase<pg8::EpiScatter, pg8::MoeOrder, false, true>(F.lds, HID, S, E);
            if (BG_ON && !rep_ && l == 0) { const int cc = (F.bx % 8) * (F.G / 8) + F.bx / 8; bg_fill(F, (((mtotal + F.G - 1) / F.G) - ((mtotal - cc + F.G - 1) / F.G)) * 12); }
            SEAM(pb + 7);
        }
    }
    if (IN(17)) for (int rep_ = 0; rep_ < REPS(17); ++rep_) { PHASE_BEGIN(2) fin_phase(F); if (rep_ + 1 < REPS(17)) GRIDBAR(); }
#undef IN
#undef SEAM
}

extern "C" void kernel_launch(void* const* d_in, const int* in_sizes, int n_in, void* d_out, int out_size, void* d_ws, size_t ws_size, hipStream_t stream) {
    static int ok = 0;
    if (ok == 0) {
        if (n_in != 28 || out_size != NB * SEQ * DM || ws_size < WS_END) { fprintf(stderr, "kernel_launch: shape mismatch: n_in %d out %d ws %zu (need %zu)\n", n_in, out_size, ws_size, (size_t)WS_END); ok = -1; return; }
        if (hipFuncSetAttribute((const void*)fwd_kernel, hipFuncAttributeMaxDynamicSharedMemorySize, LDS_BYTES) != hipSuccess) { fprintf(stderr, "kernel_launch: hipFuncSetAttribute failed\n"); ok = -1; return; }
        int per_cu = 0;
        if (hipOccupancyMaxActiveBlocksPerMultiprocessor(&per_cu, (const void*)fwd_kernel, NTHR, LDS_BYTES) != hipSuccess || per_cu < 1) fprintf(stderr, "kernel_launch: occupancy query says %d blocks per CU\n", per_cu);
        (void)hipGetLastError();
        ok = 1;
    }
    if (ok < 0) return;
    (void)hipMemsetAsync((char*)d_ws + WS_CTL, 0, CTL_BYTES, stream);
    Params prm{};
    for (int i = 0; i < 28; ++i) prm.in[i] = (const float*)d_in[i];
    prm.in[I_OUT] = (const float*)d_out; prm.in[I_WS] = (const float*)d_ws;
#if MK_N_LAUNCHES == 1
    prm.ph_lo = 0; prm.ph_hi = N_PHASES;
    hipLaunchKernelGGL(fwd_kernel, dim3(GRID), dim3(NTHR), LDS_BYTES, stream, prm);
#else
    for (int k = 0; k < N_PHASES; ++k) { prm.ph_lo = k; prm.ph_hi = k + 1; hipLaunchKernelGGL(fwd_kernel, dim3(GRID), dim3(NTHR), LDS_BYTES, stream, prm); }
#endif
    const hipError_t le = hipPeekAtLastError();
    if (le != hipSuccess) fprintf(stderr, "kernel_launch: launch failed: %s\n", hipGetErrorName(le));
}
```

```cpp
#include <hip/hip_runtime.h>
#include <stdint.h>
#include <stdio.h>

#ifndef MK_N_LAUNCHES
#define MK_N_LAUNCHES 1
#endif

#define LAS __attribute__((address_space(3)))
typedef unsigned short bf16_t;
typedef short bf16x8 __attribute__((ext_vector_type(8)));
typedef short s16x4 __attribute__((ext_vector_type(4)));
typedef float f32x2 __attribute__((ext_vector_type(2)));
typedef float f32x4 __attribute__((ext_vector_type(4)));
typedef float f32x16 __attribute__((ext_vector_type(16)));
typedef unsigned u32x2 __attribute__((ext_vector_type(2)));
typedef unsigned u32x4 __attribute__((ext_vector_type(4)));

constexpr int DM = 2048, NB = 2, SEQ = 8192, CTXL = 256, TB = SEQ + CTXL, MTOK = NB * TB;
constexpr int INW = 4608;
constexpr int C_QA = 0, C_KA = 512, C_VA = 768, C_UB = 1024, C_GB = 2048, C_QN = 3072, C_KN = 3584, C_VN = 4096;
constexpr int NEXP = 32, HID = 1024, CAP = MTOK, NCHUNK = TB / 64;
constexpr int PMAX = 2 * MTOK + NEXP * 256;
constexpr float EPS = 1e-6f;
constexpr int NTHR = 512;
constexpr int GRID = 256;

constexpr size_t al256(size_t x) { return (x + 255) / 256 * 256; }
constexpr size_t WS_CTL = 0, CTL_BYTES = 65536;
constexpr size_t CTL_CNT = 16384, CTL_Q = 20480;
constexpr size_t WS_MOD = WS_CTL + CTL_BYTES;
constexpr size_t WS_ROPE = WS_MOD + al256((size_t)2 * 3 * 12288 * 4);
constexpr size_t WS_WRT = WS_ROPE + 32768;
constexpr size_t WS_AGG = WS_WRT + al256((size_t)2 * 36 * 2048 * 4);
constexpr size_t WS_LDEST = WS_AGG + al256((size_t)2 * 2 * NCHUNK * 1024 * 8);
constexpr size_t WS_LW = WS_LDEST + al256((size_t)NEXP * CAP * 4);
constexpr size_t WS_X = WS_LW + al256((size_t)NEXP * CAP * 4);
constexpr size_t WS_HB = WS_X + al256((size_t)MTOK * DM * 4);
constexpr size_t WS_P = WS_HB + al256((size_t)MTOK * DM * 2);
constexpr size_t WS_MIX = WS_P + al256((size_t)MTOK * INW * 2);
constexpr size_t WS_ACT = WS_MIX + al256((size_t)MTOK * DM * 2);
constexpr size_t WS_Y = WS_ACT + al256((size_t)PMAX * HID * 2);
constexpr size_t WS_LAB = WS_Y + al256((size_t)MTOK * 2 * DM * 2);
constexpr size_t WS_WIN = WS_LAB + al256((size_t)NB * NCHUNK * 8 * 8 * 8 * 64 * 16);
constexpr size_t WS_WOUT = WS_WIN + al256((size_t)2 * INW * DM * 2);
constexpr size_t WS_LRUW = WS_WOUT + al256((size_t)2 * DM * DM * 2);
constexpr size_t WS_W1 = WS_LRUW + al256((size_t)2 * 2 * 8 * 2 * 128 * 128 * 2);
constexpr size_t WS_W2 = WS_W1 + al256((size_t)2 * NEXP * 2048 * DM);
constexpr size_t WS_END = WS_W2 + al256((size_t)2 * NEXP * DM * HID);

constexpr int LDS_STAGE = 131072;
constexpr int LDS_BARW = LDS_STAGE;
constexpr int LDS_MISC = LDS_STAGE + 64;
constexpr int LDS_UD = LDS_STAGE + 512;
constexpr int LDS_ROWS = LDS_STAGE + 1024;
constexpr int LDS_WTS = LDS_ROWS + 8192;
constexpr int LDS_BYTES = LDS_WTS + 8192;

struct Params { const float* in[30]; int ph_lo, ph_hi; };
enum { I_X = 0, I_C, I_CTX, I_CCTX, I_ADAW, I_ADAB, I_N1G, I_N2G, I_WIN, I_WOUT, I_QNORM, I_KNORM, I_CONVW, I_CONVB, I_LRUWR, I_LRUBR, I_LRUWI, I_LRUBI, I_LAM, I_RPB,
       I_RWG, I_RBG, I_RWE, I_RBE, I_MWG, I_MWU, I_MWD, I_FING, I_OUT, I_WS };

__device__ __forceinline__ unsigned cvt_pk_bf16(float lo, float hi) { unsigned r; asm volatile("v_cvt_pk_bf16_f32 %0, %1, %2" : "=v"(r) : "v"(lo), "v"(hi)); return r; }
__device__ __forceinline__ unsigned cvt_pk_fp8x4(float a, float b, float c, float d) { int w = 0; w = __builtin_amdgcn_cvt_pk_fp8_f32(a, b, w, false); w = __builtin_amdgcn_cvt_pk_fp8_f32(c, d, w, true); return (unsigned)w; }
__device__ __forceinline__ unsigned cvt_pk_fp8x4_sat(float a, float b, float c, float d) {
    return cvt_pk_fp8x4(__builtin_amdgcn_fmed3f(a, -448.f, 448.f), __builtin_amdgcn_fmed3f(b, -448.f, 448.f), __builtin_amdgcn_fmed3f(c, -448.f, 448.f), __builtin_amdgcn_fmed3f(d, -448.f, 448.f)); }
__device__ __forceinline__ float bflo(unsigned w) { return __uint_as_float(w << 16); }
__device__ __forceinline__ float bfhi(unsigned w) { return __uint_as_float(w & 0xffff0000u); }
__device__ __forceinline__ float wave_sum(float v) {
#pragma unroll
    for (int o = 32; o >= 1; o >>= 1) v += __shfl_xor(v, o);
    return v;
}
__device__ __forceinline__ float sigmoidf_(float x) { return __builtin_amdgcn_rcpf(1.0f + __expf(-x)); }
__device__ __forceinline__ float gelu_tanh(float x) { const float z = 0.7978845608028654f * (x + 0.044715f * x * x * x); const float e = __expf(2.0f * z); const float th = 1.0f - 2.0f * __builtin_amdgcn_rcpf(e + 1.0f); return 0.5f * x * (1.0f + th); }

#define XB_TMO      128
#define XB_XCNT(j)  (256  + 64 * (j))
#define XB_XSUB(j)  (1280 + 64 * (j))
#define XB_XGEN(j)  (2304 + 64 * (j))
#define XB_TOP      3328
#define XB_TOPGEN   3392
#define XCD_BAR_WORDS 3456
#define XB_SPIN_CAP (1u << 18)
__device__ __forceinline__ unsigned xb_ld(unsigned* p)              { return __hip_atomic_load(p, __ATOMIC_RELAXED, __HIP_MEMORY_SCOPE_AGENT); }
__device__ __forceinline__ unsigned xb_add(unsigned* p, unsigned v) { return __hip_atomic_fetch_add(p, v, __ATOMIC_RELAXED, __HIP_MEMORY_SCOPE_AGENT); }
__device__ __forceinline__ unsigned xb_xcc_id() { return (unsigned)__builtin_amdgcn_s_getreg((3 << 11) | 20) & 0xFu; }
#define XB_SPIN(cond, bar) do { unsigned _sp = 0; while (cond) { __builtin_amdgcn_s_sleep(1); \
    if ((++_sp & 255u) == 0u) { if (xb_ld(&(bar)[XB_TMO])) break; if (_sp > XB_SPIN_CAP) { atomicAdd(&(bar)[XB_TMO], 1u); break; } } } } while (0)
struct XcdBarrier { unsigned* bar; unsigned x; volatile LAS unsigned* st; };
__device__ __forceinline__ XcdBarrier xcd_barrier_post(unsigned* bar, volatile LAS unsigned* st) {
    XcdBarrier b; b.bar = bar; b.x = xb_xcc_id(); b.st = st;
    if (threadIdx.x == 0) (void)xb_add(&bar[XB_XCNT(b.x)], 1u);
    return b;
}
__device__ __forceinline__ void xcd_barrier_complete(unsigned* bar, unsigned x, unsigned& nloc, unsigned& nx) {
    const unsigned G = gridDim.x * gridDim.y * gridDim.z;
    unsigned sum, cnt, mine, sp = 0u;
    for (;;) {
        sum = 0u; cnt = 0u; mine = 0u;
#pragma unroll
        for (unsigned j = 0; j < 16; ++j) { const unsigned c = xb_ld(&bar[XB_XCNT(j)]); sum += c; cnt += (c > 0u) ? 1u : 0u; mine = (j == x) ? c : mine; }
        if (sum == G) break;
        __builtin_amdgcn_s_sleep(1);
        if ((++sp & 255u) == 0u) { if (xb_ld(&bar[XB_TMO])) break; if (sp > XB_SPIN_CAP) { atomicAdd(&bar[XB_TMO], 1u); break; } }
    }
    nloc = mine > 0u ? mine : 1u; nx = cnt > 0u ? cnt : 1u;
}
__device__ __forceinline__ void xcd_barrier(const XcdBarrier& b) {
    asm volatile("s_waitcnt vmcnt(0)" ::: "memory");
    __syncthreads();
    if (threadIdx.x == 0) {
        unsigned* bar = b.bar;
        __builtin_amdgcn_s_waitcnt(0);
        unsigned nloc = b.st[0], nx = b.st[1];
        if (nloc == 0u) { xcd_barrier_complete(bar, b.x, nloc, nx); b.st[0] = nloc; b.st[1] = nx; }
        const unsigned old = xb_add(&bar[XB_XSUB(b.x)], 1u);
        const unsigned gen = old / nloc;
        if (old + 1u == (gen + 1u) * nloc) {
            __builtin_amdgcn_fence(__ATOMIC_RELEASE, "agent");
            asm volatile("s_waitcnt vmcnt(0)" ::: "memory");
            const unsigned og = xb_add(&bar[XB_TOP], 1u);
            const unsigned tg = og / nx;
            if (og + 1u == (tg + 1u) * nx) xb_add(&bar[XB_TOPGEN], 1u);
            else XB_SPIN(xb_ld(&bar[XB_TOPGEN]) == tg, bar);
            __builtin_amdgcn_fence(__ATOMIC_ACQUIRE, "agent");
            xb_add(&bar[XB_XGEN(b.x)], 1u);
            asm volatile("s_waitcnt vmcnt(0)" ::: "memory");
        } else {
            XB_SPIN(xb_ld(&bar[XB_XGEN(b.x)]) == gen, bar);
            __builtin_amdgcn_fence(__ATOMIC_ACQUIRE, "agent");
            asm volatile("s_waitcnt vmcnt(0)" ::: "memory");
        }
    }
    __syncthreads();
}

namespace pg8 {
constexpr int BM = 256, BK = 64, HALF = 128, HTB = HALF * BK * 2, STAGE_BYTES = 8 * HTB, NXCD = 8, WGM = 8;
__device__ __forceinline__ int lds_byte(int r, int c) { const int st = (r >> 4) * 2 + (c >> 5), rr = r & 15, cc = c & 31, ob = rr * 64 + cc * 2; return st * 1024 + (ob ^ (((ob >> 9) & 1) << 5)); }
__device__ __forceinline__ void stage_rc(int b, int& R, int& C) { const int st = b / 1024, sb = b % 1024, swz = sb ^ (((sb >> 9) & 1) << 5); R = (st >> 1) * 16 + swz / 64; C = (st & 1) * 32 + (swz % 64) / 2; }
__device__ __forceinline__ int perm32(int rho) { const int n = rho >> 4, i = rho & 15; return 8 * (i >> 2) + 4 * n + (i & 3); }

struct Unit { int pm, pn, e, ml, cntv, ui; const char* A; const char* B; };

struct DenseOrder {
    int nM, nN, nwg, G, c, pitch, skip32; const char* A; const char* Bt;
    __device__ void init(const void* A_, const void* Bt_, int nM_, int nN_, int pitch_, int G_, int c_, int skip32_) { A = (const char*)A_; Bt = (const char*)Bt_; nM = nM_; nN = nN_; pitch = pitch_; nwg = nM * nN; G = G_; c = c_; skip32 = skip32_; }
    __device__ __forceinline__ bool next(int i, Unit& u) const {
        const long L = (long)i * G + c; if (L >= nwg) return false;
        int wgid = (int)L; { const int q = nwg / NXCD, r = nwg % NXCD, xcd = wgid % NXCD, off = wgid / NXCD; wgid = (xcd < r ? xcd * (q + 1) : r * (q + 1) + (xcd - r) * q) + off; }
        const int nig = WGM * nN, gid = wgid / nig, fm = gid * WGM, gsz = (nM - fm) < WGM ? (nM - fm) : WGM;
        int pm = fm + ((wgid % nig) % gsz); u.pn = (wgid % nig) / gsz; if (skip32) pm += pm >> 5; u.pm = pm; u.e = 0; u.ml = 0; u.cntv = 0; u.ui = 0;
        u.A = A + (size_t)pm * 256 * pitch; u.B = Bt + (size_t)u.pn * 256 * pitch; return true;
    }
    __device__ __forceinline__ unsigned grow(const Unit&, int) const { return 0u; }
};
struct MoeOrder {
    const LAS int* ud; const LAS int* rows; int pitch; const char* A; const char* Bt; size_t bstride; int gather;
    __device__ __forceinline__ bool next(int i, Unit& u) const {
        if (i >= 8) return false;
        const int e = __builtin_amdgcn_readfirstlane(ud[i * 8 + 0]); if (e < 0) return false;
        u.e = e; u.pn = __builtin_amdgcn_readfirstlane(ud[i * 8 + 1]); u.ml = __builtin_amdgcn_readfirstlane(ud[i * 8 + 2]); u.pm = __builtin_amdgcn_readfirstlane(ud[i * 8 + 3]); u.cntv = __builtin_amdgcn_readfirstlane(ud[i * 8 + 4]); u.ui = i;
        u.A = gather ? A : A + (size_t)u.pm * 256 * pitch; u.B = Bt + (size_t)e * bstride + (size_t)u.pn * 256 * pitch; return true;
    }
    __device__ __forceinline__ unsigned grow(const Unit& u, int r) const { const int d = rows[u.ui * 256 + r]; return d >= 0 ? (unsigned)(d >> 1) : 0u; }
};

typedef int i32x8 __attribute__((ext_vector_type(8)));
typedef int i32x4_ __attribute__((ext_vector_type(4)));
template <class Epi, class Sched, bool GATHER, bool FP8>
__device__ __forceinline__ void gemm_phase(LAS unsigned char* lds, const int pitch, const Sched& S, const Epi& E) {
    int tz = threadIdx.x; asm volatile("" : "+v"(tz));
    const int tid = tz, wid = __builtin_amdgcn_readfirstlane(tid >> 6), lane = tid & 63, wr = wid >> 2, wc = wid & 3, fr = lane & 15, fq = lane >> 4;
    const int nt = pitch / 128;
    unsigned voffA[2], voffB[2];
#pragma unroll
    for (int i = 0; i < 2; ++i) { int R, C; stage_rc(tid * 16 + i * 8192, R, C); const int Rb = Epi::PERM ? ((R & ~31) + perm32(R & 31)) : R;
        voffA[i] = (unsigned)(R * pitch + C * 2); voffB[i] = (unsigned)(Rb * pitch + C * 2); }
    const size_t kstep = (size_t)(BK * 2);
    const size_t hstep = (size_t)HALF * pitch;
    const unsigned ldsw = (unsigned)wid * 1024u;
    const int aoff = lds_byte(wr * 64 + fr, fq * 8), boff = lds_byte(wc * 32 + fr, fq * 8);
#define PG8_SA(b, h) (((b) * 2 + (h)) * HTB)
#define PG8_SB(b, h) ((4 + (b) * 2 + (h)) * HTB)
#define PG8_STAGE(bufoff, gbase, voff) do { _Pragma("unroll") for (int _i = 0; _i < 2; ++_i) \
        __builtin_amdgcn_global_load_lds((const unsigned*)((const char*)(gbase) + (voff)[_i]), (LAS unsigned*)(lds + (bufoff) + ldsw + _i * 8192), 16, 0, 0); } while (0)
#define PG8_STAGE_A(bufoff, gbase, h, nx) do { if (GATHER) { unsigned _v[2]; _v[0] = (nx) ? nG[h][0] : gA[h][0]; _v[1] = (nx) ? nG[h][1] : gA[h][1]; PG8_STAGE(bufoff, gbase, _v); } \
        else PG8_STAGE(bufoff, (gbase) + (h) * hstep, voffA); } while (0)
#define PG8_RD(off) (*(const LAS i32x4_*)(lds + (off)))
#define PG8_LDA(dst, b, h) do { _Pragma("unroll") for (int m = 0; m < 4; ++m) dst[m] = __builtin_shufflevector(PG8_RD(PG8_SA(b, h) + aoff + m * 2048), PG8_RD(PG8_SA(b, h) + aoff + m * 2048 + 1024), 0, 1, 2, 3, 4, 5, 6, 7); } while (0)
#define PG8_LDB(dst, b, h) do { _Pragma("unroll") for (int n = 0; n < 2; ++n) dst[n] = __builtin_shufflevector(PG8_RD(PG8_SB(b, h) + boff + n * 2048), PG8_RD(PG8_SB(b, h) + boff + n * 2048 + 1024), 0, 1, 2, 3, 4, 5, 6, 7); } while (0)
#define PG8_LO(x) __builtin_bit_cast(bf16x8, __builtin_shufflevector(x, x, 0, 1, 2, 3))
#define PG8_HI(x) __builtin_bit_cast(bf16x8, __builtin_shufflevector(x, x, 4, 5, 6, 7))
#define PG8_MMA(ai, bj, At, Bt) do { __builtin_amdgcn_s_setprio(1); \
        if (FP8) { _Pragma("unroll") for (int m = 0; m < 4; ++m) _Pragma("unroll") for (int n = 0; n < 2; ++n) \
            asm volatile("v_mfma_scale_f32_16x16x128_f8f6f4 %0, %1, %2, %0, %3, %3 op_sel_hi:[0,0,0]" : "+v"(acc[ai][bj][m][n]) : "v"(Bt[n]), "v"(At[m]), "v"(sc1)); } \
        else { _Pragma("unroll") for (int m = 0; m < 4; ++m) _Pragma("unroll") for (int n = 0; n < 2; ++n) { \
            acc[ai][bj][m][n] = __builtin_amdgcn_mfma_f32_16x16x32_bf16(PG8_LO(Bt[n]), PG8_LO(At[m]), acc[ai][bj][m][n], 0, 0, 0); \
            acc[ai][bj][m][n] = __builtin_amdgcn_mfma_f32_16x16x32_bf16(PG8_HI(Bt[n]), PG8_HI(At[m]), acc[ai][bj][m][n], 0, 0, 0); } } \
        __builtin_amdgcn_s_setprio(0); } while (0)
#define PG8_WAIT_V(n) asm volatile("s_waitcnt vmcnt(" #n ")" ::: "memory")
#define PG8_WAIT_L(n) asm volatile("s_waitcnt lgkmcnt(" #n ")" ::: "memory")
#define PG8_BAR __builtin_amdgcn_s_barrier()
#define PG8_SCHED __builtin_amdgcn_sched_barrier(0)
    Unit cur, nxt; int ui = 0;
    if (!S.next(0, cur)) return;
    unsigned gA[2][2] = {{0u, 0u}, {0u, 0u}}, nG[2][2] = {{0u, 0u}, {0u, 0u}};
    if (GATHER) {
#pragma unroll
        for (int h = 0; h < 2; ++h)
#pragma unroll
            for (int i = 0; i < 2; ++i) { int R, C; stage_rc(tid * 16 + i * 8192, R, C); gA[h][i] = S.grow(cur, h * HALF + R) * (unsigned)pitch + (unsigned)C * 2u; }
    }
    f32x4 acc[2][2][4][2];
#pragma unroll
    for (int a = 0; a < 2; ++a)
#pragma unroll
        for (int b = 0; b < 2; ++b)
#pragma unroll
            for (int m = 0; m < 4; ++m)
#pragma unroll
                for (int n = 0; n < 2; ++n) acc[a][b][m][n] = (f32x4){0.f, 0.f, 0.f, 0.f};
    i32x8 At[4], B0[2], B1[2];
    int sc1 = 0x7F7F7F7F; asm volatile("" : "+v"(sc1));
    const char* cA = cur.A; const char* cB = cur.B;
    PG8_STAGE(PG8_SB(0, 0), cB, voffB); PG8_STAGE_A(PG8_SA(0, 0), cA, 0, false); PG8_STAGE(PG8_SB(0, 1), cB + hstep, voffB); PG8_STAGE_A(PG8_SA(0, 1), cA, 1, false);
    if (wr == 1) PG8_BAR;
    PG8_WAIT_V(4); PG8_BAR;
    PG8_STAGE(PG8_SB(1, 0), cB + kstep, voffB); PG8_STAGE_A(PG8_SA(1, 0), cA + kstep, 0, false); PG8_STAGE(PG8_SB(1, 1), cB + hstep + kstep, voffB);
    PG8_WAIT_V(6); PG8_BAR;
    for (;;) {
        const bool has_next = S.next(ui + 1, nxt);
        const char* nA = has_next ? nxt.A : cA; const char* nB = has_next ? nxt.B : cB;
        if (GATHER) {
#pragma unroll
            for (int h = 0; h < 2; ++h)
#pragma unroll
                for (int i = 0; i < 2; ++i) { int tg = threadIdx.x; asm volatile("" : "+v"(tg)); int R, C; stage_rc(tg * 16 + i * 8192, R, C); nG[h][i] = has_next ? S.grow(nxt, h * HALF + R) * (unsigned)pitch + (unsigned)C * 2u : gA[h][i]; }
        }
#pragma unroll 1
        for (int t = 0; t < nt; t += 2) {
            const bool last = (t == nt - 2);
            const char* a1 = cA + (size_t)(t + 1) * kstep;
            const char* a2 = last ? nA : cA + (size_t)(t + 2) * kstep; const char* b2 = last ? nB : cB + (size_t)(t + 2) * kstep;
            const char* a3 = a2 + kstep; const char* b3 = b2 + kstep;
            PG8_LDB(B0, 0, 0); PG8_SCHED; PG8_LDA(At, 0, 0); PG8_STAGE_A(PG8_SA(1, 1), a1, 1, false);
            PG8_WAIT_L(8); PG8_BAR; PG8_WAIT_L(0); PG8_MMA(0, 0, At, B0); PG8_BAR; PG8_SCHED;
            PG8_LDB(B1, 0, 1); PG8_STAGE(PG8_SB(0, 0), b2, voffB);
            PG8_BAR; PG8_WAIT_L(0); PG8_MMA(0, 1, At, B1); PG8_BAR;
            PG8_LDA(At, 0, 1); PG8_STAGE_A(PG8_SA(0, 0), a2, 0, last);
            PG8_BAR; PG8_WAIT_L(0); PG8_MMA(1, 0, At, B0); PG8_BAR; PG8_SCHED;
            PG8_STAGE(PG8_SB(0, 1), b2 + hstep, voffB);
            PG8_WAIT_V(6); PG8_BAR; PG8_MMA(1, 1, At, B1); PG8_BAR;
            PG8_LDB(B0, 1, 0); PG8_SCHED; PG8_LDA(At, 1, 0); PG8_STAGE_A(PG8_SA(0, 1), a2, 1, last);
            PG8_WAIT_L(8); PG8_BAR; PG8_WAIT_L(0); PG8_MMA(0, 0, At, B0); PG8_BAR; PG8_SCHED;
            PG8_LDB(B1, 1, 1); PG8_STAGE(PG8_SB(1, 0), b3, voffB);
            PG8_BAR; PG8_WAIT_L(0); PG8_MMA(0, 1, At, B1); PG8_BAR;
            PG8_LDA(At, 1, 1); PG8_STAGE_A(PG8_SA(1, 0), a3, 0, last);
            PG8_BAR; PG8_WAIT_L(0); PG8_MMA(1, 0, At, B0); PG8_BAR; PG8_SCHED;
            PG8_STAGE(PG8_SB(1, 1), b3 + hstep, voffB);
            PG8_WAIT_V(6); PG8_BAR; PG8_MMA(1, 1, At, B1); PG8_BAR;
        }
        if (FP8) asm volatile("s_nop 15\n\ts_nop 15\n\ts_nop 15" ::: "memory");
        { int te = threadIdx.x; asm volatile("" : "+v"(te)); const int le = te & 63; E(acc, cur, wr, wc, le & 15, le >> 4); }
        if (!has_next) break;
#pragma unroll
        for (int a = 0; a < 2; ++a)
#pragma unroll
            for (int b = 0; b < 2; ++b)
#pragma unroll
                for (int m = 0; m < 4; ++m)
#pragma unroll
                    for (int n = 0; n < 2; ++n) acc[a][b][m][n] = (f32x4){0.f, 0.f, 0.f, 0.f};
        cur = nxt; cA = nA; cB = nB; ++ui;
        if (GATHER) {
#pragma unroll
            for (int h = 0; h < 2; ++h)
#pragma unroll
                for (int i = 0; i < 2; ++i) gA[h][i] = nG[h][i];
        }
    }
    PG8_WAIT_V(0);
    if (wr == 0) PG8_BAR;
    PG8_BAR;
#undef PG8_SA
#undef PG8_SB
#undef PG8_STAGE
#undef PG8_STAGE_A
#undef PG8_LDA
#undef PG8_LDB
#undef PG8_MMA
#undef PG8_RD
#undef PG8_LO
#undef PG8_HI
#undef PG8_WAIT_V
#undef PG8_WAIT_L
#undef PG8_BAR
#undef PG8_SCHED
}

struct EpiP {
    static constexpr bool PERM = true;
    bf16_t* O;
    __device__ __forceinline__ void operator()(const f32x4 (&acc)[2][2][4][2], const Unit& u, int wr, int wc, int fr, int fq) const {
        const int row0 = u.pm * BM + wr * 64 + fr, col0 = u.pn * BM + wc * 32 + 8 * fq;
#pragma unroll
        for (int ai = 0; ai < 2; ++ai)
#pragma unroll
            for (int m = 0; m < 4; ++m) { bf16_t* rowp = O + (size_t)(row0 + ai * HALF + m * 16) * INW + col0;
#pragma unroll
                for (int bj = 0; bj < 2; ++bj) { const f32x4 v0 = acc[ai][bj][m][0], v1 = acc[ai][bj][m][1];
                    u32x4 w; w.x = cvt_pk_bf16(v0[0], v0[1]); w.y = cvt_pk_bf16(v0[2], v0[3]); w.z = cvt_pk_bf16(v1[0], v1[1]); w.w = cvt_pk_bf16(v1[2], v1[3]);
                    *(u32x4*)(rowp + bj * HALF) = w; } }
    }
};
struct EpiResid {
    static constexpr bool PERM = true;
    bf16_t* X; const float* mod; float scale;
    __device__ __forceinline__ void operator()(const f32x4 (&acc)[2][2][4][2], const Unit& u, int wr, int wc, int fr, int fq) const {
        const int row0 = u.pm * BM + wr * 64 + fr, col0 = u.pn * BM + wc * 32 + 8 * fq;
        const int sel = (u.pm % 33 == 32) ? 2 : u.pm / 33;
        const float* gv = mod + sel * 12288 + 4096;
        f32x4 g[2][2];
#pragma unroll
        for (int bj = 0; bj < 2; ++bj)
#pragma unroll
            for (int n = 0; n < 2; ++n) g[bj][n] = *(const f32x4*)(gv + col0 + bj * HALF + n * 4) * scale;
#pragma unroll
        for (int ai = 0; ai < 2; ++ai)
#pragma unroll
            for (int m = 0; m < 4; ++m) { bf16_t* rowp = X + (size_t)(row0 + ai * HALF + m * 16) * DM + col0;
#pragma unroll
                for (int bj = 0; bj < 2; ++bj) { u32x4* q = (u32x4*)(rowp + bj * HALF); const u32x4 xw = *q;
                    const f32x4 v0 = (f32x4){bflo(xw.x), bfhi(xw.x), bflo(xw.y), bfhi(xw.y)} + g[bj][0] * acc[ai][bj][m][0], v1 = (f32x4){bflo(xw.z), bfhi(xw.z), bflo(xw.w), bfhi(xw.w)} + g[bj][1] * acc[ai][bj][m][1];
                    u32x4 w; w.x = cvt_pk_bf16(v0[0], v0[1]); w.y = cvt_pk_bf16(v0[2], v0[3]); w.z = cvt_pk_bf16(v1[0], v1[1]); w.w = cvt_pk_bf16(v1[2], v1[3]); *q = w; } }
    }
};
struct EpiSwiglu {
    static constexpr bool PERM = true;
    unsigned char* ACT;
    __device__ __forceinline__ void operator()(const f32x4 (&acc)[2][2][4][2], const Unit& u, int wr, int wc, int fr, int fq) const {
        const int row0 = u.pm * BM + wr * 64 + fr, col0 = u.pn * HALF + wc * 32 + 8 * fq;
#pragma unroll
        for (int ai = 0; ai < 2; ++ai)
#pragma unroll
            for (int m = 0; m < 4; ++m) { unsigned char* rowp = ACT + (size_t)(row0 + ai * HALF + m * 16) * HID + col0;
                float o[8];
#pragma unroll
                for (int n = 0; n < 2; ++n)
#pragma unroll
                    for (int j = 0; j < 4; ++j) { const float g = acc[ai][0][m][n][j] * 0.00390625f, up = acc[ai][1][m][n][j] * 0.00390625f; o[n * 4 + j] = g * sigmoidf_(g) * up; }
                u32x2 w; w.x = cvt_pk_fp8x4_sat(o[0], o[1], o[2], o[3]); w.y = cvt_pk_fp8x4_sat(o[4], o[5], o[6], o[7]);
                *(u32x2*)rowp = w; }
    }
};
struct EpiScatter {
    static constexpr bool PERM = true;
    unsigned char* Y; const LAS int* rows; const LAS float* wts;
    __device__ __forceinline__ void operator()(const f32x4 (&acc)[2][2][4][2], const Unit& u, int wr, int wc, int fr, int fq) const {
        const int r0 = wr * 64 + fr, col0 = u.pn * BM + wc * 32 + 8 * fq;
#pragma unroll
        for (int ai = 0; ai < 2; ++ai)
#pragma unroll
            for (int m = 0; m < 4; ++m) { const int r = r0 + ai * HALF + m * 16; const int dest = rows[u.ui * 256 + r];
                if (dest >= 0) { const float w_ = wts[u.ui * 256 + r] * 0.0625f; unsigned char* rowp = Y + (size_t)dest * DM + col0;
#pragma unroll
                    for (int bj = 0; bj < 2; ++bj) { const f32x4 v0 = acc[ai][bj][m][0] * w_, v1 = acc[ai][bj][m][1] * w_;
                        u32x2 w; w.x = cvt_pk_fp8x4_sat(v0[0], v0[1], v0[2], v0[3]); w.y = cvt_pk_fp8x4_sat(v1[0], v1[1], v1[2], v1[3]);
                        *(u32x2*)(rowp + bj * HALF) = w; } } }
    }
};
}

namespace att {
constexpr int D = 128, NW = 8, QBLK = 32, KVBLK = 64;
constexpr float SCALE = 0.088388347648318440f;
constexpr float THR = 8.f;
constexpr int LDP = INW;
constexpr int LDO = DM;
constexpr size_t SHM_V = KVBLK * D * 2, SHM_K = KVBLK * D * 2, SHM_ATTN = 2 * SHM_V + 2 * SHM_K + NW * 64 * 4;
constexpr int RPB_OFF = (int)SHM_ATTN;
#define KSWZ(row, colB) ((row) * 256 + ((colB) ^ (((row) & 7) << 4)))
#define SBAR() __builtin_amdgcn_sched_barrier(0)
__device__ __forceinline__ int crow(int r, int hi) { return (r & 3) + 8 * (r >> 2) + 4 * hi; }

__device__ __forceinline__ void partialSM(f32x16& p0, f32x16& p1, float& m_reg, float& mn, float& alpha) {
  constexpr float C = SCALE * 1.4426950408889634f;
  float pmax = p0[0]; for (int r = 1; r < 16; ++r) pmax = fmaxf(pmax, p0[r]); for (int r = 0; r < 16; ++r) pmax = fmaxf(pmax, p1[r]);
  { auto rr = __builtin_amdgcn_permlane32_swap(__float_as_uint(pmax), __float_as_uint(pmax), false, false);
    pmax = fmaxf(__uint_as_float(rr[0]), __uint_as_float(rr[1])); }
  if (__builtin_expect(__all(pmax - m_reg <= THR / SCALE), 1)) { mn = m_reg; alpha = 1.f; }
  else { mn = fmaxf(m_reg, pmax); alpha = __builtin_amdgcn_exp2f((m_reg - mn) * C); m_reg = mn; }
  float mnC = -mn * C;
  for (int r = 0; r < 16; ++r) p0[r] = fmaf(p0[r], C, mnC); for (int r = 0; r < 16; ++r) p1[r] = fmaf(p1[r], C, mnC);
  for (int r = 0; r < 16; ++r) p0[r] = __builtin_amdgcn_exp2f(p0[r]);
}
__device__ __forceinline__ void finishSM(f32x16& p0, f32x16& p1, float alpha, float& l_reg, bf16x8& pa0, bf16x8& pa1, bf16x8& pa2, bf16x8& pa3) {
  for (int r = 0; r < 16; ++r) p1[r] = __builtin_amdgcn_exp2f(p1[r]);
  float ps = 0; for (int r = 0; r < 16; ++r) ps += p0[r]; for (int r = 0; r < 16; ++r) ps += p1[r];
  { auto rr = __builtin_amdgcn_permlane32_swap(__float_as_uint(ps), __float_as_uint(ps), false, false);
    ps = __uint_as_float(rr[0]) + __uint_as_float(rr[1]); }
  l_reg = l_reg * alpha + ps;
#define PK4(P, BASE, OUT) do { unsigned a0 = cvt_pk_bf16(P[BASE + 0], P[BASE + 1]), a1 = cvt_pk_bf16(P[BASE + 2], P[BASE + 3]);   \
    unsigned b0 = cvt_pk_bf16(P[BASE + 4], P[BASE + 5]), b1 = cvt_pk_bf16(P[BASE + 6], P[BASE + 7]);                              \
    auto r0 = __builtin_amdgcn_permlane32_swap(a0, b0, false, false); auto r1 = __builtin_amdgcn_permlane32_swap(a1, b1, false, false); \
    u32x4 w = {r0[0], r1[0], r0[1], r1[1]}; OUT = *reinterpret_cast<bf16x8*>(&w); } while (0)
  PK4(p0, 0, pa0); PK4(p0, 8, pa1); PK4(p1, 0, pa2); PK4(p1, 8, pa3);
#undef PK4
}
__device__ __forceinline__ void qkt(f32x16& p0, f32x16& p1, const bf16_t* Ks, const bf16x8* qr, int r32, int hi) {
  p0 = f32x16{}; p1 = f32x16{};
  for (int d0 = 0; d0 < 8; ++d0) { int cb = (d0 * 16 + hi * 8) * 2;
    bf16x8 b0 = *reinterpret_cast<const bf16x8*>((const char*)Ks + KSWZ(r32, cb));
    bf16x8 b1 = *reinterpret_cast<const bf16x8*>((const char*)Ks + KSWZ(32 + r32, cb));
    p0 = __builtin_amdgcn_mfma_f32_32x32x16_bf16(b0, qr[d0], p0, 0, 0, 0);
    p1 = __builtin_amdgcn_mfma_f32_32x32x16_bf16(b1, qr[d0], p1, 0, 0, 0); }
}
__device__ __forceinline__ int v_st(int k, int c) { const int kk = (k & ~0xC) | ((k & 4) << 1) | ((k & 8) >> 1); return ((kk >> 3) * 4 + (c >> 5)) * 512 + ((kk & 7) * 32 + (c & 31)) * 2; }
__device__ __forceinline__ int v_rd_base(int lane) { return ((lane & 3) << 3) | (((lane >> 2) & 3) << 6) | (((lane >> 4) & 1) << 5) | (((lane >> 5) & 1) << 8); }
constexpr int v_rd_off(int d0, int ks, int half) { return d0 * 512 + ks * 4096 + half * 2048; }
template <int OFF> __device__ __forceinline__ s16x4 tr_read(int vb) {
  s16x4 r; asm volatile("ds_read_b64_tr_b16 %0, %1 offset:%2" : "=&v"(r) : "v"(vb), "i"(OFF) : "memory"); return r;
}
template <int D0> __device__ __forceinline__ void pv_one(f32x16& od, int vb, bf16x8 pa0, bf16x8 pa1, bf16x8 pa2, bf16x8 pa3) {
  const s16x4 l0 = tr_read<v_rd_off(D0, 0, 0)>(vb), h0 = tr_read<v_rd_off(D0, 0, 1)>(vb), l1 = tr_read<v_rd_off(D0, 1, 0)>(vb), h1 = tr_read<v_rd_off(D0, 1, 1)>(vb);
  const s16x4 l2 = tr_read<v_rd_off(D0, 2, 0)>(vb), h2 = tr_read<v_rd_off(D0, 2, 1)>(vb), l3 = tr_read<v_rd_off(D0, 3, 0)>(vb), h3 = tr_read<v_rd_off(D0, 3, 1)>(vb);
  asm volatile("s_waitcnt lgkmcnt(0)" ::: "memory"); SBAR();
#define PK(L, H) (bf16x8){L[0], L[1], L[2], L[3], H[0], H[1], H[2], H[3]}
  od = __builtin_amdgcn_mfma_f32_32x32x16_bf16(pa0, PK(l0, h0), od, 0, 0, 0);
  od = __builtin_amdgcn_mfma_f32_32x32x16_bf16(pa1, PK(l1, h1), od, 0, 0, 0);
  od = __builtin_amdgcn_mfma_f32_32x32x16_bf16(pa2, PK(l2, h2), od, 0, 0, 0);
  od = __builtin_amdgcn_mfma_f32_32x32x16_bf16(pa3, PK(l3, h3), od, 0, 0, 0);
#undef PK
}
__device__ __forceinline__ void pv_d0(f32x16* o, int vb, bf16x8 pa0, bf16x8 pa1, bf16x8 pa2, bf16x8 pa3) {
  pv_one<0>(o[0], vb, pa0, pa1, pa2, pa3); pv_one<1>(o[1], vb, pa0, pa1, pa2, pa3); pv_one<2>(o[2], vb, pa0, pa1, pa2, pa3); pv_one<3>(o[3], vb, pa0, pa1, pa2, pa3);
}

struct Job { const bf16_t* Q; const bf16_t* K; const bf16_t* V; bf16_t* O; int nt, mode, row_a, row_b, gr0, kstart; };
__device__ __forceinline__ int ufy(int v) { v = __builtin_amdgcn_readfirstlane(v); asm volatile("" : "+s"(v)); return v; }
template <class T> __device__ __forceinline__ T* ufyp(T* q) { unsigned long long a = (unsigned long long)q; unsigned lo = __builtin_amdgcn_readfirstlane((unsigned)a), hi = __builtin_amdgcn_readfirstlane((unsigned)(a >> 32)); asm volatile("" : "+s"(lo), "+s"(hi)); return (T*)(((unsigned long long)hi << 32) | lo); }
__device__ __forceinline__ void opaque(Job& J) { J.Q = ufyp(J.Q); J.K = ufyp(J.K); J.V = ufyp(J.V); J.O = ufyp(J.O); J.nt = ufy(J.nt); J.row_a = ufy(J.row_a); J.row_b = ufy(J.row_b); J.gr0 = ufy(J.gr0); J.kstart = ufy(J.kstart); }

template <int MODE> __device__ __forceinline__ void na_mask(f32x16& p0, f32x16& p1, const Job& J, int t, int wid, int r32, int hi, const float* rpb) {
  if (MODE == 1 && t >= 4) {
    const int r = J.gr0 + (wid >> 1), j = ((wid & 1) << 5) + r32, kr = J.kstart + t - 4;
    const int rs = min(max(r - 4, 0), 120), cs = min(max(j - 8, 0), 48);
    const bool rowok = (kr >= rs) && (kr < rs + 8);
    const int base = (kr - r + 7) * 31 - j + 15;
#pragma unroll
    for (int q = 0; q < 16; ++q) {
      const int c0 = crow(q, hi), c1 = c0 + 32;
      const bool in0 = rowok && ((unsigned)(c0 - cs) < 16u), in1 = rowok && ((unsigned)(c1 - cs) < 16u);
      const float b0 = rpb[in0 ? base + c0 : 0], b1 = rpb[in1 ? base + c1 : 0];
      p0[q] = in0 ? p0[q] + b0 : -1e30f; p1[q] = in1 ? p1[q] + b1 : -1e30f;
    }
  }
}

template <int MODE> __device__ __forceinline__ void attn_unit(const Job& J, char* lds) {
  int tz = threadIdx.x; asm volatile("" : "+v"(tz));
  const int tid = tz, wid = tid >> 6, lane = tid & 63, r32 = lane & 31, hi = lane >> 5;
  bf16_t* V_lds = (bf16_t*)lds; bf16_t* K_lds = (bf16_t*)(lds + 2 * SHM_V);
  float* ws = (float*)(lds + 2 * SHM_V + 2 * SHM_K) + wid * 64; float* li_l = ws; float* al_l = ws + 32;
  const float* rpb = (const float*)(lds + RPB_OFF);
  float m_reg = -1e30f, l_reg = 0; f32x16 o[4] = {}; bf16x8 qr[8];
  const bf16_t* Qw = J.Q + (long)(wid * QBLK + r32) * LDP + hi * 8;
#pragma unroll
  for (int d0 = 0; d0 < 8; ++d0) qr[d0] = *reinterpret_cast<const bf16x8*>(Qw + d0 * 16);
  const int sr = tid >> 4, sc = (tid & 15) * 8, vst0 = v_st(sr, sc), vst1 = v_st(32 + sr, sc);
  const int vb0 = (int)(uintptr_t)V_lds + v_rd_base(lane);
  struct { bf16x8 vs0, vs1, ks0, ks1; } sr_[2];
#define TROW(t) ((MODE == 1 && (t) >= 4) ? (J.row_b + 64 * ((t) - 4)) : (J.row_a + 64 * (t)))
#define SLOAD(i, t) do { const long _r0 = (long)(TROW(t) + sr) * LDP + sc; sr_[i].vs0 = *reinterpret_cast<const bf16x8*>(J.V + _r0); sr_[i].vs1 = *reinterpret_cast<const bf16x8*>(J.V + _r0 + 32L * LDP); \
    sr_[i].ks0 = *reinterpret_cast<const bf16x8*>(J.K + _r0); sr_[i].ks1 = *reinterpret_cast<const bf16x8*>(J.K + _r0 + 32L * LDP); } while (0)
#define SWRITE(b, i) do { *(bf16x8*)((char*)V_lds + (b) * SHM_V + vst0) = sr_[i].vs0;          \
    *(bf16x8*)((char*)V_lds + (b) * SHM_V + vst1) = sr_[i].vs1; int kc = sc * 2;               \
    *(bf16x8*)((char*)K_lds + (b) * SHM_K + KSWZ(sr, kc)) = sr_[i].ks0;                       \
    *(bf16x8*)((char*)K_lds + (b) * SHM_K + KSWZ(32 + sr, kc)) = sr_[i].ks1; } while (0)
#define SWAIT() asm volatile("s_waitcnt vmcnt(4)" ::: "memory")
#define RESC(a) do { if (__any((a) < 1.f)) { if (hi == 0) al_l[r32] = (a); asm volatile("s_waitcnt lgkmcnt(0)" ::: "memory"); \
    for (int d = 0; d < 4; ++d) for (int r = 0; r < 16; ++r) o[d][r] *= al_l[crow(r, hi)]; } } while (0)
  f32x16 pA0, pA1, pB0, pB1; float mnA, mnB, alA, alB; bf16x8 pa0, pa1, pa2, pa3; int NT = J.nt; asm volatile("" : "+s"(NT));
  constexpr int SE = 0, SO = 1;
  SLOAD(SE, 0); asm volatile("s_waitcnt vmcnt(0)" ::: "memory"); SWRITE(0, SE); __syncthreads();
  qkt(pA0, pA1, K_lds, qr, r32, hi); na_mask<MODE>(pA0, pA1, J, 0, wid, r32, hi, rpb); partialSM(pA0, pA1, m_reg, mnA, alA);
  SLOAD(SO, 1); if (2 < NT) SLOAD(SE, 2);
  SWAIT(); SWRITE(1, SO); __syncthreads();
#pragma unroll 1
  for (int j = 1; j + 1 < NT; j += 2) {
    SBAR(); qkt(pB0, pB1, (bf16_t*)((char*)K_lds + SHM_K), qr, r32, hi);
    finishSM(pA0, pA1, alA, l_reg, pa0, pa1, pa2, pa3); SBAR();
    SLOAD(SO, min(j + 2, NT - 1)); SBAR();
    pv_d0(o, vb0, pa0, pa1, pa2, pa3); na_mask<MODE>(pB0, pB1, J, j, wid, r32, hi, rpb); partialSM(pB0, pB1, m_reg, mnB, alB);
    __syncthreads(); SWAIT(); SWRITE(0, SE);
    RESC(alB); __syncthreads();
    SBAR(); qkt(pA0, pA1, K_lds, qr, r32, hi);
    finishSM(pB0, pB1, alB, l_reg, pa0, pa1, pa2, pa3); SBAR();
    if (j + 3 < NT) SLOAD(SE, j + 3); SBAR();
    pv_d0(o, vb0 + (int)SHM_V, pa0, pa1, pa2, pa3); na_mask<MODE>(pA0, pA1, J, j + 1, wid, r32, hi, rpb); partialSM(pA0, pA1, m_reg, mnA, alA);
    __syncthreads(); SWAIT(); SWRITE(1, SO);
    RESC(alA); __syncthreads();
  }
  SBAR(); qkt(pB0, pB1, (bf16_t*)((char*)K_lds + SHM_K), qr, r32, hi);
  finishSM(pA0, pA1, alA, l_reg, pa0, pa1, pa2, pa3); SBAR();
  pv_d0(o, vb0, pa0, pa1, pa2, pa3); na_mask<MODE>(pB0, pB1, J, NT - 1, wid, r32, hi, rpb); partialSM(pB0, pB1, m_reg, mnB, alB);
  __syncthreads(); RESC(alB);
  finishSM(pB0, pB1, alB, l_reg, pa0, pa1, pa2, pa3); SBAR();
  pv_d0(o, vb0 + (int)SHM_V, pa0, pa1, pa2, pa3);
  if (hi == 0) li_l[r32] = l_reg; asm volatile("s_waitcnt lgkmcnt(0)" ::: "memory");
  float rli[16];
#pragma unroll
  for (int r = 0; r < 16; ++r) rli[r] = __builtin_amdgcn_rcpf(li_l[crow(r, hi)]);
  bf16_t* Ow = J.O + (long)(wid * QBLK) * LDO;
#pragma unroll
  for (int r = 0; r < 16; ++r) { int orow = crow(r, hi);
    for (int d0 = 0; d0 < 4; ++d0) Ow[(long)orow * LDO + d0 * 32 + r32] = (bf16_t)(cvt_pk_bf16(o[d0][r] * rli[r], 0.f) & 0xffffu); }
  asm volatile("s_waitcnt vmcnt(0)" ::: "memory");
  __syncthreads();
#undef TROW
#undef SLOAD
#undef SWRITE
#undef SWAIT
#undef RESC
}

__device__ __forceinline__ void attn_unit_na(const Job& J, char* lds) {
  int tz = threadIdx.x; asm volatile("" : "+v"(tz));
  const int tid = tz, wid = tid >> 6, lane = tid & 63, r32 = lane & 31, hi = lane >> 5;
  bf16_t* V_lds = (bf16_t*)lds; bf16_t* K_lds = (bf16_t*)(lds + 2 * SHM_V);
  float* ws = (float*)(lds + 2 * SHM_V + 2 * SHM_K) + wid * 64; float* li_l = ws; float* al_l = ws + 32;
  const float* rpb = (const float*)(lds + RPB_OFF);
  float m_reg = -1e30f, l_reg = 0; f32x16 o[4] = {}; bf16x8 qr[8];
  const bf16_t* Qw = J.Q + (long)(wid * QBLK + r32) * LDP + hi * 8;
#pragma unroll
  for (int d0 = 0; d0 < 8; ++d0) qr[d0] = *reinterpret_cast<const bf16x8*>(Qw + d0 * 16);
  const int sr = tid >> 4, sc = (tid & 15) * 8, vst0 = v_st(sr, sc), vst1 = v_st(32 + sr, sc);
  const int vb0 = (int)(uintptr_t)V_lds + v_rd_base(lane);
  bf16x8 vs0, vs1, ks0, ks1;
#define TROW(t) (((t) >= 4) ? (J.row_b + 64 * ((t) - 4)) : (J.row_a + 64 * (t)))
#define SLOAD(t) do { const long _r0 = (long)(TROW(t) + sr) * LDP + sc; vs0 = *reinterpret_cast<const bf16x8*>(J.V + _r0); vs1 = *reinterpret_cast<const bf16x8*>(J.V + _r0 + 32L * LDP); \
    ks0 = *reinterpret_cast<const bf16x8*>(J.K + _r0); ks1 = *reinterpret_cast<const bf16x8*>(J.K + _r0 + 32L * LDP); } while (0)
#define SWRITE(b) do { *(bf16x8*)((char*)V_lds + (b) * SHM_V + vst0) = vs0; *(bf16x8*)((char*)V_lds + (b) * SHM_V + vst1) = vs1; int kc = sc * 2;               \
    *(bf16x8*)((char*)K_lds + (b) * SHM_K + KSWZ(sr, kc)) = ks0; *(bf16x8*)((char*)K_lds + (b) * SHM_K + KSWZ(32 + sr, kc)) = ks1; } while (0)
  SLOAD(0); asm volatile("s_waitcnt vmcnt(0)" ::: "memory"); SWRITE(0); __syncthreads();
  const int NT = J.nt;
#pragma unroll 1
  for (int t = 0; t < NT; ++t) {
    const int bsel = t & 1;
    if (t + 1 < NT) SLOAD(t + 1);
    bool active = true;
    if (t >= 4) { const int r = J.gr0 + (wid >> 1), kr = J.kstart + t - 4, rs = min(max(r - 4, 0), 120); active = (kr >= rs) && (kr < rs + 8); }
    if (active) {
    f32x16 p0, p1; float mn, al; bf16x8 pa0, pa1, pa2, pa3;
    qkt(p0, p1, (bf16_t*)((char*)K_lds + bsel * SHM_K), qr, r32, hi);
    na_mask<1>(p0, p1, J, t, wid, r32, hi, rpb);
    partialSM(p0, p1, m_reg, mn, al);
    if (__any(al < 1.f)) { if (hi == 0) al_l[r32] = al; asm volatile("s_waitcnt lgkmcnt(0)" ::: "memory");
      for (int d = 0; d < 4; ++d) for (int r = 0; r < 16; ++r) o[d][r] *= al_l[crow(r, hi)]; }
    finishSM(p0, p1, al, l_reg, pa0, pa1, pa2, pa3); SBAR();
    pv_d0(o, vb0 + bsel * (int)SHM_V, pa0, pa1, pa2, pa3);
    }
    if (t + 1 < NT) { asm volatile("s_waitcnt vmcnt(0)" ::: "memory"); SWRITE(bsel ^ 1); }
    __syncthreads();
  }
  if (hi == 0) li_l[r32] = l_reg; asm volatile("s_waitcnt lgkmcnt(0)" ::: "memory");
  float rli[16];
#pragma unroll
  for (int r = 0; r < 16; ++r) rli[r] = __builtin_amdgcn_rcpf(li_l[crow(r, hi)]);
  bf16_t* Ow = J.O + (long)(wid * QBLK) * LDO;
#pragma unroll
  for (int r = 0; r < 16; ++r) { int orow = crow(r, hi);
    for (int d0 = 0; d0 < 4; ++d0) Ow[(long)orow * LDO + d0 * 32 + r32] = (bf16_t)(cvt_pk_bf16(o[d0][r] * rli[r], 0.f) & 0xffffu); }
  asm volatile("s_waitcnt vmcnt(0)" ::: "memory");
  __syncthreads();
#undef TROW
#undef SLOAD
#undef SWRITE
}
}

struct Frame {
    const Params* p; unsigned char* ws; LAS unsigned char* lds; char* ldsg; int tid, lane, wave, bx, G;
};
__device__ __forceinline__ const float* inp(const Frame& F, int i) { i = __builtin_amdgcn_readfirstlane(i); asm volatile("" : "+s"(i)); return F.p->in[i]; }
__device__ __forceinline__ unsigned char* launder_ws(unsigned char* q) { unsigned long long a = (unsigned long long)q; unsigned lo = (unsigned)a, hi = (unsigned)(a >> 32); asm volatile("" : "+s"(lo), "+s"(hi)); return (unsigned char*)(((unsigned long long)hi << 32) | lo); }
__device__ __forceinline__ int launder_i(int v) { asm volatile("" : "+s"(v)); return v; }
#define FACC(name, type, off) __device__ __forceinline__ type* name(const Frame& F) { return (type*)(F.ws + (off)); }
FACC(fMOD, float, WS_MOD) FACC(fROPE, float, WS_ROPE) FACC(fWRT, float, WS_WRT) FACC(fAGG, f32x2, WS_AGG) FACC(fLDEST, int, WS_LDEST) FACC(fLW, float, WS_LW) FACC(fX, bf16_t, WS_X)
FACC(fHB, bf16_t, WS_HB) FACC(fHB8, unsigned char, WS_HB) FACC(fP, bf16_t, WS_P) FACC(fMIX, bf16_t, WS_MIX) FACC(fACT, unsigned char, WS_ACT) FACC(fY, unsigned char, WS_Y) FACC(fWIN, bf16_t, WS_WIN) FACC(fWOUT, bf16_t, WS_WOUT)
FACC(fLAB, u32x4, WS_LAB) FACC(fLRUW, bf16_t, WS_LRUW) FACC(fW1, unsigned char, WS_W1) FACC(fW2, unsigned char, WS_W2) FACC(fCNT, int, WS_CTL + CTL_CNT)

constexpr int P0_CV_L = 26304;
struct CvtDesc { const float* src; void* dst; int ldsrc, lddst, f8; };
__device__ __forceinline__ CvtDesc cvt_desc(const Frame& F, int l, int r) {
    CvtDesc d; d.f8 = 0;
    if (r < 1152) { const int kt = r / 72, nt = r % 72; d.src = inp(F, I_WIN) + ((size_t)l * 2048 + kt * 128) * INW + nt * 64; d.ldsrc = INW; d.dst = fWIN(F) + ((size_t)l * INW + nt * 64) * DM + kt * 128; d.lddst = DM; }
    else if (r < 1664) { r -= 1152; const int kt = r / 32, nt = r % 32; d.src = inp(F, I_WOUT) + ((size_t)l * 2048 + kt * 128) * DM + nt * 64; d.ldsrc = DM; d.dst = fWOUT(F) + ((size_t)l * DM + nt * 64) * DM + kt * 128; d.lddst = DM; }
    else if (r < 1664 + 16384) { r -= 1664; const int up = r >= 8192; r -= up * 8192; const int e = r >> 8, t = r & 255, kt = t >> 4, nt = t & 15, n0 = nt * 64;
        d.src = inp(F, up ? I_MWU : I_MWG) + ((size_t)(l * NEXP + e) * 2048 + kt * 128) * HID + n0; d.ldsrc = HID;
        const int drow = 256 * (n0 >> 7) + (n0 & 127) + up * 128; d.dst = fW1(F) + ((size_t)(l * NEXP + e) * 2048 + drow) * DM + kt * 128; d.lddst = DM; d.f8 = 1; }
    else if (r < 1664 + 24576) { r -= 1664 + 16384; const int e = r >> 8, t = r & 255, kt = t >> 5, nt = t & 31;
        d.src = inp(F, I_MWD) + ((size_t)(l * NEXP + e) * HID + kt * 128) * DM + nt * 64; d.ldsrc = DM; d.dst = fW2(F) + ((size_t)(l * NEXP + e) * DM + nt * 64) * HID + kt * 128; d.lddst = HID; d.f8 = 1; }
    else { r -= 1664 + 24576; const int mat = r >> 1, nt = r & 1, gate = mat >> 4, dd = (mat >> 3) & 1, n = mat & 7;
        d.src = inp(F, gate ? I_LRUWI : I_LRUWR) + ((size_t)((l * 2 + dd) * 8 + n) * 128) * 128 + nt * 64; d.ldsrc = 128;
        d.dst = fLRUW(F) + ((size_t)(((l * 2 + dd) * 8 + n) * 2 + gate) * 128 + nt * 64) * 128; d.lddst = 128; }
    return d;
}
__device__ __forceinline__ CvtDesc cvt_desc_g(const Frame& F, int g) {
    const int l = g >= P0_CV_L ? 1 : 0, sidx = g - l * P0_CV_L;
    const int r = sidx < 1664 ? sidx : (sidx < 1728 ? 26240 + (sidx - 1664) : sidx - 64);
    return cvt_desc(F, l, r);
}
__device__ __forceinline__ void cvt_run(const Frame& F, int first, int stride, int end, LAS float* T) {
    const int tid = F.tid, kk = tid >> 4, n4 = tid & 15, wv = tid >> 6, lane = tid & 63;
    if (first >= end) return;
    f32x4 v[4]; CvtDesc d = cvt_desc_g(F, first);
#pragma unroll
    for (int q = 0; q < 4; ++q) v[q] = __builtin_nontemporal_load((const f32x4*)(d.src + (size_t)(q * 32 + kk) * d.ldsrc + n4 * 4));
    int buf = 0;
#pragma unroll 1
    for (int r = first; r < end; r += stride, buf ^= 1) {
        LAS float* Tb = T + buf * (128 * 65);
#pragma unroll
        for (int q = 0; q < 4; ++q) { const int kr = q * 32 + kk; LAS float* w = Tb + kr * 65 + ((n4 * 4) ^ ((kr >> 4) << 2)); w[0] = v[q][0]; w[1] = v[q][1]; w[2] = v[q][2]; w[3] = v[q][3]; }
        const CvtDesc dc = d;
        if (r + stride < end) { d = cvt_desc_g(F, r + stride);
#pragma unroll
            for (int q = 0; q < 4; ++q) v[q] = __builtin_nontemporal_load((const f32x4*)(d.src + (size_t)(q * 32 + kk) * d.ldsrc + n4 * 4)); }
        __syncthreads();
        if (dc.f8) {
            const int nn = wv * 8 + (lane >> 3), k0 = (lane & 7) * 16; float x[16];
#pragma unroll
            for (int j = 0; j < 16; ++j) x[j] = Tb[(k0 + j) * 65 + (nn ^ ((k0 >> 4) << 2))] * 256.0f;
            *(u32x4*)((unsigned char*)dc.dst + (size_t)nn * dc.lddst + k0) = (u32x4){cvt_pk_fp8x4(x[0], x[1], x[2], x[3]), cvt_pk_fp8x4(x[4], x[5], x[6], x[7]), cvt_pk_fp8x4(x[8], x[9], x[10], x[11]), cvt_pk_fp8x4(x[12], x[13], x[14], x[15])};
        } else {
            const int rr = lane >> 4, k0 = (lane & 15) * 8;
#pragma unroll
            for (int i = 0; i < 2; ++i) { const int nn = wv * 8 + i * 4 + rr; float x[8];
#pragma unroll
                for (int j = 0; j < 8; ++j) x[j] = Tb[(k0 + j) * 65 + (nn ^ ((k0 >> 4) << 2))];
                *(u32x4*)((bf16_t*)dc.dst + (size_t)nn * dc.lddst + k0) = (u32x4){cvt_pk_bf16(x[0], x[1]), cvt_pk_bf16(x[2], x[3]), cvt_pk_bf16(x[4], x[5]), cvt_pk_bf16(x[6], x[7])}; }
        }
    }
    __syncthreads();
}
constexpr int CV_SMALL = 1728, CV_TOTAL = 2 * P0_CV_L;
constexpr int BG_T = 49152;
__device__ __forceinline__ int bg_claim(const Frame& F, int n) {
    LAS int* slot = (LAS int*)(F.lds + LDS_MISC + 256);
    __syncthreads();
    if (F.tid == 0) *slot = __hip_atomic_fetch_add((int*)(F.ws + WS_CTL + CTL_Q), n, __ATOMIC_RELAXED, __HIP_MEMORY_SCOPE_AGENT);
    __syncthreads();
    return *slot;
}
__device__ __forceinline__ void bg_fill(const Frame& F, int quota) {
    if (quota <= 0) return;
    const int g0 = bg_claim(F, quota); if (g0 >= CV_TOTAL) return;
    cvt_run(F, g0, 1, min(g0 + quota, CV_TOTAL), (LAS float*)(F.lds + BG_T));
}
__device__ __forceinline__ void bg_drain(const Frame& F, int target) {
    for (;;) { const int g0 = bg_claim(F, 6); if (g0 >= CV_TOTAL) break; cvt_run(F, g0, 1, min(g0 + 6, CV_TOTAL), (LAS float*)(F.lds + BG_T)); if (g0 + 6 >= target) break; }
}
constexpr int P0_ADA = 384, P0_RT = 96, P0_ROPE = 1, P0_UNITS = P0_ADA + P0_RT + P0_ROPE;
__device__ __forceinline__ void p0_prologue(const Frame& F) {
    const Params& p = *F.p; const int tid = F.tid;
    LAS float* sv = (LAS float*)F.lds;
    LAS float* part = (LAS float*)(F.lds + 24576);
    LAS float* T = (LAS float*)(F.lds + 49152);
    for (int i = tid; i < 3 * 2048; i += NTHR) { const float c = i < 4096 ? inp(F, I_C)[i] : inp(F, I_CCTX)[i - 4096]; sv[i] = c / (1.0f + __expf(-c)); }
    __syncthreads();
    for (int u = F.bx; u < P0_UNITS; u += F.G) {
        if (u < P0_ADA) {
            const int l = u / 192, col0 = (u % 192) * 64, c4 = tid & 15, ks = tid >> 4;
            const float* W = inp(F, I_ADAW) + ((size_t)l * 2048 + ks * 64) * 12288 + col0 + c4 * 4;
            f32x4 a0 = {0, 0, 0, 0}, a1 = a0, a2 = a0;
#pragma unroll 8
            for (int k = 0; k < 64; ++k) { const f32x4 w = __builtin_nontemporal_load((const f32x4*)(W + (size_t)k * 12288)); const float s0 = sv[ks * 64 + k], s1 = sv[2048 + ks * 64 + k], s2 = sv[4096 + ks * 64 + k];
                a0 += w * s0; a1 += w * s1; a2 += w * s2; }
#pragma unroll
            for (int j = 0; j < 4; ++j) { part[(ks * 3 + 0) * 64 + c4 * 4 + j] = a0[j]; part[(ks * 3 + 1) * 64 + c4 * 4 + j] = a1[j]; part[(ks * 3 + 2) * 64 + c4 * 4 + j] = a2[j]; }
            __syncthreads();
            if (tid < 192) { const int v = tid >> 6, c = tid & 63; float s = 0.f;
#pragma unroll
                for (int k = 0; k < 32; ++k) s += part[(k * 3 + v) * 64 + c];
                fMOD(F)[(size_t)(l * 3 + v) * 12288 + col0 + c] = s + inp(F, I_ADAB)[(size_t)l * 12288 + col0 + c]; }
            __syncthreads();
        } else if (u < P0_ADA + P0_RT) {
            const int q = u - P0_ADA, l = q / 48, j = q % 48; bf16_t* wrb = (bf16_t*)fWRT(F);
            for (int k = tid; k < 2048; k += NTHR) { const float v = j < 4 ? inp(F, I_RWG)[((size_t)l * 2048 + k) * 4 + j] : (j < 36 ? inp(F, I_RWE)[((size_t)l * 2048 + k) * 32 + (j - 4)] : 0.f);
                wrb[(size_t)(l * 48 + j) * 2048 + k] = (bf16_t)(cvt_pk_bf16(v, 0.f) & 0xffffu); }
        } else if (u < P0_ADA + P0_RT + P0_ROPE) {
            for (int i = tid; i < 4096; i += NTHR) { const int pos = i >> 5, f = i & 31; const double inv = exp(-9.210340371976184 * (double)f / 32.0); const double ang = (double)pos * inv;
                fROPE(F)[i] = (float)cos(ang); fROPE(F)[4096 + i] = (float)sin(ang); }
        }
    }
    __syncthreads();
    bg_drain(F, CV_SMALL);
}

__device__ __forceinline__ const float* mod_vec(const Frame& F, int l, int row) { const int b = row / TB, t = row - b * TB; return fMOD(F) + (size_t)(l * 3 + (t >= SEQ ? 2 : b)) * 12288; }
typedef u32x4 RowRaw[8];
__device__ __forceinline__ void load_raw(const Frame& F, int l, int row, RowRaw& r) {
    const int lane = F.lane; const int b = row / TB, t = row - b * TB;
    if (l == 0) { const float* src = t >= SEQ ? inp(F, I_CTX) + ((size_t)b * CTXL + (t - SEQ)) * DM : inp(F, I_X) + ((size_t)b * SEQ + t) * DM;
#pragma unroll
        for (int j = 0; j < 8; ++j) r[j] = *(const u32x4*)(src + j * 256 + lane * 4);
    } else { const bf16_t* xr = fX(F) + (size_t)row * DM; const unsigned char* y0 = fY(F) + (size_t)row * 2 * DM; const unsigned char* y1 = y0 + DM;
#pragma unroll
        for (int j = 0; j < 8; ++j) { const int c = j * 256 + lane * 4; const u32x2 xw = *(const u32x2*)(xr + c); r[j] = (u32x4){xw.x, xw.y, *(const unsigned*)(y0 + c), *(const unsigned*)(y1 + c)}; } }
}
__device__ __forceinline__ void finish_raw(const Frame& F, int l, int row, const RowRaw& r, f32x4 (&xv)[8]) {
    const int lane = F.lane;
    if (l == 0) {
#pragma unroll
        for (int j = 0; j < 8; ++j) xv[j] = __builtin_bit_cast(f32x4, r[j]);
    } else { const float* g = mod_vec(F, l - 1, row) + 10240;
#pragma unroll
        for (int j = 0; j < 8; ++j) { const int c = j * 256 + lane * 4; const f32x4 x = {bflo(r[j].x), bfhi(r[j].x), bflo(r[j].y), bfhi(r[j].y)}, gg = *(const f32x4*)(g + c);
            const unsigned a = r[j].z, bb = r[j].w;
            const f32x2 a0 = __builtin_amdgcn_cvt_pk_f32_fp8((int)a, false), a1 = __builtin_amdgcn_cvt_pk_f32_fp8((int)a, true), b0 = __builtin_amdgcn_cvt_pk_f32_fp8((int)bb, false), b1 = __builtin_amdgcn_cvt_pk_f32_fp8((int)bb, true);
            f32x4 y; y[0] = a0[0] + b0[0]; y[1] = a0[1] + b0[1]; y[2] = a1[0] + b1[0]; y[3] = a1[1] + b1[1]; xv[j] = x + gg * (y * 0.0625f); } }
}
__device__ __forceinline__ float row_rstd(const f32x4 (&xv)[8]) { float s = 0.f;
#pragma unroll
    for (int j = 0; j < 8; ++j) s += xv[j][0] * xv[j][0] + xv[j][1] * xv[j][1] + xv[j][2] * xv[j][2] + xv[j][3] * xv[j][3];
    s = wave_sum(s); return rsqrtf(s * (1.0f / DM) + EPS); }

__device__ __forceinline__ void n1_phase(const Frame& F, int l, bool dry) {
    const int lane = F.lane, stride = F.G * 8;
    int row = F.bx * 8 + F.wave; RowRaw cur, nxt;
    if (row < MTOK) load_raw(F, l, row, cur);
#pragma unroll 1
    for (; row < MTOK; row += stride) {
        const bool hn = row + stride < MTOK;
        if (hn) load_raw(F, l, row + stride, nxt);
        f32x4 xv[8]; finish_raw(F, l, row, cur, xv);
        bf16_t* xo = (dry ? fP(F) : fX(F)) + (size_t)row * DM;
#pragma unroll
        for (int j = 0; j < 8; ++j) { u32x2 w; w.x = cvt_pk_bf16(xv[j][0], xv[j][1]); w.y = cvt_pk_bf16(xv[j][2], xv[j][3]); *(u32x2*)(xo + j * 256 + lane * 4) = w; }
        const float rstd = row_rstd(xv); const float* mv = mod_vec(F, l, row); const float* g = inp(F, I_N1G) + (size_t)l * DM; bf16_t* ho = (dry ? fMIX(F) : fHB(F)) + (size_t)row * DM;
#pragma unroll
        for (int j = 0; j < 8; ++j) { const int c = j * 256 + lane * 4; const f32x4 gg = *(const f32x4*)(g + c), sh = *(const f32x4*)(mv + c), sc = *(const f32x4*)(mv + 2048 + c);
            const f32x4 h = xv[j] * rstd * gg * (sc + 1.0f) + sh; u32x2 w; w.x = cvt_pk_bf16(h[0], h[1]); w.y = cvt_pk_bf16(h[2], h[3]); *(u32x2*)(ho + c) = w; }
#pragma unroll
        for (int j = 0; j < 8; ++j) cur[j] = nxt[j];
    }
}
__device__ __forceinline__ void fin_phase(const Frame& F) {
    const int lane = F.lane, stride = F.G * 8;
    int q = F.bx * 8 + F.wave; RowRaw cur, nxt;
#define FIN_ROW(qq) (((qq) / SEQ) * TB + ((qq) % SEQ))
    if (q < NB * SEQ) load_raw(F, 2, FIN_ROW(q), cur);
#pragma unroll 1
    for (; q < NB * SEQ; q += stride) {
        const bool hn = q + stride < NB * SEQ;
        if (hn) load_raw(F, 2, FIN_ROW(q + stride), nxt);
        f32x4 xv[8]; finish_raw(F, 2, FIN_ROW(q), cur, xv);
        const float rstd = row_rstd(xv); const float* g = inp(F, I_FING); float* o = (float*)inp(F, I_OUT) + (size_t)q * DM;
#pragma unroll
        for (int j = 0; j < 8; ++j) { const int c = j * 256 + lane * 4; *(f32x4*)(o + c) = xv[j] * rstd * *(const f32x4*)(g + c); }
#pragma unroll
        for (int j = 0; j < 8; ++j) cur[j] = nxt[j];
    }
#undef FIN_ROW
}

constexpr int N2_T = 0, N2_TP = 2056, N2_RED = 16 * N2_TP * 2, N2_LG = N2_RED + 8 * 16 * 48 * 4, N2_CTL = N2_LG + 16 * 48 * 4;
__device__ __forceinline__ void n2_phase(const Frame& F, int l, bool dry) {
    const int lane = F.lane, tid = F.tid, wave = F.wave;
    LAS bf16_t* T = (LAS bf16_t*)(F.lds + N2_T); LAS float* RED = (LAS float*)(F.lds + N2_RED); LAS float* LG = (LAS float*)(F.lds + N2_LG);
    LAS int* lc = (LAS int*)(F.lds + N2_CTL);
    LAS int* gb = lc + 32;
    LAS int* ri = gb + 32;
    LAS float* rw = (LAS float*)(ri + 66 * 4);
    if (tid < 32) lc[tid] = 0;
    __syncthreads();
    const int r0 = F.bx * 66;
    const bf16_t* wrb = (const bf16_t*)fWRT(F) + (size_t)l * 48 * 2048;
    const float* g = inp(F, I_N2G) + (size_t)l * DM; const float* rbg = inp(F, I_RBG) + l * 4; const float* rbe = inp(F, I_RBE) + l * 32;
    bf16x8 WA[8][3];
    { const int fr_ = lane & 15, kq_ = lane >> 4;
#pragma unroll
      for (int s8 = 0; s8 < 8; ++s8)
#pragma unroll
          for (int t3 = 0; t3 < 3; ++t3) WA[s8][t3] = *(const bf16x8*)(wrb + (size_t)(t3 * 16 + fr_) * 2048 + (wave * 8 + s8) * 32 + kq_ * 8); }
    u32x2 xraw[2][8];
#define N2_LOADX(ubv) do { _Pragma("unroll") for (int q2 = 0; q2 < 2; ++q2) { const int rr_ = wave * 2 + q2, row_ = r0 + (ubv) + rr_; const int t_ = row_ % TB; \
        const bool ok_ = ((ubv) + rr_ < 66) && !(l == 1 && t_ >= SEQ); const bf16_t* xr_ = fX(F) + (size_t)row_ * DM; \
        _Pragma("unroll") for (int j = 0; j < 8; ++j) xraw[q2][j] = ok_ ? *(const u32x2*)(xr_ + j * 256 + lane * 4) : (u32x2){0u, 0u}; } } while (0)
    N2_LOADX(0);
#pragma unroll 1
    for (int ub = 0; ub < 66; ub += 16) {
        const int nrow = min(16, 66 - ub);
#pragma unroll
        for (int q2 = 0; q2 < 2; ++q2) {
            const int rr = wave * 2 + q2;
            const int i = ub + rr, row = r0 + i; const int b = row / TB, t = row - b * TB;
            const bool ok = (rr < nrow) && !(l == 1 && t >= SEQ);
            if (ok) {
            f32x4 xv[8];
#pragma unroll
            for (int j = 0; j < 8; ++j) { const u32x2 xw = xraw[q2][j]; xv[j] = (f32x4){bflo(xw.x), bfhi(xw.x), bflo(xw.y), bfhi(xw.y)}; }
            const float rstd = row_rstd(xv); const float* mv = mod_vec(F, l, row); unsigned char* ho = fHB8(F) + (size_t)row * DM;
#pragma unroll
            for (int j = 0; j < 8; ++j) { const int c = j * 256 + lane * 4; const f32x4 gg = *(const f32x4*)(g + c), sh = *(const f32x4*)(mv + 6144 + c), sc = *(const f32x4*)(mv + 8192 + c);
                const f32x4 h = xv[j] * rstd * gg * (sc + 1.0f) + sh; u32x2 w; w.x = cvt_pk_bf16(h[0], h[1]); w.y = cvt_pk_bf16(h[2], h[3]); *(unsigned*)(ho + c) = cvt_pk_fp8x4_sat(h[0], h[1], h[2], h[3]); *(LAS u32x2*)(T + rr * N2_TP + c) = w; }
            }
        }
        if (ub + 16 < 66) N2_LOADX(ub + 16);
        __syncthreads();
        { const int fr = lane & 15, kq = lane >> 4;
          f32x4 acc[3] = {{0, 0, 0, 0}, {0, 0, 0, 0}, {0, 0, 0, 0}};
#pragma unroll
          for (int s = 0; s < 8; ++s) { const int k0 = (wave * 8 + s) * 32 + kq * 8;
              const bf16x8 tb = *(const LAS bf16x8*)(T + fr * N2_TP + k0);
#pragma unroll
              for (int t3 = 0; t3 < 3; ++t3) acc[t3] = __builtin_amdgcn_mfma_f32_16x16x32_bf16(WA[s][t3], tb, acc[t3], 0, 0, 0); }
#pragma unroll
          for (int t3 = 0; t3 < 3; ++t3) *(LAS f32x4*)(RED + (wave * 16 + fr) * 48 + t3 * 16 + kq * 4) = acc[t3]; }
        __syncthreads();
        for (int q = tid; q < 16 * 48; q += NTHR) { float s = 0.f;
#pragma unroll
            for (int w = 0; w < 8; ++w) s += RED[w * 768 + q];
            const int e = q % 48; LG[q] = s + (e < 4 ? rbg[e] : (e < 36 ? rbe[e - 4] : 0.f)); }
        __syncthreads();
        if (tid < nrow) {
            const int i = ub + tid, row = r0 + i; const int b = row / TB, t = row - b * TB;
            if (l == 1 && t >= SEQ) ri[i * 4] = -1;
            else {
                const LAS float* lg = LG + tid * 48;
                int gs = 0; float gm = lg[0];
#pragma unroll
                for (int k = 1; k < 4; ++k) if (lg[k] > gm) { gm = lg[k]; gs = k; }
                float den = 0.f;
#pragma unroll
                for (int k = 0; k < 4; ++k) den += __expf(lg[k] - gm);
                const float ggate = 1.0f / den;
                const LAS float* le = lg + 4 + gs * 8;
                int i0 = 0; float v0 = le[0];
#pragma unroll
                for (int k = 1; k < 8; ++k) if (le[k] > v0) { v0 = le[k]; i0 = k; }
                int i1 = -1; float v1 = -3.0e38f;
#pragma unroll
                for (int k = 0; k < 8; ++k) if (k != i0 && le[k] > v1) { v1 = le[k]; i1 = k; }
                const float e1 = __expf(v1 - v0), w0 = ggate / (1.0f + e1), w1 = ggate * e1 / (1.0f + e1);
                const int ex0 = gs * 8 + i0, ex1 = gs * 8 + i1;
                const int lp0 = __hip_atomic_fetch_add(lc + ex0, 1, __ATOMIC_RELAXED, __HIP_MEMORY_SCOPE_WORKGROUP), lp1 = __hip_atomic_fetch_add(lc + ex1, 1, __ATOMIC_RELAXED, __HIP_MEMORY_SCOPE_WORKGROUP);
                ri[i * 4 + 0] = ex0; ri[i * 4 + 1] = ex1; ri[i * 4 + 2] = lp0; ri[i * 4 + 3] = lp1; rw[i * 2] = w0; rw[i * 2 + 1] = w1;
            }
        }
    }
#undef N2_LOADX
    __syncthreads();
    if (dry) { __syncthreads(); return; }
    if (tid < 32) { const int c = lc[tid]; gb[tid] = c > 0 ? __hip_atomic_fetch_add(fCNT(F) + l * 32 + tid, c, __ATOMIC_RELAXED, __HIP_MEMORY_SCOPE_AGENT) : 0; }
    __syncthreads();
    if (tid < 66 && ri[tid * 4] >= 0) { const int row = r0 + tid;
#pragma unroll
        for (int k = 0; k < 2; ++k) { const int e = ri[tid * 4 + k]; const size_t pos = (size_t)e * CAP + gb[e] + ri[tid * 4 + 2 + k]; fLDEST(F)[pos] = row * 2 + k; fLW(F)[pos] = rw[tid * 2 + k]; } }
    __syncthreads();
}

__device__ __forceinline__ void qknorm_phase(const Frame& F, int l) {
    const int lane = F.lane, li = lane & 15;
    const float* COS = fROPE(F); const float* SIN = fROPE(F) + 4096;
    const float* gqp = inp(F, I_QNORM) + l * 128 + li * 8; const float* gkp = inp(F, I_KNORM) + l * 128 + li * 8;
    const f32x4 gq0 = *(const f32x4*)gqp, gq1 = *(const f32x4*)(gqp + 4), gk0 = *(const f32x4*)gkp, gk1 = *(const f32x4*)(gkp + 4);
    const int half = (li >> 2) & 1, axis = li >> 3;
#pragma unroll 1
    for (int row = (F.bx * 8 + F.wave) * 4 + (lane >> 4); row < MTOK; row += F.G * 32) {
        bf16_t* base = fP(F) + (size_t)row * INW + li * 8;
        u32x4 raw[6];
#pragma unroll
        for (int sl = 0; sl < 6; ++sl) raw[sl] = *(const u32x4*)(base + (sl < 4 ? C_QA + sl * 128 : C_KA + (sl - 4) * 128));
        const int t = row % TB; const bool rope = t < SEQ;
        const int pos = axis ? (t & 63) : (t >> 6); const int fb = (rope ? pos : 0) * 32 + (li & 3) * 8;
        const f32x4 c0 = *(const f32x4*)(COS + fb), c1 = *(const f32x4*)(COS + fb + 4), s0 = *(const f32x4*)(SIN + fb), s1 = *(const f32x4*)(SIN + fb + 4);
#pragma unroll
        for (int sl = 0; sl < 6; ++sl) {
            const u32x4 rw = raw[sl];
            float v[8] = {bflo(rw.x), bfhi(rw.x), bflo(rw.y), bfhi(rw.y), bflo(rw.z), bfhi(rw.z), bflo(rw.w), bfhi(rw.w)};
            float ss = 0.f;
#pragma unroll
            for (int e = 0; e < 8; ++e) ss += v[e] * v[e];
            ss += __shfl_xor(ss, 1); ss += __shfl_xor(ss, 2); ss += __shfl_xor(ss, 4); ss += __shfl_xor(ss, 8);
            const float rstd = rsqrtf(ss * (1.0f / 128.0f) + EPS);
            const f32x4 g0 = sl < 4 ? gq0 : gk0, g1 = sl < 4 ? gq1 : gk1;
#pragma unroll
            for (int e = 0; e < 4; ++e) { v[e] = v[e] * rstd * g0[e]; v[4 + e] = v[4 + e] * rstd * g1[e]; }
            float pr[8];
#pragma unroll
            for (int e = 0; e < 8; ++e) pr[e] = __shfl_xor(v[e], 4);
            if (rope) {
#pragma unroll
                for (int e = 0; e < 8; ++e) { const float c = e < 4 ? c0[e] : c1[e - 4], sn = e < 4 ? s0[e] : s1[e - 4]; v[e] = half ? v[e] * c + pr[e] * sn : v[e] * c - pr[e] * sn; } }
            u32x4 w; w.x = cvt_pk_bf16(v[0], v[1]); w.y = cvt_pk_bf16(v[2], v[3]); w.z = cvt_pk_bf16(v[4], v[5]); w.w = cvt_pk_bf16(v[6], v[7]);
            *(u32x4*)(base + (sl < 4 ? C_QA + sl * 128 : C_KA + (sl - 4) * 128)) = w;
        }
    }
}

template <int DIR> __device__ __forceinline__ void lru_scan(const f32x16 (&A)[2], f32x16 (&Bv)[2], float h_in, int hi, float& Atot, float& hend, bool want_h) {
    float GA[8], GB[8], PA[8], PB[8], hs[8];
#pragma unroll
    for (int j = 0; j < 8; ++j) { const int mt = j >> 2, rb = (j & 3) * 4; float Bc = 0.f, Ap = 1.f;
#pragma unroll
        for (int q = 0; q < 4; ++q) { const int e = DIR ? 3 - q : q; const float a = A[mt][rb + e], b = Bv[mt][rb + e]; Bc = a * Bc + b; Ap *= a; }
        GA[j] = Ap; GB[j] = Bc; PA[j] = __shfl_xor(Ap, 32); PB[j] = __shfl_xor(Bc, 32); }
    float h = h_in, at = 1.f;
#pragma unroll
    for (int q = 0; q < 8; ++q) { const int j = DIR ? 7 - q : q;
        const bool own_first = DIR ? (hi == 1) : (hi == 0);
        const float a0 = own_first ? GA[j] : PA[j], b0 = own_first ? GB[j] : PB[j], a1 = own_first ? PA[j] : GA[j], b1 = own_first ? PB[j] : GB[j];
        const float h0 = h, h1 = a0 * h0 + b0, h2 = a1 * h1 + b1; hs[j] = own_first ? h0 : h1; h = h2; at *= GA[j] * PA[j]; }
    Atot = at; hend = h;
    if (want_h) {
#pragma unroll
        for (int j = 0; j < 8; ++j) { const int mt = j >> 2, rb = (j & 3) * 4; float hc = hs[j];
#pragma unroll
            for (int q = 0; q < 4; ++q) { const int e = DIR ? 3 - q : q; hc = A[mt][rb + e] * hc + Bv[mt][rb + e]; Bv[mt][rb + e] = hc; } }
    }
}
constexpr int LRU_UCF = 0, LRU_UCB = 32768, LRU_HS = 51200, LRU_CAR = 116736, LRU_CW = 126464;
template <bool FINAL> __device__ __forceinline__ void lru_units(const Frame& F, int l) {
    int tz = threadIdx.x; asm volatile("" : "+v"(tz)); const int tid = tz, lane = tid & 63, wave = __builtin_amdgcn_readfirstlane(tid >> 6), r32 = lane & 31, hi = lane >> 5, d = wave >> 2, cg = wave & 3;
    LAS float* UCf = (LAS float*)(F.lds + LRU_UCF); LAS bf16_t* UCb = (LAS bf16_t*)(F.lds + LRU_UCB); LAS float* HS = (LAS float*)(F.lds + LRU_HS);
    LAS float* CAR = (LAS float*)(F.lds + LRU_CAR); LAS float* CW = (LAS float*)(F.lds + LRU_CW);
    const int nch = (FINAL && l == 1) ? SEQ / 64 : NCHUNK;
    const int nunits = NB * nch * 8;
    const int n = F.bx & 7;
    const int ch = n * 128 + cg * 32 + r32;
    const int q0 = F.bx >> 3;
    for (int i = tid; i < 640; i += NTHR) CW[i] = i < 512 ? inp(F, I_CONVW)[(size_t)l * 4096 + (i >> 7) * 1024 + n * 128 + (i & 127)] : inp(F, I_CONVB)[(size_t)l * 1024 + n * 128 + (i - 512)];
    if (FINAL) {
        const int cb_ = tid >> 8, cd = (tid >> 7) & 1, cl = tid & 127;
        const f32x2* ag = fAGG(F) + (size_t)((cb_ * 2 + cd) * NCHUNK) * 1024 + n * 128 + cl;
        float h = 0.f;
#pragma unroll 1
        for (int p0 = 0; p0 < NCHUNK; p0 += 12) {
            f32x2 ab[12];
#pragma unroll
            for (int j = 0; j < 12; ++j) { const int pp = p0 + j; const int cc = cd ? (NCHUNK - 1 - pp) : (pp + 128) % NCHUNK; ab[j] = ag[(size_t)cc * 1024]; }
#pragma unroll
            for (int j = 0; j < 12; ++j) { const int pp = p0 + j; const int cc = cd ? (NCHUNK - 1 - pp) : (pp + 128) % NCHUNK;
                if (cc < nch) { const int q = cb_ * nch + cc - q0; if (q >= 0 && (q & 31) == 0) CAR[((q >> 5) * 2 + cd) * 128 + cl] = h; }
                h = ab[j].x * h + ab[j].y; }
        }
    }
    bf16x8 Br[8], Bi[8];
    { const bf16_t* wb = fLRUW(F) + ((size_t)(((l * 2 + d) * 8 + n) * 2) * 128 + cg * 32 + r32) * 128 + hi * 8;
#pragma unroll
      for (int s = 0; s < 8; ++s) { Br[s] = *(const bf16x8*)(wb + s * 16); Bi[s] = *(const bf16x8*)(wb + 128 * 128 + s * 16); } }
    const float brv = -1.4426950409f * inp(F, I_LRUBR)[(l * 2 + d) * 1024 + ch], biv = -1.4426950409f * inp(F, I_LRUBI)[(l * 2 + d) * 1024 + ch];
    const float lam = inp(F, I_LAM)[(l * 2 + d) * 1024 + ch]; const float sp8 = -8.0f * 1.4426950409f * log1pf(__expf(-lam));
    const int tok = tid >> 3, ch0 = (tid & 7) * 16;
    u32x4 U[4][2];
#define LRU_LOADU(uu) do { const int q_ = (uu) >> 3, b_ = q_ / nch, c_ = q_ - b_ * nch; const int t_ = c_ * 64 + tok, lo_ = c_ >= 128 ? SEQ : 0, hi_ = c_ >= 128 ? TB : SEQ; \
        _Pragma("unroll") for (int i = 0; i < 4; ++i) { const int tt = t_ - 1 + i; if (tt >= lo_ && tt < hi_) { const bf16_t* up = fP(F) + ((size_t)(b_ * TB + tt)) * INW + C_UB + n * 128 + ch0; U[i][0] = *(const u32x4*)up; U[i][1] = *(const u32x4*)(up + 8); } \
            else { U[i][0] = (u32x4){0u, 0u, 0u, 0u}; U[i][1] = (u32x4){0u, 0u, 0u, 0u}; } } } while (0)
    if (F.bx < nunits) LRU_LOADU(F.bx);
    __syncthreads();
    int kk = 0;
#pragma unroll 1
    for (int u = F.bx; u < nunits; u += F.G, ++kk) {
        const int q = u >> 3, b = q / nch, c = q - b * nch;
        { float y[16];
#pragma unroll
          for (int j = 0; j < 16; j += 4) { const f32x4 bv = *(const LAS f32x4*)(CW + 512 + ch0 + j); y[j] = bv[0]; y[j + 1] = bv[1]; y[j + 2] = bv[2]; y[j + 3] = bv[3]; }
#pragma unroll
          for (int i = 0; i < 4; ++i) { const u32x4 u0 = U[i][0], u1 = U[i][1];
              const float uu[16] = {bflo(u0.x), bfhi(u0.x), bflo(u0.y), bfhi(u0.y), bflo(u0.z), bfhi(u0.z), bflo(u0.w), bfhi(u0.w), bflo(u1.x), bfhi(u1.x), bflo(u1.y), bfhi(u1.y), bflo(u1.z), bfhi(u1.z), bflo(u1.w), bfhi(u1.w)};
#pragma unroll
              for (int j = 0; j < 16; j += 4) { const f32x4 wv = *(const LAS f32x4*)(CW + i * 128 + ch0 + j); y[j] += wv[0] * uu[j]; y[j + 1] += wv[1] * uu[j + 1]; y[j + 2] += wv[2] * uu[j + 2]; y[j + 3] += wv[3] * uu[j + 3]; } }
#pragma unroll
          for (int j = 0; j < 16; j += 4) *(LAS f32x4*)(UCf + tok * 128 + ch0 + j) = (f32x4){y[j], y[j + 1], y[j + 2], y[j + 3]};
          LAS u32x4* ub = (LAS u32x4*)(UCb + tok * 136 + ch0);
          ub[0] = (u32x4){cvt_pk_bf16(y[0], y[1]), cvt_pk_bf16(y[2], y[3]), cvt_pk_bf16(y[4], y[5]), cvt_pk_bf16(y[6], y[7])};
          ub[1] = (u32x4){cvt_pk_bf16(y[8], y[9]), cvt_pk_bf16(y[10], y[11]), cvt_pk_bf16(y[12], y[13]), cvt_pk_bf16(y[14], y[15])}; }
        u32x4 g0 = {0u, 0u, 0u, 0u}, g1 = g0;
        const size_t row = (size_t)b * TB + c * 64 + tok;
        if (FINAL) { const bf16_t* gp = fP(F) + row * INW + C_GB + n * 128 + ch0; g0 = *(const u32x4*)gp; g1 = *(const u32x4*)(gp + 8); }
        if (u + F.G < nunits) LRU_LOADU(u + F.G);
        __syncthreads();
        f32x16 av[2] = {}, bv[2] = {};
#pragma unroll
        for (int s = 0; s < 8; ++s)
#pragma unroll
            for (int mt = 0; mt < 2; ++mt) { const bf16x8 a = *(const LAS bf16x8*)(UCb + (mt * 32 + r32) * 136 + s * 16 + hi * 8);
                av[mt] = __builtin_amdgcn_mfma_f32_32x32x16_bf16(a, Br[s], av[mt], 0, 0, 0); bv[mt] = __builtin_amdgcn_mfma_f32_32x32x16_bf16(a, Bi[s], bv[mt], 0, 0, 0); }
        u32x4* lab = fLAB(F) + ((size_t)(u * 8 + wave) * 8) * 64 + lane;
#pragma unroll
        for (int mt = 0; mt < 2; ++mt)
#pragma unroll
            for (int rg = 0; rg < 4; ++rg) { unsigned w4[4];
#pragma unroll
                for (int j = 0; j < 4; ++j) { const int r = rg * 4 + j; const int tk = mt * 32 + (r & 3) + 8 * (r >> 2) + 4 * hi; const float uc = UCf[tk * 128 + cg * 32 + r32];
                    const float e1 = __builtin_amdgcn_exp2f(fminf(fmaf(av[mt][r], -1.4426950409f, brv), 40.f)), e2 = __builtin_amdgcn_exp2f(fminf(fmaf(bv[mt][r], -1.4426950409f, biv), 40.f));
                    const float d1 = 1.0f + e1, d2 = 1.0f + e2, rc = __builtin_amdgcn_rcpf(d1 * d2); const float la = sp8 * (rc * d2); const float a = __builtin_amdgcn_exp2f(la);
                    const float bb = __builtin_amdgcn_sqrtf(fmaxf(fmaf(-a, a, 1.0f), 0.f)) * (rc * d1) * uc; av[mt][r] = a; bv[mt][r] = bb;
                    if (!FINAL) { const _Float16 hl = (_Float16)la; w4[j] = ((unsigned)__builtin_bit_cast(unsigned short, hl) << 16) | (cvt_pk_bf16(bb, 0.f) & 0xffffu); } }
                if (!FINAL) lab[(mt * 4 + rg) * 64] = (u32x4){w4[0], w4[1], w4[2], w4[3]}; }
        if (!FINAL) {
            float At, he;
            if (d == 0) lru_scan<0>(av, bv, 0.f, hi, At, he, false); else lru_scan<1>(av, bv, 0.f, hi, At, he, false);
            if (hi == 0) fAGG(F)[(size_t)((b * 2 + d) * NCHUNK + c) * 1024 + ch] = (f32x2){At, he};
            __syncthreads();
        } else {
            const float h_in = CAR[(kk * 2 + d) * 128 + cg * 32 + r32];
            float At, he;
            if (d == 0) lru_scan<0>(av, bv, h_in, hi, At, he, true); else lru_scan<1>(av, bv, h_in, hi, At, he, true);
#pragma unroll
            for (int mt = 0; mt < 2; ++mt)
#pragma unroll
                for (int r = 0; r < 16; ++r) { const int tk = mt * 32 + (r & 3) + 8 * (r >> 2) + 4 * hi; HS[(d * 64 + tk) * 128 + cg * 32 + r32] = bv[mt][r]; }
            __syncthreads();
            { const float gg[16] = {bflo(g0.x), bfhi(g0.x), bflo(g0.y), bfhi(g0.y), bflo(g0.z), bfhi(g0.z), bflo(g0.w), bfhi(g0.w), bflo(g1.x), bfhi(g1.x), bflo(g1.y), bfhi(g1.y), bflo(g1.z), bfhi(g1.z), bflo(g1.w), bfhi(g1.w)};
              float o[16];
#pragma unroll
              for (int j = 0; j < 16; ++j) o[j] = (HS[tok * 128 + ch0 + j] + HS[(64 + tok) * 128 + ch0 + j]) * gelu_tanh(gg[j]);
              u32x4* op = (u32x4*)(fMIX(F) + row * DM + 512 + n * 128 + ch0);
              op[0] = (u32x4){cvt_pk_bf16(o[0], o[1]), cvt_pk_bf16(o[2], o[3]), cvt_pk_bf16(o[4], o[5]), cvt_pk_bf16(o[6], o[7])};
              op[1] = (u32x4){cvt_pk_bf16(o[8], o[9]), cvt_pk_bf16(o[10], o[11]), cvt_pk_bf16(o[12], o[13]), cvt_pk_bf16(o[14], o[15])}; }
            __syncthreads();
        }
    }
#undef LRU_LOADU
}

__device__ __forceinline__ void lru_pass2(const Frame& F, int l) {
    int tz = threadIdx.x; asm volatile("" : "+v"(tz)); const int tid = tz, lane = tid & 63, wave = __builtin_amdgcn_readfirstlane(tid >> 6), r32 = lane & 31, hi = lane >> 5, d = wave >> 2, cg = wave & 3;
    LAS float* HS = (LAS float*)(F.lds + LRU_HS); LAS float* CAR = (LAS float*)(F.lds + LRU_CAR);
    const int nch = (l == 1) ? SEQ / 64 : NCHUNK;
    const int nunits = NB * nch * 8, n = F.bx & 7, q0 = F.bx >> 3;
    { const int cb_ = tid >> 8, cd = (tid >> 7) & 1, cl = tid & 127;
      const f32x2* ag = fAGG(F) + (size_t)((cb_ * 2 + cd) * NCHUNK) * 1024 + n * 128 + cl;
      float h = 0.f;
#pragma unroll 1
      for (int p0 = 0; p0 < NCHUNK; p0 += 12) {
          f32x2 ab[12];
#pragma unroll
          for (int j = 0; j < 12; ++j) { const int pp = p0 + j; const int cc = cd ? (NCHUNK - 1 - pp) : (pp + 128) % NCHUNK; ab[j] = ag[(size_t)cc * 1024]; }
#pragma unroll
          for (int j = 0; j < 12; ++j) { const int pp = p0 + j; const int cc = cd ? (NCHUNK - 1 - pp) : (pp + 128) % NCHUNK;
              if (cc < nch) { const int q = cb_ * nch + cc - q0; if (q >= 0 && (q & 31) == 0) CAR[((q >> 5) * 2 + cd) * 128 + cl] = h; }
              h = ab[j].x * h + ab[j].y; }
      } }
    const int tok = tid >> 3, ch0 = (tid & 7) * 16;
    u32x4 W[8];
#define LRU_LOADW(uu) do { const int q_ = (uu) >> 3, b_ = q_ / nch, c_ = q_ - b_ * nch; const u32x4* lab_ = fLAB(F) + ((size_t)(((b_ * NCHUNK + c_) * 8 + n) * 8 + wave) * 8) * 64 + lane; \
        _Pragma("unroll") for (int q8 = 0; q8 < 8; ++q8) W[q8] = lab_[q8 * 64]; } while (0)
    if (F.bx < nunits) LRU_LOADW(F.bx);
    __syncthreads();
    int kk = 0;
#pragma unroll 1
    for (int u = F.bx; u < nunits; u += F.G, ++kk) {
        const int q = u >> 3, b = q / nch, c = q - b * nch;
        f32x16 av[2], bv[2];
#pragma unroll
        for (int q8 = 0; q8 < 8; ++q8)
#pragma unroll
            for (int j = 0; j < 4; ++j) { const unsigned w = W[q8][j]; const int mt = q8 >> 2, r = (q8 & 3) * 4 + j;
                av[mt][r] = __builtin_amdgcn_exp2f((float)__builtin_bit_cast(_Float16, (unsigned short)(w >> 16))); bv[mt][r] = __uint_as_float(w << 16); }
        const size_t row = (size_t)b * TB + c * 64 + tok;
        const bf16_t* gp = fP(F) + row * INW + C_GB + n * 128 + ch0; const u32x4 g0 = *(const u32x4*)gp, g1 = *(const u32x4*)(gp + 8);
        if (u + F.G < nunits) LRU_LOADW(u + F.G);
        const float h_in = CAR[(kk * 2 + d) * 128 + cg * 32 + r32];
        float At, he;
        if (d == 0) lru_scan<0>(av, bv, h_in, hi, At, he, true); else lru_scan<1>(av, bv, h_in, hi, At, he, true);
#pragma unroll
        for (int mt = 0; mt < 2; ++mt)
#pragma unroll
            for (int r = 0; r < 16; ++r) { const int tk = mt * 32 + (r & 3) + 8 * (r >> 2) + 4 * hi; HS[(d * 64 + tk) * 128 + cg * 32 + r32] = bv[mt][r]; }
        __syncthreads();
        { const float gg[16] = {bflo(g0.x), bfhi(g0.x), bflo(g0.y), bfhi(g0.y), bflo(g0.z), bfhi(g0.z), bflo(g0.w), bfhi(g0.w), bflo(g1.x), bfhi(g1.x), bflo(g1.y), bfhi(g1.y), bflo(g1.z), bfhi(g1.z), bflo(g1.w), bfhi(g1.w)};
          float o[16];
#pragma unroll
          for (int j = 0; j < 16; ++j) o[j] = (HS[tok * 128 + ch0 + j] + HS[(64 + tok) * 128 + ch0 + j]) * gelu_tanh(gg[j]);
          u32x4* op = (u32x4*)(fMIX(F) + row * DM + 512 + n * 128 + ch0);
          op[0] = (u32x4){cvt_pk_bf16(o[0], o[1]), cvt_pk_bf16(o[2], o[3]), cvt_pk_bf16(o[4], o[5]), cvt_pk_bf16(o[6], o[7])};
          op[1] = (u32x4){cvt_pk_bf16(o[8], o[9]), cvt_pk_bf16(o[10], o[11]), cvt_pk_bf16(o[12], o[13]), cvt_pk_bf16(o[14], o[15])}; }
        __syncthreads();
    }
#undef LRU_LOADW
}

#ifndef ATT_REP_MODE
#define ATT_REP_MODE 7
#endif
__device__ __forceinline__ void attn_phase(const Frame& F, int l, int rep) {
    const int amode = rep ? ATT_REP_MODE : 7;
    const Params& p = *F.p; const int bx = F.bx;
    const int x = bx & 7, o = (bx >> 3) & 31;
#ifndef NA_SKIP
    if (amode & 2) {
        att::Job J; J.mode = 1;
        const int b = x >> 2, h = x & 3, rg = o;
        float* rp = (float*)(F.ldsg + att::RPB_OFF);
        for (int i = F.tid; i < 15 * 31; i += NTHR) rp[i] = inp(F, I_RPB)[(size_t)(l * 4 + h) * 465 + i] * (1.0f / att::SCALE);
        J.Q = fP(F) + ((size_t)b * TB + rg * 256) * INW + C_QN + h * 128; J.K = fP(F) + C_KN + h * 128; J.V = fP(F) + C_VN + h * 128;
        J.O = fMIX(F) + ((size_t)b * TB + rg * 256) * DM + 1536 + h * 128; J.nt = 16; J.row_a = b * TB + SEQ; J.gr0 = rg * 4;
        J.kstart = min(max(rg * 4 - 4, 0), 116); J.row_b = b * TB + J.kstart * 64;
        att::opaque(J); att::attn_unit_na(J, F.ldsg);
    }
#endif
#ifndef GQA_SKIP
    const int njobs = (amode & 1) ? ((l == 0 && bx < 16) ? 2 : 1) : 0;
#pragma unroll 1
    for (int k = 0; k < njobs; ++k) {
        att::Job J; J.mode = 0; J.row_b = 0; J.gr0 = 0; J.kstart = 0;
        int qc, kc, vc, oc, q0;
        if (k == 0) { const int b = x >> 2, kvh = (x >> 1) & 1, hq = kvh * 2 + (x & 1); q0 = b * TB + o * 256; qc = C_QA + hq * 128; kc = C_KA + kvh * 128; vc = C_VA + kvh * 128; oc = hq * 128; J.nt = TB / 64; J.row_a = b * TB; }
        else { const int b = bx >> 3, hh = bx & 7; q0 = b * TB + SEQ; J.nt = 4; J.row_a = q0;
            qc = hh < 4 ? C_QA + hh * 128 : C_QN + (hh - 4) * 128; kc = hh < 4 ? C_KA + (hh >> 1) * 128 : C_KN + (hh - 4) * 128; vc = hh < 4 ? C_VA + (hh >> 1) * 128 : C_VN + (hh - 4) * 128; oc = hh < 4 ? hh * 128 : 1536 + (hh - 4) * 128; }
        J.Q = fP(F) + (size_t)q0 * INW + qc; J.K = fP(F) + kc; J.V = fP(F) + vc; J.O = fMIX(F) + (size_t)q0 * DM + oc;
        att::opaque(J); att::attn_unit<0>(J, F.ldsg);
    }
#endif
#ifndef LRU2_SKIP
    if (amode & 4) lru_pass2(F, l);
#endif
}

__device__ __forceinline__ int moe_setup(const Frame& F, int l) {
    LAS int* tp = (LAS int*)(F.lds + LDS_MISC); LAS int* ud = (LAS int*)(F.lds + LDS_UD); LAS int* rows = (LAS int*)(F.lds + LDS_ROWS); LAS float* wts = (LAS float*)(F.lds + LDS_WTS);
    const int* cnt = fCNT(F) + l * 32;
    if (F.tid == 0) { int s = 0; for (int e = 0; e < NEXP; ++e) { tp[e] = s; s += (cnt[e] + 255) >> 8; } tp[NEXP] = s; }
    __syncthreads();
    const int total = tp[NEXP] * 8, cc = (F.bx % 8) * (F.G / 8) + F.bx / 8;
    if (F.tid < 8) { const int i = F.tid, L = i * F.G + cc; int e = -1, pn = 0, ml = 0, pm = 0, cv = 0;
        if (L < total) { e = 0; for (int j = 1; j < NEXP; ++j) e = (L >= tp[j] * 8) ? j : e; const int t0 = tp[e], te = tp[e + 1] - t0, rem = L - t0 * 8; pn = rem / te; ml = rem % te; pm = t0 + ml; cv = cnt[e]; }
        ud[i * 8 + 0] = e; ud[i * 8 + 1] = pn; ud[i * 8 + 2] = ml; ud[i * 8 + 3] = pm; ud[i * 8 + 4] = cv; }
    __syncthreads();
    for (int q = F.tid; q < 8 * 256; q += NTHR) { const int i = q >> 8, r = q & 255; const int e = ud[i * 8]; int d = -1; float w = 0.f;
        if (e >= 0) { const int idx = ud[i * 8 + 2] * 256 + r; if (idx < ud[i * 8 + 4]) { d = fLDEST(F)[e * CAP + idx]; w = fLW(F)[e * CAP + idx]; } }
        rows[q] = d; wts[q] = w; }
    __syncthreads();
    return total;
}

constexpr int N_PHASES = 18;
__global__ void __launch_bounds__(NTHR, 2) fwd_kernel(Params prm) {
    extern __shared__ __attribute__((aligned(16))) unsigned char lds_raw[];
    Frame F0; F0.p = &prm; F0.ws = nullptr; F0.lds = (LAS unsigned char*)lds_raw; F0.ldsg = (char*)lds_raw;
    F0.tid = threadIdx.x; F0.lane = F0.tid & 63; F0.wave = __builtin_amdgcn_readfirstlane(F0.tid >> 6); F0.bx = blockIdx.x; F0.G = gridDim.x;
    if (threadIdx.x < 4) ((LAS unsigned*)(F0.lds + LDS_BARW))[threadIdx.x] = 0u;
    __syncthreads();
    const int lo = prm.ph_lo, hi = prm.ph_hi;
    if (hi - lo > 1) (void)xcd_barrier_post((unsigned*)inp(F0, I_WS), (volatile LAS unsigned*)(F0.lds + LDS_BARW));
#ifndef BG_ON
#define BG_ON 1
#endif
#define DENSE_SHORT(nwg) ((((nwg) + F.G - 1) / F.G) - (((nwg) - F.bx + F.G - 1) / F.G))
#ifndef PH_MASK
#define PH_MASK 0xFFu
#endif
#define IN(k) (lo <= (k) && (k) < hi && ((PH_MASK >> ((k) == 0 ? 0 : (k) == 17 ? 0 : (((k) - 1) % 8))) & 1u))
#define GRIDBAR() do { XcdBarrier bar_; bar_.bar = (unsigned*)inp(F0, I_WS); bar_.x = xb_xcc_id(); bar_.st = (volatile LAS unsigned*)((LAS unsigned char*)lds_raw + LDS_BARW); xcd_barrier(bar_); } while (0)
#define SEAM(k) do { if (IN(k) && (IN((k) + 1) || rep_ + 1 < REPS(k))) GRIDBAR(); } while (0)
#ifndef DUP_PH
#define DUP_PH -1
#endif
#define REPS(k) (((k) == 0 ? 8 : (k) == 17 ? 9 : ((k) - 1) % 8) == DUP_PH ? 2 : 1)
#define PHASE_BEGIN(lv) Frame F; F.p = &prm; F.lds = (LAS unsigned char*)lds_raw; F.ldsg = (char*)lds_raw; F.ws = (unsigned char*)inp(F, I_WS); const int l = launder_i(lv); (void)l; { int tz_ = threadIdx.x; asm volatile("" : "+v"(tz_)); F.tid = tz_; F.lane = tz_ & 63; F.wave = __builtin_amdgcn_readfirstlane(tz_ >> 6); F.bx = launder_i(blockIdx.x); F.G = launder_i(gridDim.x); }
    if (IN(0)) for (int rep_ = 0; rep_ < REPS(0); ++rep_) { PHASE_BEGIN(0) p0_prologue(F); SEAM(0); }
#pragma unroll 1
    for (int l0 = 0; l0 < 2; ++l0) {
        const int pb = 1 + 8 * l0;
        if (IN(pb + 0)) for (int rep_ = 0; rep_ < REPS(pb + 0); ++rep_) { PHASE_BEGIN(l0) n1_phase(F, l, rep_ != 0); if (!rep_ && l == 1) bg_drain(F, P0_CV_L + CV_SMALL); SEAM(pb + 0); }
        if (IN(pb + 1)) for (int rep_ = 0; rep_ < REPS(pb + 1); ++rep_) { PHASE_BEGIN(l0)
            pg8::DenseOrder S; S.init(fHB(F), fWIN(F) + (size_t)l * INW * DM, MTOK / 256, INW / 256, DM * 2, F.G, F.bx, 0);
            pg8::EpiP E{fP(F)};
            pg8::gemm_phase<pg8::EpiP, pg8::DenseOrder, false, false>(F.lds, DM * 2, S, E);
            if (BG_ON && !rep_) bg_fill(F, DENSE_SHORT((MTOK / 256) * (INW / 256)) * 30);
            SEAM(pb + 1);
        }
        if (IN(pb + 2)) for (int rep_ = 0; rep_ < REPS(pb + 2); ++rep_) { PHASE_BEGIN(l0) if (!rep_) qknorm_phase(F, l); lru_units<false>(F, l); if (BG_ON && !rep_) bg_fill(F, F.bx >= 64 ? 4 : 0); SEAM(pb + 2); }
        if (IN(pb + 3)) for (int rep_ = 0; rep_ < REPS(pb + 3); ++rep_) { PHASE_BEGIN(l0) attn_phase(F, l, rep_); if (BG_ON && !rep_ && l == 0) bg_fill(F, (F.bx >= 16 ? 6 : 0) + (F.bx >= 64 ? 6 : 0)); SEAM(pb + 3); }
        if (IN(pb + 4)) for (int rep_ = 0; rep_ < REPS(pb + 4); ++rep_) { PHASE_BEGIN(l0)
            pg8::DenseOrder S; S.init(fMIX(F), fWOUT(F) + (size_t)l * DM * DM, l == 0 ? MTOK / 256 : NB * SEQ / 256, DM / 256, DM * 2, F.G, F.bx, l == 0 ? 0 : 1);
            pg8::EpiResid E{fX(F), fMOD(F) + (size_t)l * 3 * 12288, rep_ ? 0.0f : 1.0f};
            pg8::gemm_phase<pg8::EpiResid, pg8::DenseOrder, false, false>(F.lds, DM * 2, S, E);
            if (BG_ON && !rep_ && l == 0) bg_fill(F, DENSE_SHORT((MTOK / 256) * (DM / 256)) * 28);
            SEAM(pb + 4);
        }
        if (IN(pb + 5)) for (int rep_ = 0; rep_ < REPS(pb + 5); ++rep_) { PHASE_BEGIN(l0) n2_phase(F, l, rep_ != 0); if (!rep_) bg_drain(F, l == 0 ? P0_CV_L : CV_TOTAL); SEAM(pb + 5); }
        if (IN(pb + 6)) for (int rep_ = 0; rep_ < REPS(pb + 6); ++rep_) { PHASE_BEGIN(l0)
            const int mtotal = moe_setup(F, l);
            pg8::MoeOrder S; S.ud = (const LAS int*)(F.lds + LDS_UD); S.rows = (const LAS int*)(F.lds + LDS_ROWS); S.pitch = DM; S.A = (const char*)fHB8(F); S.Bt = (const char*)(fW1(F) + (size_t)l * NEXP * 2048 * DM);
            S.bstride = (size_t)2048 * DM; S.gather = 1;
            pg8::EpiSwiglu E{fACT(F)};
            pg8::gemm_phase<pg8::EpiSwiglu, pg8::MoeOrder, true, true>(F.lds, DM, S, E);
            if (BG_ON && !rep_ && l == 0) { const int cc = (F.bx % 8) * (F.G / 8) + F.bx / 8; bg_fill(F, (((mtotal + F.G - 1) / F.G) - ((mtotal - cc + F.G - 1) / F.G)) * 18); }
            SEAM(pb + 6);
        }
        if (IN(pb + 7)) for (int rep_ = 0; rep_ < REPS(pb + 7); ++rep_) { PHASE_BEGIN(l0)
            const int mtotal = moe_setup(F, l);
            pg8::MoeOrder S; S.ud = (const LAS int*)(F.lds + LDS_UD); S.rows = (const LAS int*)(F.lds + LDS_ROWS); S.pitch = HID; S.A = (const char*)fACT(F); S.Bt = (const char*)(fW2(F) + (size_t)l * NEXP * DM * HID);
            S.bstride = (size_t)DM * HID; S.gather = 0;
            pg8::EpiScatter E{fY(F), (const LAS int*)(F.lds + LDS_ROWS), (const LAS float*)(F.lds + LDS_WTS)};
            pg8::gemm_phase<pg8::EpiScatter, pg8::MoeOrder, false, true>(F.lds, HID, S, E);
            if (BG_ON && !rep_ && l == 0) { const int cc = (F.bx % 8) * (F.G / 8) + F.bx / 8; bg_fill(F, (((mtotal + F.G - 1) / F.G) - ((mtotal - cc + F.G - 1) / F.G)) * 12); }
            SEAM(pb + 7);
        }
    }
    if (IN(17)) for (int rep_ = 0; rep_ < REPS(17); ++rep_) { PHASE_BEGIN(2) fin_phase(F); if (rep_ + 1 < REPS(17)) GRIDBAR(); }
#undef IN
#undef SEAM
}

extern "C" void kernel_launch(void* const* d_in, const int* in_sizes, int n_in, void* d_out, int out_size, void* d_ws, size_t ws_size, hipStream_t stream) {
    static int ok = 0;
    if (ok == 0) {
        if (n_in != 28 || out_size != NB * SEQ * DM || ws_size < WS_END) { fprintf(stderr, "kernel_launch: shape mismatch: n_in %d out %d ws %zu (need %zu)\n", n_in, out_size, ws_size, (size_t)WS_END); ok = -1; return; }
        if (hipFuncSetAttribute((const void*)fwd_kernel, hipFuncAttributeMaxDynamicSharedMemorySize, LDS_BYTES) != hipSuccess) { fprintf(stderr, "kernel_launch: hipFuncSetAttribute failed\n"); ok = -1; return; }
        int per_cu = 0;
        if (hipOccupancyMaxActiveBlocksPerMultiprocessor(&per_cu, (const void*)fwd_kernel, NTHR, LDS_BYTES) != hipSuccess || per_cu < 1) fprintf(stderr, "kernel_launch: occupancy query says %d blocks per CU\n", per_cu);
        (void)hipGetLastError();
        ok = 1;
    }
    if (ok < 0) return;
    (void)hipMemsetAsync((char*)d_ws + WS_CTL, 0, CTL_BYTES, stream);
    Params prm{};
    for (int i = 0; i < 28; ++i) prm.in[i] = (const float*)d_in[i];
    prm.in[I_OUT] = (const float*)d_out; prm.in[I_WS] = (const float*)d_ws;
#if MK_N_LAUNCHES == 1
    prm.ph_lo = 0; prm.ph_hi = N_PHASES;
    hipLaunchKernelGGL(fwd_kernel, dim3(GRID), dim3(NTHR), LDS_BYTES, stream, prm);
#else
    for (int k = 0; k < N_PHASES; ++k) { prm.ph_lo = k; prm.ph_hi = k + 1; hipLaunchKernelGGL(fwd_kernel, dim3(GRID), dim3(NTHR), LDS_BYTES, stream, prm); }
#endif
    const hipError_t le = hipPeekAtLastError();
    if (le != hipSuccess) fprintf(stderr, "kernel_launch: launch failed: %s\n", hipGetErrorName(le));
}
```

```cpp
#include <hip/hip_runtime.h>
#include <stdint.h>
#include <stdio.h>

#ifndef MK_N_LAUNCHES
#define MK_N_LAUNCHES 1
#endif

#define LAS __attribute__((address_space(3)))
typedef unsigned short bf16_t;
typedef short bf16x8 __attribute__((ext_vector_type(8)));
typedef short s16x4 __attribute__((ext_vector_type(4)));
typedef float f32x2 __attribute__((ext_vector_type(2)));
typedef float f32x4 __attribute__((ext_vector_type(4)));
typedef float f32x16 __attribute__((ext_vector_type(16)));
typedef unsigned u32x2 __attribute__((ext_vector_type(2)));
typedef unsigned u32x4 __attribute__((ext_vector_type(4)));

constexpr int DM = 2048, NB = 2, SEQ = 8192, CTXL = 256, TB = SEQ + CTXL, MTOK = NB * TB;
constexpr int INW = 4608;
constexpr int C_QA = 0, C_KA = 512, C_VA = 768, C_UB = 1024, C_GB = 2048, C_QN = 3072, C_KN = 3584, C_VN = 4096;
constexpr int NEXP = 32, HID = 1024, CAP = MTOK, NCHUNK = TB / 64;
constexpr int PMAX = 2 * MTOK + NEXP * 256;
constexpr float EPS = 1e-6f;
constexpr int NTHR = 512;
constexpr int GRID = 256;

constexpr size_t al256(size_t x) { return (x + 255) / 256 * 256; }
constexpr size_t WS_CTL = 0, CTL_BYTES = 65536;
constexpr size_t CTL_CNT = 16384, CTL_Q = 20480;
constexpr size_t WS_MOD = WS_CTL + CTL_BYTES;
constexpr size_t WS_ROPE = WS_MOD + al256((size_t)2 * 3 * 12288 * 4);
constexpr size_t WS_WRT = WS_ROPE + 32768;
constexpr size_t WS_AGG = WS_WRT + al256((size_t)2 * 36 * 2048 * 4);
constexpr size_t WS_LDEST = WS_AGG + al256((size_t)2 * 2 * NCHUNK * 1024 * 8);
constexpr size_t WS_LW = WS_LDEST + al256((size_t)NEXP * CAP * 4);
constexpr size_t WS_X = WS_LW + al256((size_t)NEXP * CAP * 4);
constexpr size_t WS_HB = WS_X + al256((size_t)MTOK * DM * 4);
constexpr size_t WS_P = WS_HB + al256((size_t)MTOK * DM * 2);
constexpr size_t WS_MIX = WS_P + al256((size_t)MTOK * INW * 2);
constexpr size_t WS_ACT = WS_MIX + al256((size_t)MTOK * DM * 2);
constexpr size_t WS_Y = WS_ACT + al256((size_t)PMAX * HID * 2);
constexpr size_t WS_LAB = WS_Y + al256((size_t)MTOK * 2 * DM * 2);
constexpr size_t WS_WIN = WS_LAB + al256((size_t)NB * NCHUNK * 8 * 8 * 8 * 64 * 16);
constexpr size_t WS_WOUT = WS_WIN + al256((size_t)2 * INW * DM * 2);
constexpr size_t WS_LRUW = WS_WOUT + al256((size_t)2 * DM * DM * 2);
constexpr size_t WS_W1 = WS_LRUW + al256((size_t)2 * 2 * 8 * 2 * 128 * 128 * 2);
constexpr size_t WS_W2 = WS_W1 + al256((size_t)2 * NEXP * 2048 * DM);
constexpr size_t WS_END = WS_W2 + al256((size_t)2 * NEXP * DM * HID);

constexpr int LDS_STAGE = 131072;
constexpr int LDS_BARW = LDS_STAGE;
constexpr int LDS_MISC = LDS_STAGE + 64;
constexpr int LDS_UD = LDS_STAGE + 512;
constexpr int LDS_ROWS = LDS_STAGE + 1024;
constexpr int LDS_WTS = LDS_ROWS + 8192;
constexpr int LDS_BYTES = LDS_WTS + 8192;

struct Params { const float* in[30]; int ph_lo, ph_hi; };
enum { I_X = 0, I_C, I_CTX, I_CCTX, I_ADAW, I_ADAB, I_N1G, I_N2G, I_WIN, I_WOUT, I_QNORM, I_KNORM, I_CONVW, I_CONVB, I_LRUWR, I_LRUBR, I_LRUWI, I_LRUBI, I_LAM, I_RPB,
       I_RWG, I_RBG, I_RWE, I_RBE, I_MWG, I_MWU, I_MWD, I_FING, I_OUT, I_WS };

__device__ __forceinline__ unsigned cvt_pk_bf16(float lo, float hi) { unsigned r; asm volatile("v_cvt_pk_bf16_f32 %0, %1, %2" : "=v"(r) : "v"(lo), "v"(hi)); return r; }
__device__ __forceinline__ unsigned cvt_pk_fp8x4(float a, float b, float c, float d) { int w = 0; w = __builtin_amdgcn_cvt_pk_fp8_f32(a, b, w, false); w = __builtin_amdgcn_cvt_pk_fp8_f32(c, d, w, true); return (unsigned)w; }
__device__ __forceinline__ unsigned cvt_pk_fp8x4_sat(float a, float b, float c, float d) {
    return cvt_pk_fp8x4(__builtin_amdgcn_fmed3f(a, -448.f, 448.f), __builtin_amdgcn_fmed3f(b, -448.f, 448.f), __builtin_amdgcn_fmed3f(c, -448.f, 448.f), __builtin_amdgcn_fmed3f(d, -448.f, 448.f)); }
__device__ __forceinline__ float bflo(unsigned w) { return __uint_as_float(w << 16); }
__device__ __forceinline__ float bfhi(unsigned w) { return __uint_as_float(w & 0xffff0000u); }
__device__ __forceinline__ float wave_sum(float v) {
#pragma unroll
    for (int o = 32; o >= 1; o >>= 1) v += __shfl_xor(v, o);
    return v;
}
__device__ __forceinline__ float sigmoidf_(float x) { return __builtin_amdgcn_rcpf(1.0f + __expf(-x)); }
__device__ __forceinline__ float gelu_tanh(float x) { const float z = 0.7978845608028654f * (x + 0.044715f * x * x * x); const float e = __expf(2.0f * z); const float th = 1.0f - 2.0f * __builtin_amdgcn_rcpf(e + 1.0f); return 0.5f * x * (1.0f + th); }

#define XB_TMO      128
#define XB_XCNT(j)  (256  + 64 * (j))
#define XB_XSUB(j)  (1280 + 64 * (j))
#define XB_XGEN(j)  (2304 + 64 * (j))
#define XB_TOP      3328
#define XB_TOPGEN   3392
#define XCD_BAR_WORDS 3456
#define XB_SPIN_CAP (1u << 18)
__device__ __forceinline__ unsigned xb_ld(unsigned* p)              { return __hip_atomic_load(p, __ATOMIC_RELAXED, __HIP_MEMORY_SCOPE_AGENT); }
__device__ __forceinline__ unsigned xb_add(unsigned* p, unsigned v) { return __hip_atomic_fetch_add(p, v, __ATOMIC_RELAXED, __HIP_MEMORY_SCOPE_AGENT); }
__device__ __forceinline__ unsigned xb_xcc_id() { return (unsigned)__builtin_amdgcn_s_getreg((3 << 11) | 20) & 0xFu; }
#define XB_SPIN(cond, bar) do { unsigned _sp = 0; while (cond) { __builtin_amdgcn_s_sleep(1); \
    if ((++_sp & 255u) == 0u) { if (xb_ld(&(bar)[XB_TMO])) break; if (_sp > XB_SPIN_CAP) { atomicAdd(&(bar)[XB_TMO], 1u); break; } } } } while (0)
struct XcdBarrier { unsigned* bar; unsigned x; volatile LAS unsigned* st; };
__device__ __forceinline__ XcdBarrier xcd_barrier_post(unsigned* bar, volatile LAS unsigned* st) {
    XcdBarrier b; b.bar = bar; b.x = xb_xcc_id(); b.st = st;
    if (threadIdx.x == 0) (void)xb_add(&bar[XB_XCNT(b.x)], 1u);
    return b;
}
__device__ __forceinline__ void xcd_barrier_complete(unsigned* bar, unsigned x, unsigned& nloc, unsigned& nx) {
    const unsigned G = gridDim.x * gridDim.y * gridDim.z;
    unsigned sum, cnt, mine, sp = 0u;
    for (;;) {
        sum = 0u; cnt = 0u; mine = 0u;
#pragma unroll
        for (unsigned j = 0; j < 16; ++j) { const unsigned c = xb_ld(&bar[XB_XCNT(j)]); sum += c; cnt += (c > 0u) ? 1u : 0u; mine = (j == x) ? c : mine; }
        if (sum == G) break;
        __builtin_amdgcn_s_sleep(1);
        if ((++sp & 255u) == 0u) { if (xb_ld(&bar[XB_TMO])) break; if (sp > XB_SPIN_CAP) { atomicAdd(&bar[XB_TMO], 1u); break; } }
    }
    nloc = mine > 0u ? mine : 1u; nx = cnt > 0u ? cnt : 1u;
}
__device__ __forceinline__ void xcd_barrier(const XcdBarrier& b) {
    asm volatile("s_waitcnt vmcnt(0)" ::: "memory");
    __syncthreads();
    if (threadIdx.x == 0) {
        unsigned* bar = b.bar;
        __builtin_amdgcn_s_waitcnt(0);
        unsigned nloc = b.st[0], nx = b.st[1];
        if (nloc == 0u) { xcd_barrier_complete(bar, b.x, nloc, nx); b.st[0] = nloc; b.st[1] = nx; }
        const unsigned old = xb_add(&bar[XB_XSUB(b.x)], 1u);
        const unsigned gen = old / nloc;
        if (old + 1u == (gen + 1u) * nloc) {
            __builtin_amdgcn_fence(__ATOMIC_RELEASE, "agent");
            asm volatile("s_waitcnt vmcnt(0)" ::: "memory");
            const unsigned og = xb_add(&bar[XB_TOP], 1u);
            const unsigned tg = og / nx;
            if (og + 1u == (tg + 1u) * nx) xb_add(&bar[XB_TOPGEN], 1u);
            else XB_SPIN(xb_ld(&bar[XB_TOPGEN]) == tg, bar);
            __builtin_amdgcn_fence(__ATOMIC_ACQUIRE, "agent");
            xb_add(&bar[XB_XGEN(b.x)], 1u);
            asm volatile("s_waitcnt vmcnt(0)" ::: "memory");
        } else {
            XB_SPIN(xb_ld(&bar[XB_XGEN(b.x)]) == gen, bar);
            __builtin_amdgcn_fence(__ATOMIC_ACQUIRE, "agent");
            asm volatile("s_waitcnt vmcnt(0)" ::: "memory");
        }
    }
    __syncthreads();
}

namespace pg8 {
constexpr int BM = 256, BK = 64, HALF = 128, HTB = HALF * BK * 2, STAGE_BYTES = 8 * HTB, NXCD = 8, WGM = 8;
__device__ __forceinline__ int lds_byte(int r, int c) { const int st = (r >> 4) * 2 + (c >> 5), rr = r & 15, cc = c & 31, ob = rr * 64 + cc * 2; return st * 1024 + (ob ^ (((ob >> 9) & 1) << 5)); }
__device__ __forceinline__ void stage_rc(int b, int& R, int& C) { const int st = b / 1024, sb = b % 1024, swz = sb ^ (((sb >> 9) & 1) << 5); R = (st >> 1) * 16 + swz / 64; C = (st & 1) * 32 + (swz % 64) / 2; }
__device__ __forceinline__ int perm32(int rho) { const int n = rho >> 4, i = rho & 15; return 8 * (i >> 2) + 4 * n + (i & 3); }

struct Unit { int pm, pn, e, ml, cntv, ui; const char* A; const char* B; };

struct DenseOrder {
    int nM, nN, nwg, G, c, pitch, skip32; const char* A; const char* Bt;
    __device__ void init(const void* A_, const void* Bt_, int nM_, int nN_, int pitch_, int G_, int c_, int skip32_) { A = (const char*)A_; Bt = (const char*)Bt_; nM = nM_; nN = nN_; pitch = pitch_; nwg = nM * nN; G = G_; c = c_; skip32 = skip32_; }
    __device__ __forceinline__ bool next(int i, Unit& u) const {
        const long L = (long)i * G + c; if (L >= nwg) return false;
        int wgid = (int)L; { const int q = nwg / NXCD, r = nwg % NXCD, xcd = wgid % NXCD, off = wgid / NXCD; wgid = (xcd < r ? xcd * (q + 1) : r * (q + 1) + (xcd - r) * q) + off; }
        const int nig = WGM * nN, gid = wgid / nig, fm = gid * WGM, gsz = (nM - fm) < WGM ? (nM - fm) : WGM;
        int pm = fm + ((wgid % nig) % gsz); u.pn = (wgid % nig) / gsz; if (skip32) pm += pm >> 5; u.pm = pm; u.e = 0; u.ml = 0; u.cntv = 0; u.ui = 0;
        u.A = A + (size_t)pm * 256 * pitch; u.B = Bt + (size_t)u.pn * 256 * pitch; return true;
    }
    __device__ __forceinline__ unsigned grow(const Unit&, int) const { return 0u; }
};
struct MoeOrder {
    const LAS int* ud; const LAS int* rows; int pitch; const char* A; const char* Bt; size_t bstride; int gather;
    __device__ __forceinline__ bool next(int i, Unit& u) const {
        if (i >= 8) return false;
        const int e = __builtin_amdgcn_readfirstlane(ud[i * 8 + 0]); if (e < 0) return false;
        u.e = e; u.pn = __builtin_amdgcn_readfirstlane(ud[i * 8 + 1]); u.ml = __builtin_amdgcn_readfirstlane(ud[i * 8 + 2]); u.pm = __builtin_amdgcn_readfirstlane(ud[i * 8 + 3]); u.cntv = __builtin_amdgcn_readfirstlane(ud[i * 8 + 4]); u.ui = i;
        u.A = gather ? A : A + (size_t)u.pm * 256 * pitch; u.B = Bt + (size_t)e * bstride + (size_t)u.pn * 256 * pitch; return true;
    }
    __device__ __forceinline__ unsigned grow(const Unit& u, int r) const { const int d = rows[u.ui * 256 + r]; return d >= 0 ? (unsigned)(d >> 1) : 0u; }
};

typedef int i32x8 __attribute__((ext_vector_type(8)));
typedef int i32x4_ __attribute__((ext_vector_type(4)));
template <class Epi, class Sched, bool GATHER, bool FP8>
__device__ __forceinline__ void gemm_phase(LAS unsigned char* lds, const int pitch, const Sched& S, const Epi& E) {
    int tz = threadIdx.x; asm volatile("" : "+v"(tz));
    const int tid = tz, wid = __builtin_amdgcn_readfirstlane(tid >> 6), lane = tid & 63, wr = wid >> 2, wc = wid & 3, fr = lane & 15, fq = lane >> 4;
    const int nt = pitch / 128;
    unsigned voffA[2], voffB[2];
#pragma unroll
    for (int i = 0; i < 2; ++i) { int R, C; stage_rc(tid * 16 + i * 8192, R, C); const int Rb = Epi::PERM ? ((R & ~31) + perm32(R & 31)) : R;
        voffA[i] = (unsigned)(R * pitch + C * 2); voffB[i] = (unsigned)(Rb * pitch + C * 2); }
    const size_t kstep = (size_t)(BK * 2);
    const size_t hstep = (size_t)HALF * pitch;
    const unsigned ldsw = (unsigned)wid * 1024u;
    const int aoff = lds_byte(wr * 64 + fr, fq * 8), boff = lds_byte(wc * 32 + fr, fq * 8);
#define PG8_SA(b, h) (((b) * 2 + (h)) * HTB)
#define PG8_SB(b, h) ((4 + (b) * 2 + (h)) * HTB)
#define PG8_STAGE(bufoff, gbase, voff) do { _Pragma("unroll") for (int _i = 0; _i < 2; ++_i) \
        __builtin_amdgcn_global_load_lds((const unsigned*)((const char*)(gbase) + (voff)[_i]), (LAS unsigned*)(lds + (bufoff) + ldsw + _i * 8192), 16, 0, 0); } while (0)
#define PG8_STAGE_A(bufoff, gbase, h, nx) do { if (GATHER) { unsigned _v[2]; _v[0] = (nx) ? nG[h][0] : gA[h][0]; _v[1] = (nx) ? nG[h][1] : gA[h][1]; PG8_STAGE(bufoff, gbase, _v); } \
        else PG8_STAGE(bufoff, (gbase) + (h) * hstep, voffA); } while (0)
#define PG8_RD(off) (*(const LAS i32x4_*)(lds + (off)))
#define PG8_LDA(dst, b, h) do { _Pragma("unroll") for (int m = 0; m < 4; ++m) dst[m] = __builtin_shufflevector(PG8_RD(PG8_SA(b, h) + aoff + m * 2048), PG8_RD(PG8_SA(b, h) + aoff + m * 2048 + 1024), 0, 1, 2, 3, 4, 5, 6, 7); } while (0)
#define PG8_LDB(dst, b, h) do { _Pragma("unroll") for (int n = 0; n < 2; ++n) dst[n] = __builtin_shufflevector(PG8_RD(PG8_SB(b, h) + boff + n * 2048), PG8_RD(PG8_SB(b, h) + boff + n * 2048 + 1024), 0, 1, 2, 3, 4, 5, 6, 7); } while (0)
#define PG8_LO(x) __builtin_bit_cast(bf16x8, __builtin_shufflevector(x, x, 0, 1, 2, 3))
#define PG8_HI(x) __builtin_bit_cast(bf16x8, __builtin_shufflevector(x, x, 4, 5, 6, 7))
#define PG8_MMA(ai, bj, At, Bt) do { __builtin_amdgcn_s_setprio(1); \
        if (FP8) { _Pragma("unroll") for (int m = 0; m < 4; ++m) _Pragma("unroll") for (int n = 0; n < 2; ++n) \
            asm volatile("v_mfma_scale_f32_16x16x128_f8f6f4 %0, %1, %2, %0, %3, %3 op_sel_hi:[0,0,0]" : "+v"(acc[ai][bj][m][n]) : "v"(Bt[n]), "v"(At[m]), "v"(sc1)); } \
        else { _Pragma("unroll") for (int m = 0; m < 4; ++m) _Pragma("unroll") for (int n = 0; n < 2; ++n) { \
            acc[ai][bj][m][n] = __builtin_amdgcn_mfma_f32_16x16x32_bf16(PG8_LO(Bt[n]), PG8_LO(At[m]), acc[ai][bj][m][n], 0, 0, 0); \
            acc[ai][bj][m][n] = __builtin_amdgcn_mfma_f32_16x16x32_bf16(PG8_HI(Bt[n]), PG8_HI(At[m]), acc[ai][bj][m][n], 0, 0, 0); } } \
        __builtin_amdgcn_s_setprio(0); } while (0)
#define PG8_WAIT_V(n) asm volatile("s_waitcnt vmcnt(" #n ")" ::: "memory")
#define PG8_WAIT_L(n) asm volatile("s_waitcnt lgkmcnt(" #n ")" ::: "memory")
#define PG8_BAR __builtin_amdgcn_s_barrier()
#define PG8_SCHED __builtin_amdgcn_sched_barrier(0)
    Unit cur, nxt; int ui = 0;
    if (!S.next(0, cur)) return;
    unsigned gA[2][2] = {{0u, 0u}, {0u, 0u}}, nG[2][2] = {{0u, 0u}, {0u, 0u}};
    if (GATHER) {
#pragma unroll
        for (int h = 0; h < 2; ++h)
#pragma unroll
            for (int i = 0; i < 2; ++i) { int R, C; stage_rc(tid * 16 + i * 8192, R, C); gA[h][i] = S.grow(cur, h * HALF + R) * (unsigned)pitch + (unsigned)C * 2u; }
    }
    f32x4 acc[2][2][4][2];
#pragma unroll
    for (int a = 0; a < 2; ++a)
#pragma unroll
        for (int b = 0; b < 2; ++b)
#pragma unroll
            for (int m = 0; m < 4; ++m)
#pragma unroll
                for (int n = 0; n < 2; ++n) acc[a][b][m][n] = (f32x4){0.f, 0.f, 0.f, 0.f};
    i32x8 At[4], B0[2], B1[2];
    int sc1 = 0x7F7F7F7F; asm volatile("" : "+v"(sc1));
    const char* cA = cur.A; const char* cB = cur.B;
    PG8_STAGE(PG8_SB(0, 0), cB, voffB); PG8_STAGE_A(PG8_SA(0, 0), cA, 0, false); PG8_STAGE(PG8_SB(0, 1), cB + hstep, voffB); PG8_STAGE_A(PG8_SA(0, 1), cA, 1, false);
    if (wr == 1) PG8_BAR;
    PG8_WAIT_V(4); PG8_BAR;
    PG8_STAGE(PG8_SB(1, 0), cB + kstep, voffB); PG8_STAGE_A(PG8_SA(1, 0), cA + kstep, 0, false); PG8_STAGE(PG8_SB(1, 1), cB + hstep + kstep, voffB);
    PG8_WAIT_V(6); PG8_BAR;
    for (;;) {
        const bool has_next = S.next(ui + 1, nxt);
        const char* nA = has_next ? nxt.A : cA; const char* nB = has_next ? nxt.B : cB;
        if (GATHER) {
#pragma unroll
            for (int h = 0; h < 2; ++h)
#pragma unroll
                for (int i = 0; i < 2; ++i) { int tg = threadIdx.x; asm volatile("" : "+v"(tg)); int R, C; stage_rc(tg * 16 + i * 8192, R, C); nG[h][i] = has_next ? S.grow(nxt, h * HALF + R) * (unsigned)pitch + (unsigned)C * 2u : gA[h][i]; }
        }
#pragma unroll 1
        for (int t = 0; t < nt; t += 2) {
            const bool last = (t == nt - 2);
            const char* a1 = cA + (size_t)(t + 1) * kstep;
            const char* a2 = last ? nA : cA + (size_t)(t + 2) * kstep; const char* b2 = last ? nB : cB + (size_t)(t + 2) * kstep;
            const char* a3 = a2 + kstep; const char* b3 = b2 + kstep;
            PG8_LDB(B0, 0, 0); PG8_SCHED; PG8_LDA(At, 0, 0); PG8_STAGE_A(PG8_SA(1, 1), a1, 1, false);
            PG8_WAIT_L(8); PG8_BAR; PG8_WAIT_L(0); PG8_MMA(0, 0, At, B0); PG8_BAR; PG8_SCHED;
            PG8_LDB(B1, 0, 1); PG8_STAGE(PG8_SB(0, 0), b2, voffB);
            PG8_BAR; PG8_WAIT_L(0); PG8_MMA(0, 1, At, B1); PG8_BAR;
            PG8_LDA(At, 0, 1); PG8_STAGE_A(PG8_SA(0, 0), a2, 0, last);
            PG8_BAR; PG8_WAIT_L(0); PG8_MMA(1, 0, At, B0); PG8_BAR; PG8_SCHED;
            PG8_STAGE(PG8_SB(0, 1), b2 + hstep, voffB);
            PG8_WAIT_V(6); PG8_BAR; PG8_MMA(1, 1, At, B1); PG8_BAR;
            PG8_LDB(B0, 1, 0); PG8_SCHED; PG8_LDA(At, 1, 0); PG8_STAGE_A(PG8_SA(0, 1), a2, 1, last);
            PG8_WAIT_L(8); PG8_BAR; PG8_WAIT_L(0); PG8_MMA(0, 0, At, B0); PG8_BAR; PG8_SCHED;
            PG8_LDB(B1, 1, 1); PG8_STAGE(PG8_SB(1, 0), b3, voffB);
            PG8_BAR; PG8_WAIT_L(0); PG8_MMA(0, 1, At, B1); PG8_BAR;
            PG8_LDA(At, 1, 1); PG8_STAGE_A(PG8_SA(1, 0), a3, 0, last);
            PG8_BAR; PG8_WAIT_L(0); PG8_MMA(1, 0, At, B0); PG8_BAR; PG8_SCHED;
            PG8_STAGE(PG8_SB(1, 1), b3 + hstep, voffB);
            PG8_WAIT_V(6); PG8_BAR; PG8_MMA(1, 1, At, B1); PG8_BAR;
        }
        if (FP8) asm volatile("s_nop 15\n\ts_nop 15\n\ts_nop 15" ::: "memory");
        { int te = threadIdx.x; asm volatile("" : "+v"(te)); const int le = te & 63; E(acc, cur, wr, wc, le & 15, le >> 4); }
        if (!has_next) break;
#pragma unroll
        for (int a = 0; a < 2; ++a)
#pragma unroll
            for (int b = 0; b < 2; ++b)
#pragma unroll
                for (int m = 0; m < 4; ++m)
#pragma unroll
                    for (int n = 0; n < 2; ++n) acc[a][b][m][n] = (f32x4){0.f, 0.f, 0.f, 0.f};
        cur = nxt; cA = nA; cB = nB; ++ui;
        if (GATHER) {
#pragma unroll
            for (int h = 0; h < 2; ++h)
#pragma unroll
                for (int i = 0; i < 2; ++i) gA[h][i] = nG[h][i];
        }
    }
    PG8_WAIT_V(0);
    if (wr == 0) PG8_BAR;
    PG8_BAR;
#undef PG8_SA
#undef PG8_SB
#undef PG8_STAGE
#undef PG8_STAGE_A
#undef PG8_LDA
#undef PG8_LDB
#undef PG8_MMA
#undef PG8_RD
#undef PG8_LO
#undef PG8_HI
#undef PG8_WAIT_V
#undef PG8_WAIT_L
#undef PG8_BAR
#undef PG8_SCHED
}

struct EpiP {
    static constexpr bool PERM = true;
    bf16_t* O;
    __device__ __forceinline__ void operator()(const f32x4 (&acc)[2][2][4][2], const Unit& u, int wr, int wc, int fr, int fq) const {
        const int row0 = u.pm * BM + wr * 64 + fr, col0 = u.pn * BM + wc * 32 + 8 * fq;
#pragma unroll
        for (int ai = 0; ai < 2; ++ai)
#pragma unroll
            for (int m = 0; m < 4; ++m) { bf16_t* rowp = O + (size_t)(row0 + ai * HALF + m * 16) * INW + col0;
#pragma unroll
                for (int bj = 0; bj < 2; ++bj) { const f32x4 v0 = acc[ai][bj][m][0], v1 = acc[ai][bj][m][1];
                    u32x4 w; w.x = cvt_pk_bf16(v0[0], v0[1]); w.y = cvt_pk_bf16(v0[2], v0[3]); w.z = cvt_pk_bf16(v1[0], v1[1]); w.w = cvt_pk_bf16(v1[2], v1[3]);
                    *(u32x4*)(rowp + bj * HALF) = w; } }
    }
};
struct EpiResid {
    static constexpr bool PERM = true;
    bf16_t* X; const float* mod; float scale;
    __device__ __forceinline__ void operator()(const f32x4 (&acc)[2][2][4][2], const Unit& u, int wr, int wc, int fr, int fq) const {
        const int row0 = u.pm * BM + wr * 64 + fr, col0 = u.pn * BM + wc * 32 + 8 * fq;
        const int sel = (u.pm % 33 == 32) ? 2 : u.pm / 33;
        const float* gv = mod + sel * 12288 + 4096;
        f32x4 g[2][2];
#pragma unroll
        for (int bj = 0; bj < 2; ++bj)
#pragma unroll
            for (int n = 0; n < 2; ++n) g[bj][n] = *(const f32x4*)(gv + col0 + bj * HALF + n * 4) * scale;
#pragma unroll
        for (int ai = 0; ai < 2; ++ai)
#pragma unroll
            for (int m = 0; m < 4; ++m) { bf16_t* rowp = X + (size_t)(row0 + ai * HALF + m * 16) * DM + col0;
#pragma unroll
                for (int bj = 0; bj < 2; ++bj) { u32x4* q = (u32x4*)(rowp + bj * HALF); const u32x4 xw = *q;
                    const f32x4 v0 = (f32x4){bflo(xw.x), bfhi(xw.x), bflo(xw.y), bfhi(xw.y)} + g[bj][0] * acc[ai][bj][m][0], v1 = (f32x4){bflo(xw.z), bfhi(xw.z), bflo(xw.w), bfhi(xw.w)} + g[bj][1] * acc[ai][bj][m][1];
                    u32x4 w; w.x = cvt_pk_bf16(v0[0], v0[1]); w.y = cvt_pk_bf16(v0[2], v0[3]); w.z = cvt_pk_bf16(v1[0], v1[1]); w.w = cvt_pk_bf16(v1[2], v1[3]); *q = w; } }
    }
};
struct EpiSwiglu {
    static constexpr bool PERM = true;
    unsigned char* ACT;
    __device__ __forceinline__ void operator()(const f32x4 (&acc)[2][2][4][2], const Unit& u, int wr, int wc, int fr, int fq) const {
        const int row0 = u.pm * BM + wr * 64 + fr, col0 = u.pn * HALF + wc * 32 + 8 * fq;
#pragma unroll
        for (int ai = 0; ai < 2; ++ai)
#pragma unroll
            for (int m = 0; m < 4; ++m) { unsigned char* rowp = ACT + (size_t)(row0 + ai * HALF + m * 16) * HID + col0;
                float o[8];
#pragma unroll
                for (int n = 0; n < 2; ++n)
#pragma unroll
                    for (int j = 0; j < 4; ++j) { const float g = acc[ai][0][m][n][j] * 0.00390625f, up = acc[ai][1][m][n][j] * 0.00390625f; o[n * 4 + j] = g * sigmoidf_(g) * up; }
                u32x2 w; w.x = cvt_pk_fp8x4_sat(o[0], o[1], o[2], o[3]); w.y = cvt_pk_fp8x4_sat(o[4], o[5], o[6], o[7]);
                *(u32x2*)rowp = w; }
    }
};
struct EpiScatter {
    static constexpr bool PERM = true;
    unsigned char* Y; const LAS int* rows; const LAS float* wts;
    __device__ __forceinline__ void operator()(const f32x4 (&acc)[2][2][4][2], const Unit& u, int wr, int wc, int fr, int fq) const {
        const int r0 = wr * 64 + fr, col0 = u.pn * BM + wc * 32 + 8 * fq;
#pragma unroll
        for (int ai = 0; ai < 2; ++ai)
#pragma unroll
            for (int m = 0; m < 4; ++m) { const int r = r0 + ai * HALF + m * 16; const int dest = rows[u.ui * 256 + r];
                if (dest >= 0) { const float w_ = wts[u.ui * 256 + r] * 0.0625f; unsigned char* rowp = Y + (size_t)dest * DM + col0;
#pragma unroll
                    for (int bj = 0; bj < 2; ++bj) { const f32x4 v0 = acc[ai][bj][m][0] * w_, v1 = acc[ai][bj][m][1] * w_;
                        u32x2 w; w.x = cvt_pk_fp8x4_sat(v0[0], v0[1], v0[2], v0[3]); w.y = cvt_pk_fp8x4_sat(v1[0], v1[1], v1[2], v1[3]);
                        *(u32x2*)(rowp + bj * HALF) = w; } } }
    }
};
}

namespace att {
constexpr int D = 128, NW = 8, QBLK = 32, KVBLK = 64;
constexpr float SCALE = 0.088388347648318440f;
constexpr float THR = 8.f;
constexpr int LDP = INW;
constexpr int LDO = DM;
constexpr size_t SHM_V = KVBLK * D * 2, SHM_K = KVBLK * D * 2, SHM_ATTN = 2 * SHM_V + 2 * SHM_K + NW * 64 * 4;
constexpr int RPB_OFF = (int)SHM_ATTN;
#define KSWZ(row, colB) ((row) * 256 + ((colB) ^ (((row) & 7) << 4)))
#define SBAR() __builtin_amdgcn_sched_barrier(0)
__device__ __forceinline__ int crow(int r, int hi) { return (r & 3) + 8 * (r >> 2) + 4 * hi; }

__device__ __forceinline__ void partialSM(f32x16& p0, f32x16& p1, float& m_reg, float& mn, float& alpha) {
  constexpr float C = SCALE * 1.4426950408889634f;
  float pmax = p0[0]; for (int r = 1; r < 16; ++r) pmax = fmaxf(pmax, p0[r]); for (int r = 0; r < 16; ++r) pmax = fmaxf(pmax, p1[r]);
  { auto rr = __builtin_amdgcn_permlane32_swap(__float_as_uint(pmax), __float_as_uint(pmax), false, false);
    pmax = fmaxf(__uint_as_float(rr[0]), __uint_as_float(rr[1])); }
  if (__builtin_expect(__all(pmax - m_reg <= THR / SCALE), 1)) { mn = m_reg; alpha = 1.f; }
  else { mn = fmaxf(m_reg, pmax); alpha = __builtin_amdgcn_exp2f((m_reg - mn) * C); m_reg = mn; }
  float mnC = -mn * C;
  for (int r = 0; r < 16; ++r) p0[r] = fmaf(p0[r], C, mnC); for (int r = 0; r < 16; ++r) p1[r] = fmaf(p1[r], C, mnC);
  for (int r = 0; r < 16; ++r) p0[r] = __builtin_amdgcn_exp2f(p0[r]);
}
__device__ __forceinline__ void finishSM(f32x16& p0, f32x16& p1, float alpha, float& l_reg, bf16x8& pa0, bf16x8& pa1, bf16x8& pa2, bf16x8& pa3) {
  for (int r = 0; r < 16; ++r) p1[r] = __builtin_amdgcn_exp2f(p1[r]);
  float ps = 0; for (int r = 0; r < 16; ++r) ps += p0[r]; for (int r = 0; r < 16; ++r) ps += p1[r];
  { auto rr = __builtin_amdgcn_permlane32_swap(__float_as_uint(ps), __float_as_uint(ps), false, false);
    ps = __uint_as_float(rr[0]) + __uint_as_float(rr[1]); }
  l_reg = l_reg * alpha + ps;
#define PK4(P, BASE, OUT) do { unsigned a0 = cvt_pk_bf16(P[BASE + 0], P[BASE + 1]), a1 = cvt_pk_bf16(P[BASE + 2], P[BASE + 3]);   \
    unsigned b0 = cvt_pk_bf16(P[BASE + 4], P[BASE + 5]), b1 = cvt_pk_bf16(P[BASE + 6], P[BASE + 7]);                              \
    auto r0 = __builtin_amdgcn_permlane32_swap(a0, b0, false, false); auto r1 = __builtin_amdgcn_permlane32_swap(a1, b1, false, false); \
    u32x4 w = {r0[0], r1[0], r0[1], r1[1]}; OUT = *reinterpret_cast<bf16x8*>(&w); } while (0)
  PK4(p0, 0, pa0); PK4(p0, 8, pa1); PK4(p1, 0, pa2); PK4(p1, 8, pa3);
#undef PK4
}
__device__ __forceinline__ void qkt(f32x16& p0, f32x16& p1, const bf16_t* Ks, const bf16x8* qr, int r32, int hi) {
  p0 = f32x16{}; p1 = f32x16{};
  for (int d0 = 0; d0 < 8; ++d0) { int cb = (d0 * 16 + hi * 8) * 2;
    bf16x8 b0 = *reinterpret_cast<const bf16x8*>((const char*)Ks + KSWZ(r32, cb));
    bf16x8 b1 = *reinterpret_cast<const bf16x8*>((const char*)Ks + KSWZ(32 + r32, cb));
    p0 = __builtin_amdgcn_mfma_f32_32x32x16_bf16(b0, qr[d0], p0, 0, 0, 0);
    p1 = __builtin_amdgcn_mfma_f32_32x32x16_bf16(b1, qr[d0], p1, 0, 0, 0); }
}
__device__ __forceinline__ int v_st(int k, int c) { const int kk = (k & ~0xC) | ((k & 4) << 1) | ((k & 8) >> 1); return ((kk >> 3) * 4 + (c >> 5)) * 512 + ((kk & 7) * 32 + (c & 31)) * 2; }
__device__ __forceinline__ int v_rd_base(int lane) { return ((lane & 3) << 3) | (((lane >> 2) & 3) << 6) | (((lane >> 4) & 1) << 5) | (((lane >> 5) & 1) << 8); }
constexpr int v_rd_off(int d0, int ks, int half) { return d0 * 512 + ks * 4096 + half * 2048; }
template <int OFF> __device__ __forceinline__ s16x4 tr_read(int vb) {
  s16x4 r; asm volatile("ds_read_b64_tr_b16 %0, %1 offset:%2" : "=&v"(r) : "v"(vb), "i"(OFF) : "memory"); return r;
}
template <int D0> __device__ __forceinline__ void pv_one(f32x16& od, int vb, bf16x8 pa0, bf16x8 pa1, bf16x8 pa2, bf16x8 pa3) {
  const s16x4 l0 = tr_read<v_rd_off(D0, 0, 0)>(vb), h0 = tr_read<v_rd_off(D0, 0, 1)>(vb), l1 = tr_read<v_rd_off(D0, 1, 0)>(vb), h1 = tr_read<v_rd_off(D0, 1, 1)>(vb);
  const s16x4 l2 = tr_read<v_rd_off(D0, 2, 0)>(vb), h2 = tr_read<v_rd_off(D0, 2, 1)>(vb), l3 = tr_read<v_rd_off(D0, 3, 0)>(vb), h3 = tr_read<v_rd_off(D0, 3, 1)>(vb);
  asm volatile("s_waitcnt lgkmcnt(0)" ::: "memory"); SBAR();
#define PK(L, H) (bf16x8){L[0], L[1], L[2], L[3], H[0], H[1], H[2], H[3]}
  od = __builtin_amdgcn_mfma_f32_32x32x16_bf16(pa0, PK(l0, h0), od, 0, 0, 0);
  od = __builtin_amdgcn_mfma_f32_32x32x16_bf16(pa1, PK(l1, h1), od, 0, 0, 0);
  od = __builtin_amdgcn_mfma_f32_32x32x16_bf16(pa2, PK(l2, h2), od, 0, 0, 0);
  od = __builtin_amdgcn_mfma_f32_32x32x16_bf16(pa3, PK(l3, h3), od, 0, 0, 0);
#undef PK
}
__device__ __forceinline__ void pv_d0(f32x16* o, int vb, bf16x8 pa0, bf16x8 pa1, bf16x8 pa2, bf16x8 pa3) {
  pv_one<0>(o[0], vb, pa0, pa1, pa2, pa3); pv_one<1>(o[1], vb, pa0, pa1, pa2, pa3); pv_one<2>(o[2], vb, pa0, pa1, pa2, pa3); pv_one<3>(o[3], vb, pa0, pa1, pa2, pa3);
}

struct Job { const bf16_t* Q; const bf16_t* K; const bf16_t* V; bf16_t* O; int nt, mode, row_a, row_b, gr0, kstart; };
__device__ __forceinline__ int ufy(int v) { v = __builtin_amdgcn_readfirstlane(v); asm volatile("" : "+s"(v)); return v; }
template <class T> __device__ __forceinline__ T* ufyp(T* q) { unsigned long long a = (unsigned long long)q; unsigned lo = __builtin_amdgcn_readfirstlane((unsigned)a), hi = __builtin_amdgcn_readfirstlane((unsigned)(a >> 32)); asm volatile("" : "+s"(lo), "+s"(hi)); return (T*)(((unsigned long long)hi << 32) | lo); }
__device__ __forceinline__ void opaque(Job& J) { J.Q = ufyp(J.Q); J.K = ufyp(J.K); J.V = ufyp(J.V); J.O = ufyp(J.O); J.nt = ufy(J.nt); J.row_a = ufy(J.row_a); J.row_b = ufy(J.row_b); J.gr0 = ufy(J.gr0); J.kstart = ufy(J.kstart); }

template <int MODE> __device__ __forceinline__ void na_mask(f32x16& p0, f32x16& p1, const Job& J, int t, int wid, int r32, int hi, const float* rpb) {
  if (MODE == 1 && t >= 4) {
    const int r = J.gr0 + (wid >> 1), j = ((wid & 1) << 5) + r32, kr = J.kstart + t - 4;
    const int rs = min(max(r - 4, 0), 120), cs = min(max(j - 8, 0), 48);
    const bool rowok = (kr >= rs) && (kr < rs + 8);
    const int base = (kr - r + 7) * 31 - j + 15;
#pragma unroll
    for (int q = 0; q < 16; ++q) {
      const int c0 = crow(q, hi), c1 = c0 + 32;
      const bool in0 = rowok && ((unsigned)(c0 - cs) < 16u), in1 = rowok && ((unsigned)(c1 - cs) < 16u);
      const float b0 = rpb[in0 ? base + c0 : 0], b1 = rpb[in1 ? base + c1 : 0];
      p0[q] = in0 ? p0[q] + b0 : -1e30f; p1[q] = in1 ? p1[q] + b1 : -1e30f;
    }
  }
}

template <int MODE> __device__ __forceinline__ void attn_unit(const Job& J, char* lds) {
  int tz = threadIdx.x; asm volatile("" : "+v"(tz));
  const int tid = tz, wid = tid >> 6, lane = tid & 63, r32 = lane & 31, hi = lane >> 5;
  bf16_t* V_lds = (bf16_t*)lds; bf16_t* K_lds = (bf16_t*)(lds + 2 * SHM_V);
  float* ws = (float*)(lds + 2 * SHM_V + 2 * SHM_K) + wid * 64; float* li_l = ws; float* al_l = ws + 32;
  const float* rpb = (const float*)(lds + RPB_OFF);
  float m_reg = -1e30f, l_reg = 0; f32x16 o[4] = {}; bf16x8 qr[8];
  const bf16_t* Qw = J.Q + (long)(wid * QBLK + r32) * LDP + hi * 8;
#pragma unroll
  for (int d0 = 0; d0 < 8; ++d0) qr[d0] = *reinterpret_cast<const bf16x8*>(Qw + d0 * 16);
  const int sr = tid >> 4, sc = (tid & 15) * 8, vst0 = v_st(sr, sc), vst1 = v_st(32 + sr, sc);
  const int vb0 = (int)(uintptr_t)V_lds + v_rd_base(lane);
  struct { bf16x8 vs0, vs1, ks0, ks1; } sr_[2];
#define TROW(t) ((MODE == 1 && (t) >= 4) ? (J.row_b + 64 * ((t) - 4)) : (J.row_a + 64 * (t)))
#define SLOAD(i, t) do { const long _r0 = (long)(TROW(t) + sr) * LDP + sc; sr_[i].vs0 = *reinterpret_cast<const bf16x8*>(J.V + _r0); sr_[i].vs1 = *reinterpret_cast<const bf16x8*>(J.V + _r0 + 32L * LDP); \
    sr_[i].ks0 = *reinterpret_cast<const bf16x8*>(J.K + _r0); sr_[i].ks1 = *reinterpret_cast<const bf16x8*>(J.K + _r0 + 32L * LDP); } while (0)
#define SWRITE(b, i) do { *(bf16x8*)((char*)V_lds + (b) * SHM_V + vst0) = sr_[i].vs0;          \
    *(bf16x8*)((char*)V_lds + (b) * SHM_V + vst1) = sr_[i].vs1; int kc = sc * 2;               \
    *(bf16x8*)((char*)K_lds + (b) * SHM_K + KSWZ(sr, kc)) = sr_[i].ks0;                       \
    *(bf16x8*)((char*)K_lds + (b) * SHM_K + KSWZ(32 + sr, kc)) = sr_[i].ks1; } while (0)
#define SWAIT() asm volatile("s_waitcnt vmcnt(4)" ::: "memory")
#define RESC(a) do { if (__any((a) < 1.f)) { if (hi == 0) al_l[r32] = (a); asm volatile("s_waitcnt lgkmcnt(0)" ::: "memory"); \
    for (int d = 0; d < 4; ++d) for (int r = 0; r < 16; ++r) o[d][r] *= al_l[crow(r, hi)]; } } while (0)
  f32x16 pA0, pA1, pB0, pB1; float mnA, mnB, alA, alB; bf16x8 pa0, pa1, pa2, pa3; int NT = J.nt; asm volatile("" : "+s"(NT));
  constexpr int SE = 0, SO = 1;
  SLOAD(SE, 0); asm volatile("s_waitcnt vmcnt(0)" ::: "memory"); SWRITE(0, SE); __syncthreads();
  qkt(pA0, pA1, K_lds, qr, r32, hi); na_mask<MODE>(pA0, pA1, J, 0, wid, r32, hi, rpb); partialSM(pA0, pA1, m_reg, mnA, alA);
  SLOAD(SO, 1); if (2 < NT) SLOAD(SE, 2);
  SWAIT(); SWRITE(1, SO); __syncthreads();
#pragma unroll 1
  for (int j = 1; j + 1 < NT; j += 2) {
    SBAR(); qkt(pB0, pB1, (bf16_t*)((char*)K_lds + SHM_K), qr, r32, hi);
    finishSM(pA0, pA1, alA, l_reg, pa0, pa1, pa2, pa3); SBAR();
    SLOAD(SO, min(j + 2, NT - 1)); SBAR();
    pv_d0(o, vb0, pa0, pa1, pa2, pa3); na_mask<MODE>(pB0, pB1, J, j, wid, r32, hi, rpb); partialSM(pB0, pB1, m_reg, mnB, alB);
    __syncthreads(); SWAIT(); SWRITE(0, SE);
    RESC(alB); __syncthreads();
    SBAR(); qkt(pA0, pA1, K_lds, qr, r32, hi);
    finishSM(pB0, pB1, alB, l_reg, pa0, pa1, pa2, pa3); SBAR();
    if (j + 3 < NT) SLOAD(SE, j + 3); SBAR();
    pv_d0(o, vb0 + (int)SHM_V, pa0, pa1, pa2, pa3); na_mask<MODE>(pA0, pA1, J, j + 1, wid, r32, hi, rpb); partialSM(pA0, pA1, m_reg, mnA, alA);
    __syncthreads(); SWAIT(); SWRITE(1, SO);
    RESC(alA); __syncthreads();
  }
  SBAR(); qkt(pB0, pB1, (bf16_t*)((char*)K_lds + SHM_K), qr, r32, hi);
  finishSM(pA0, pA1, alA, l_reg, pa0, pa1, pa2, pa3); SBAR();
  pv_d0(o, vb0, pa0, pa1, pa2, pa3); na_mask<MODE>(pB0, pB1, J, NT - 1, wid, r32, hi, rpb); partialSM(pB0, pB1, m_reg, mnB, alB);
  __syncthreads(); RESC(alB);
  finishSM(pB0, pB1, alB, l_reg, pa0, pa1, pa2, pa3); SBAR();
  pv_d0(o, vb0 + (int)SHM_V, pa0, pa1, pa2, pa3);
  if (hi == 0) li_l[r32] = l_reg; asm volatile("s_waitcnt lgkmcnt(0)" ::: "memory");
  float rli[16];
#pragma unroll
  for (int r = 0; r < 16; ++r) rli[r] = __builtin_amdgcn_rcpf(li_l[crow(r, hi)]);
  bf16_t* Ow = J.O + (long)(wid * QBLK) * LDO;
#pragma unroll
  for (int r = 0; r < 16; ++r) { int orow = crow(r, hi);
    for (int d0 = 0; d0 < 4; ++d0) Ow[(long)orow * LDO + d0 * 32 + r32] = (bf16_t)(cvt_pk_bf16(o[d0][r] * rli[r], 0.f) & 0xffffu); }
  asm volatile("s_waitcnt vmcnt(0)" ::: "memory");
  __syncthreads();
#undef TROW
#undef SLOAD
#undef SWRITE
#undef SWAIT
#undef RESC
}

__device__ __forceinline__ void attn_unit_na(const Job& J, char* lds) {
  int tz = threadIdx.x; asm volatile("" : "+v"(tz));
  const int tid = tz, wid = tid >> 6, lane = tid & 63, r32 = lane & 31, hi = lane >> 5;
  bf16_t* V_lds = (bf16_t*)lds; bf16_t* K_lds = (bf16_t*)(lds + 2 * SHM_V);
  float* ws = (float*)(lds + 2 * SHM_V + 2 * SHM_K) + wid * 64; float* li_l = ws; float* al_l = ws + 32;
  const float* rpb = (const float*)(lds + RPB_OFF);
  float m_reg = -1e30f, l_reg = 0; f32x16 o[4] = {}; bf16x8 qr[8];
  const bf16_t* Qw = J.Q + (long)(wid * QBLK + r32) * LDP + hi * 8;
#pragma unroll
  for (int d0 = 0; d0 < 8; ++d0) qr[d0] = *reinterpret_cast<const bf16x8*>(Qw + d0 * 16);
  const int sr = tid >> 4, sc = (tid & 15) * 8, vst0 = v_st(sr, sc), vst1 = v_st(32 + sr, sc);
  const int vb0 = (int)(uintptr_t)V_lds + v_rd_base(lane);
  bf16x8 vs0, vs1, ks0, ks1;
#define TROW(t) (((t) >= 4) ? (J.row_b + 64 * ((t) - 4)) : (J.row_a + 64 * (t)))
#define SLOAD(t) do { const long _r0 = (long)(TROW(t) + sr) * LDP + sc; vs0 = *reinterpret_cast<const bf16x8*>(J.V + _r0); vs1 = *reinterpret_cast<const bf16x8*>(J.V + _r0 + 32L * LDP); \
    ks0 = *reinterpret_cast<const bf16x8*>(J.K + _r0); ks1 = *reinterpret_cast<const bf16x8*>(J.K + _r0 + 32L * LDP); } while (0)
#define SWRITE(b) do { *(bf16x8*)((char*)V_lds + (b) * SHM_V + vst0) = vs0; *(bf16x8*)((char*)V_lds + (b) * SHM_V + vst1) = vs1; int kc = sc * 2;               \
    *(bf16x8*)((char*)K_lds + (b) * SHM_K + KSWZ(sr, kc)) = ks0; *(bf16x8*)((char*)K_lds + (b) * SHM_K + KSWZ(32 + sr, kc)) = ks1; } while (0)
  SLOAD(0); asm volatile("s_waitcnt vmcnt(0)" ::: "memory"); SWRITE(0); __syncthreads();
  const int NT = J.nt;
#pragma unroll 1
  for (int t = 0; t < NT; ++t) {
    const int bsel = t & 1;
    if (t + 1 < NT) SLOAD(t + 1);
    bool active = true;
    if (t >= 4) { const int r = J.gr0 + (wid >> 1), kr = J.kstart + t - 4, rs = min(max(r - 4, 0), 120); active = (kr >= rs) && (kr < rs + 8); }
    if (active) {
    f32x16 p0, p1; float mn, al; bf16x8 pa0, pa1, pa2, pa3;
    qkt(p0, p1, (bf16_t*)((char*)K_lds + bsel * SHM_K), qr, r32, hi);
    na_mask<1>(p0, p1, J, t, wid, r32, hi, rpb);
    partialSM(p0, p1, m_reg, mn, al);
    if (__any(al < 1.f)) { if (hi == 0) al_l[r32] = al; asm volatile("s_waitcnt lgkmcnt(0)" ::: "memory");
      for (int d = 0; d < 4; ++d) for (int r = 0; r < 16; ++r) o[d][r] *= al_l[crow(r, hi)]; }
    finishSM(p0, p1, al, l_reg, pa0, pa1, pa2, pa3); SBAR();
    pv_d0(o, vb0 + bsel * (int)SHM_V, pa0, pa1, pa2, pa3);
    }
    if (t + 1 < NT) { asm volatile("s_waitcnt vmcnt(0)" ::: "memory"); SWRITE(bsel ^ 1); }
    __syncthreads();
  }
  if (hi == 0) li_l[r32] = l_reg; asm volatile("s_waitcnt lgkmcnt(0)" ::: "memory");
  float rli[16];
#pragma unroll
  for (int r = 0; r < 16; ++r) rli[r] = __builtin_amdgcn_rcpf(li_l[crow(r, hi)]);
  bf16_t* Ow = J.O + (long)(wid * QBLK) * LDO;
#pragma unroll
  for (int r = 0; r < 16; ++r) { int orow = crow(r, hi);
    for (int d0 = 0; d0 < 4; ++d0) Ow[(long)orow * LDO + d0 * 32 + r32] = (bf16_t)(cvt_pk_bf16(o[d0][r] * rli[r], 0.f) & 0xffffu); }
  asm volatile("s_waitcnt vmcnt(0)" ::: "memory");
  __syncthreads();
#undef TROW
#undef SLOAD
#undef SWRITE
}
}

struct Frame {
    const Params* p; unsigned char* ws; LAS unsigned char* lds; char* ldsg; int tid, lane, wave, bx, G;
};
__device__ __forceinline__ const float* inp(const Frame& F, int i) { i = __builtin_amdgcn_readfirstlane(i); asm volatile("" : "+s"(i)); return F.p->in[i]; }
__device__ __forceinline__ unsigned char* launder_ws(unsigned char* q) { unsigned long long a = (unsigned long long)q; unsigned lo = (unsigned)a, hi = (unsigned)(a >> 32); asm volatile("" : "+s"(lo), "+s"(hi)); return (unsigned char*)(((unsigned long long)hi << 32) | lo); }
__device__ __forceinline__ int launder_i(int v) { asm volatile("" : "+s"(v)); return v; }
#define FACC(name, type, off) __device__ __forceinline__ type* name(const Frame& F) { return (type*)(F.ws + (off)); }
FACC(fMOD, float, WS_MOD) FACC(fROPE, float, WS_ROPE) FACC(fWRT, float, WS_WRT) FACC(fAGG, f32x2, WS_AGG) FACC(fLDEST, int, WS_LDEST) FACC(fLW, float, WS_LW) FACC(fX, bf16_t, WS_X)
FACC(fHB, bf16_t, WS_HB) FACC(fHB8, unsigned char, WS_HB) FACC(fP, bf16_t, WS_P) FACC(fMIX, bf16_t, WS_MIX) FACC(fACT, unsigned char, WS_ACT) FACC(fY, unsigned char, WS_Y) FACC(fWIN, bf16_t, WS_WIN) FACC(fWOUT, bf16_t, WS_WOUT)
FACC(fLAB, u32x4, WS_LAB) FACC(fLRUW, bf16_t, WS_LRUW) FACC(fW1, unsigned char, WS_W1) FACC(fW2, unsigned char, WS_W2) FACC(fCNT, int, WS_CTL + CTL_CNT)

constexpr int P0_CV_L = 26304;
struct CvtDesc { const float* src; void* dst; int ldsrc, lddst, f8; };
__device__ __forceinline__ CvtDesc cvt_desc(const Frame& F, int l, int r) {
    CvtDesc d; d.f8 = 0;
    if (r < 1152) { const int kt = r / 72, nt = r % 72; d.src = inp(F, I_WIN) + ((size_t)l * 2048 + kt * 128) * INW + nt * 64; d.ldsrc = INW; d.dst = fWIN(F) + ((size_t)l * INW + nt * 64) * DM + kt * 128; d.lddst = DM; }
    else if (r < 1664) { r -= 1152; const int kt = r / 32, nt = r % 32; d.src = inp(F, I_WOUT) + ((size_t)l * 2048 + kt * 128) * DM + nt * 64; d.ldsrc = DM; d.dst = fWOUT(F) + ((size_t)l * DM + nt * 64) * DM + kt * 128; d.lddst = DM; }
    else if (r < 1664 + 16384) { r -= 1664; const int up = r >= 8192; r -= up * 8192; const int e = r >> 8, t = r & 255, kt = t >> 4, nt = t & 15, n0 = nt * 64;
        d.src = inp(F, up ? I_MWU : I_MWG) + ((size_t)(l * NEXP + e) * 2048 + kt * 128) * HID + n0; d.ldsrc = HID;
        const int drow = 256 * (n0 >> 7) + (n0 & 127) + up * 128; d.dst = fW1(F) + ((size_t)(l * NEXP + e) * 2048 + drow) * DM + kt * 128; d.lddst = DM; d.f8 = 1; }
    else if (r < 1664 + 24576) { r -= 1664 + 16384; const int e = r >> 8, t = r & 255, kt = t >> 5, nt = t & 31;
        d.src = inp(F, I_MWD) + ((size_t)(l * NEXP + e) * HID + kt * 128) * DM + nt * 64; d.ldsrc = DM; d.dst = fW2(F) + ((size_t)(l * NEXP + e) * DM + nt * 64) * HID + kt * 128; d.lddst = HID; d.f8 = 1; }
    else { r -= 1664 + 24576; const int mat = r >> 1, nt = r & 1, gate = mat >> 4, dd = (mat >> 3) & 1, n = mat & 7;
        d.src = inp(F, gate ? I_LRUWI : I_LRUWR) + ((size_t)((l * 2 + dd) * 8 + n) * 128) * 128 + nt * 64; d.ldsrc = 128;
        d.dst = fLRUW(F) + ((size_t)(((l * 2 + dd) * 8 + n) * 2 + gate) * 128 + nt * 64) * 128; d.lddst = 128; }
    return d;
}
__device__ __forceinline__ CvtDesc cvt_desc_g(const Frame& F, int g) {
    const int l = g >= P0_CV_L ? 1 : 0, sidx = g - l * P0_CV_L;
    const int r = sidx < 1664 ? sidx : (sidx < 1728 ? 26240 + (sidx - 1664) : sidx - 64);
    return cvt_desc(F, l, r);
}
__device__ __forceinline__ void cvt_run(const Frame& F, int first, int stride, int end, LAS float* T) {
    const int tid = F.tid, kk = tid >> 4, n4 = tid & 15, wv = tid >> 6, lane = tid & 63;
    if (first >= end) return;
    f32x4 v[4]; CvtDesc d = cvt_desc_g(F, first);
#pragma unroll
    for (int q = 0; q < 4; ++q) v[q] = __builtin_nontemporal_load((const f32x4*)(d.src + (size_t)(q * 32 + kk) * d.ldsrc + n4 * 4));
    int buf = 0;
#pragma unroll 1
    for (int r = first; r < end; r += stride, buf ^= 1) {
        LAS float* Tb = T + buf * (128 * 65);
#pragma unroll
        for (int q = 0; q < 4; ++q) { const int kr = q * 32 + kk; LAS float* w = Tb + kr * 65 + ((n4 * 4) ^ ((kr >> 4) << 2)); w[0] = v[q][0]; w[1] = v[q][1]; w[2] = v[q][2]; w[3] = v[q][3]; }
        const CvtDesc dc = d;
        if (r + stride < end) { d = cvt_desc_g(F, r + stride);
#pragma unroll
            for (int q = 0; q < 4; ++q) v[q] = __builtin_nontemporal_load((const f32x4*)(d.src + (size_t)(q * 32 + kk) * d.ldsrc + n4 * 4)); }
        __syncthreads();
        if (dc.f8) {
            const int nn = wv * 8 + (lane >> 3), k0 = (lane & 7) * 16; float x[16];
#pragma unroll
            for (int j = 0; j < 16; ++j) x[j] = Tb[(k0 + j) * 65 + (nn ^ ((k0 >> 4) << 2))] * 256.0f;
            *(u32x4*)((unsigned char*)dc.dst + (size_t)nn * dc.lddst + k0) = (u32x4){cvt_pk_fp8x4(x[0], x[1], x[2], x[3]), cvt_pk_fp8x4(x[4], x[5], x[6], x[7]), cvt_pk_fp8x4(x[8], x[9], x[10], x[11]), cvt_pk_fp8x4(x[12], x[13], x[14], x[15])};
        } else {
            const int rr = lane >> 4, k0 = (lane & 15) * 8;
#pragma unroll
            for (int i = 0; i < 2; ++i) { const int nn = wv * 8 + i * 4 + rr; float x[8];
#pragma unroll
                for (int j = 0; j < 8; ++j) x[j] = Tb[(k0 + j) * 65 + (nn ^ ((k0 >> 4) << 2))];
                *(u32x4*)((bf16_t*)dc.dst + (size_t)nn * dc.lddst + k0) = (u32x4){cvt_pk_bf16(x[0], x[1]), cvt_pk_bf16(x[2], x[3]), cvt_pk_bf16(x[4], x[5]), cvt_pk_bf16(x[6], x[7])}; }
        }
    }
    __syncthreads();
}
constexpr int CV_SMALL = 1728, CV_TOTAL = 2 * P0_CV_L;
constexpr int BG_T = 49152;
__device__ __forceinline__ int bg_claim(const Frame& F, int n) {
    LAS int* slot = (LAS int*)(F.lds + LDS_MISC + 256);
    __syncthreads();
    if (F.tid == 0) *slot = __hip_atomic_fetch_add((int*)(F.ws + WS_CTL + CTL_Q), n, __ATOMIC_RELAXED, __HIP_MEMORY_SCOPE_AGENT);
    __syncthreads();
    return *slot;
}
__device__ __forceinline__ void bg_fill(const Frame& F, int quota) {
    if (quota <= 0) return;
    const int g0 = bg_claim(F, quota); if (g0 >= CV_TOTAL) return;
    cvt_run(F, g0, 1, min(g0 + quota, CV_TOTAL), (LAS float*)(F.lds + BG_T));
}
__device__ __forceinline__ void bg_drain(const Frame& F, int target) {
    for (;;) { const int g0 = bg_claim(F, 6); if (g0 >= CV_TOTAL) break; cvt_run(F, g0, 1, min(g0 + 6, CV_TOTAL), (LAS float*)(F.lds + BG_T)); if (g0 + 6 >= target) break; }
}
constexpr int P0_ADA = 384, P0_RT = 96, P0_ROPE = 1, P0_UNITS = P0_ADA + P0_RT + P0_ROPE;
__device__ __forceinline__ void p0_prologue(const Frame& F) {
    const Params& p = *F.p; const int tid = F.tid;
    LAS float* sv = (LAS float*)F.lds;
    LAS float* part = (LAS float*)(F.lds + 24576);
    LAS float* T = (LAS float*)(F.lds + 49152);
    for (int i = tid; i < 3 * 2048; i += NTHR) { const float c = i < 4096 ? inp(F, I_C)[i] : inp(F, I_CCTX)[i - 4096]; sv[i] = c / (1.0f + __expf(-c)); }
    __syncthreads();
    for (int u = F.bx; u < P0_UNITS; u += F.G) {
        if (u < P0_ADA) {
            const int l = u / 192, col0 = (u % 192) * 64, c4 = tid & 15, ks = tid >> 4;
            const float* W = inp(F, I_ADAW) + ((size_t)l * 2048 + ks * 64) * 12288 + col0 + c4 * 4;
            f32x4 a0 = {0, 0, 0, 0}, a1 = a0, a2 = a0;
#pragma unroll 8
            for (int k = 0; k < 64; ++k) { const f32x4 w = __builtin_nontemporal_load((const f32x4*)(W + (size_t)k * 12288)); const float s0 = sv[ks * 64 + k], s1 = sv[2048 + ks * 64 + k], s2 = sv[4096 + ks * 64 + k];
                a0 += w * s0; a1 += w * s1; a2 += w * s2; }
#pragma unroll
            for (int j = 0; j < 4; ++j) { part[(ks * 3 + 0) * 64 + c4 * 4 + j] = a0[j]; part[(ks * 3 + 1) * 64 + c4 * 4 + j] = a1[j]; part[(ks * 3 + 2) * 64 + c4 * 4 + j] = a2[j]; }
            __syncthreads();
            if (tid < 192) { const int v = tid >> 6, c = tid & 63; float s = 0.f;
#pragma unroll
                for (int k = 0; k < 32; ++k) s += part[(k * 3 + v) * 64 + c];
                fMOD(F)[(size_t)(l * 3 + v) * 12288 + col0 + c] = s + inp(F, I_ADAB)[(size_t)l * 12288 + col0 + c]; }
            __syncthreads();
        } else if (u < P0_ADA + P0_RT) {
            const int q = u - P0_ADA, l = q / 48, j = q % 48; bf16_t* wrb = (bf16_t*)fWRT(F);
            for (int k = tid; k < 2048; k += NTHR) { const float v = j < 4 ? inp(F, I_RWG)[((size_t)l * 2048 + k) * 4 + j] : (j < 36 ? inp(F, I_RWE)[((size_t)l * 2048 + k) * 32 + (j - 4)] : 0.f);
                wrb[(size_t)(l * 48 + j) * 2048 + k] = (bf16_t)(cvt_pk_bf16(v, 0.f) & 0xffffu); }
        } else if (u < P0_ADA + P0_RT + P0_ROPE) {
            for (int i = tid; i < 4096; i += NTHR) { const int pos = i >> 5, f = i & 31; const double inv = exp(-9.210340371976184 * (double)f / 32.0); const double ang = (double)pos * inv;
                fROPE(F)[i] = (float)cos(ang); fROPE(F)[4096 + i] = (float)sin(ang); }
        }
    }
    __syncthreads();
    bg_drain(F, CV_SMALL);
}

__device__ __forceinline__ const float* mod_vec(const Frame& F, int l, int row) { const int b = row / TB, t = row - b * TB; return fMOD(F) + (size_t)(l * 3 + (t >= SEQ ? 2 : b)) * 12288; }
typedef u32x4 RowRaw[8];
__device__ __forceinline__ void load_raw(const Frame& F, int l, int row, RowRaw& r) {
    const int lane = F.lane; const int b = row / TB, t = row - b * TB;
    if (l == 0) { const float* src = t >= SEQ ? inp(F, I_CTX) + ((size_t)b * CTXL + (t - SEQ)) * DM : inp(F, I_X) + ((size_t)b * SEQ + t) * DM;
#pragma unroll
        for (int j = 0; j < 8; ++j) r[j] = __builtin_nontemporal_load((const u32x4*)(src + j * 256 + lane * 4));
    } else { const bf16_t* xr = fX(F) + (size_t)row * DM; const unsigned char* y0 = fY(F) + (size_t)row * 2 * DM; const unsigned char* y1 = y0 + DM;
#pragma unroll
        for (int j = 0; j < 8; ++j) { const int c = j * 256 + lane * 4; const u32x2 xw = __builtin_nontemporal_load((const u32x2*)(xr + c)); r[j] = (u32x4){xw.x, xw.y, __builtin_nontemporal_load((const unsigned*)(y0 + c)), __builtin_nontemporal_load((const unsigned*)(y1 + c))}; } }
}
__device__ __forceinline__ void finish_raw(const Frame& F, int l, int row, const RowRaw& r, f32x4 (&xv)[8]) {
    const int lane = F.lane;
    if (l == 0) {
#pragma unroll
        for (int j = 0; j < 8; ++j) xv[j] = __builtin_bit_cast(f32x4, r[j]);
    } else { const float* g = mod_vec(F, l - 1, row) + 10240;
#pragma unroll
        for (int j = 0; j < 8; ++j) { const int c = j * 256 + lane * 4; const f32x4 x = {bflo(r[j].x), bfhi(r[j].x), bflo(r[j].y), bfhi(r[j].y)}, gg = *(const f32x4*)(g + c);
            const unsigned a = r[j].z, bb = r[j].w;
            const f32x2 a0 = __builtin_amdgcn_cvt_pk_f32_fp8((int)a, false), a1 = __builtin_amdgcn_cvt_pk_f32_fp8((int)a, true), b0 = __builtin_amdgcn_cvt_pk_f32_fp8((int)bb, false), b1 = __builtin_amdgcn_cvt_pk_f32_fp8((int)bb, true);
            f32x4 y; y[0] = a0[0] + b0[0]; y[1] = a0[1] + b0[1]; y[2] = a1[0] + b1[0]; y[3] = a1[1] + b1[1]; xv[j] = x + gg * (y * 0.0625f); } }
}
__device__ __forceinline__ float row_rstd(const f32x4 (&xv)[8]) { float s = 0.f;
#pragma unroll
    for (int j = 0; j < 8; ++j) s += xv[j][0] * xv[j][0] + xv[j][1] * xv[j][1] + xv[j][2] * xv[j][2] + xv[j][3] * xv[j][3];
    s = wave_sum(s); return rsqrtf(s * (1.0f / DM) + EPS); }

__device__ __forceinline__ void n1_phase(const Frame& F, int l, bool dry) {
    const int lane = F.lane, stride = F.G * 8;
    int row = F.bx * 8 + F.wave; RowRaw cur, nxt;
    if (row < MTOK) load_raw(F, l, row, cur);
#pragma unroll 1
    for (; row < MTOK; row += stride) {
        const bool hn = row + stride < MTOK;
        if (hn) load_raw(F, l, row + stride, nxt);
        f32x4 xv[8]; finish_raw(F, l, row, cur, xv);
        bf16_t* xo = (dry ? fP(F) : fX(F)) + (size_t)row * DM;
#pragma unroll
        for (int j = 0; j < 8; ++j) { u32x2 w; w.x = cvt_pk_bf16(xv[j][0], xv[j][1]); w.y = cvt_pk_bf16(xv[j][2], xv[j][3]); *(u32x2*)(xo + j * 256 + lane * 4) = w; }
        const float rstd = row_rstd(xv); const float* mv = mod_vec(F, l, row); const float* g = inp(F, I_N1G) + (size_t)l * DM; bf16_t* ho = (dry ? fMIX(F) : fHB(F)) + (size_t)row * DM;
#pragma unroll
        for (int j = 0; j < 8; ++j) { const int c = j * 256 + lane * 4; const f32x4 gg = *(const f32x4*)(g + c), sh = *(const f32x4*)(mv + c), sc = *(const f32x4*)(mv + 2048 + c);
            const f32x4 h = xv[j] * rstd * gg * (sc + 1.0f) + sh; u32x2 w; w.x = cvt_pk_bf16(h[0], h[1]); w.y = cvt_pk_bf16(h[2], h[3]); *(u32x2*)(ho + c) = w; }
#pragma unroll
        for (int j = 0; j < 8; ++j) cur[j] = nxt[j];
    }
}
__device__ __forceinline__ void fin_phase(const Frame& F) {
    const int lane = F.lane, stride = F.G * 8;
    int q = F.bx * 8 + F.wave; RowRaw cur, nxt;
#define FIN_ROW(qq) (((qq) / SEQ) * TB + ((qq) % SEQ))
    if (q < NB * SEQ) load_raw(F, 2, FIN_ROW(q), cur);
#pragma unroll 1
    for (; q < NB * SEQ; q += stride) {
        const bool hn = q + stride < NB * SEQ;
        if (hn) load_raw(F, 2, FIN_ROW(q + stride), nxt);
        f32x4 xv[8]; finish_raw(F, 2, FIN_ROW(q), cur, xv);
        const float rstd = row_rstd(xv); const float* g = inp(F, I_FING); float* o = (float*)inp(F, I_OUT) + (size_t)q * DM;
#pragma unroll
        for (int j = 0; j < 8; ++j) { const int c = j * 256 + lane * 4; __builtin_nontemporal_store(xv[j] * rstd * *(const f32x4*)(g + c), (f32x4*)(o + c)); }
#pragma unroll
        for (int j = 0; j < 8; ++j) cur[j] = nxt[j];
    }
#undef FIN_ROW
}

constexpr int N2_T = 0, N2_TP = 2056, N2_RED = 16 * N2_TP * 2, N2_LG = N2_RED + 8 * 16 * 48 * 4, N2_CTL = N2_LG + 16 * 48 * 4;
__device__ __forceinline__ void n2_phase(const Frame& F, int l, bool dry) {
    const int lane = F.lane, tid = F.tid, wave = F.wave;
    LAS bf16_t* T = (LAS bf16_t*)(F.lds + N2_T); LAS float* RED = (LAS float*)(F.lds + N2_RED); LAS float* LG = (LAS float*)(F.lds + N2_LG);
    LAS int* lc = (LAS int*)(F.lds + N2_CTL);
    LAS int* gb = lc + 32;
    LAS int* ri = gb + 32;
    LAS float* rw = (LAS float*)(ri + 66 * 4);
    if (tid < 32) lc[tid] = 0;
    __syncthreads();
    const int r0 = F.bx * 66;
    const bf16_t* wrb = (const bf16_t*)fWRT(F) + (size_t)l * 48 * 2048;
    const float* g = inp(F, I_N2G) + (size_t)l * DM; const float* rbg = inp(F, I_RBG) + l * 4; const float* rbe = inp(F, I_RBE) + l * 32;
    bf16x8 WA[8][3];
    { const int fr_ = lane & 15, kq_ = lane >> 4;
#pragma unroll
      for (int s8 = 0; s8 < 8; ++s8)
#pragma unroll
          for (int t3 = 0; t3 < 3; ++t3) WA[s8][t3] = *(const bf16x8*)(wrb + (size_t)(t3 * 16 + fr_) * 2048 + (wave * 8 + s8) * 32 + kq_ * 8); }
    u32x2 xraw[2][8];
#define N2_LOADX(ubv) do { _Pragma("unroll") for (int q2 = 0; q2 < 2; ++q2) { const int rr_ = wave * 2 + q2, row_ = r0 + (ubv) + rr_; const int t_ = row_ % TB; \
        const bool ok_ = ((ubv) + rr_ < 66) && !(l == 1 && t_ >= SEQ); const bf16_t* xr_ = fX(F) + (size_t)row_ * DM; \
        _Pragma("unroll") for (int j = 0; j < 8; ++j) xraw[q2][j] = ok_ ? *(const u32x2*)(xr_ + j * 256 + lane * 4) : (u32x2){0u, 0u}; } } while (0)
    N2_LOADX(0);
#pragma unroll 1
    for (int ub = 0; ub < 66; ub += 16) {
        const int nrow = min(16, 66 - ub);
#pragma unroll
        for (int q2 = 0; q2 < 2; ++q2) {
            const int rr = wave * 2 + q2;
            const int i = ub + rr, row = r0 + i; const int b = row / TB, t = row - b * TB;
            const bool ok = (rr < nrow) && !(l == 1 && t >= SEQ);
            if (ok) {
            f32x4 xv[8];
#pragma unroll
            for (int j = 0; j < 8; ++j) { const u32x2 xw = xraw[q2][j]; xv[j] = (f32x4){bflo(xw.x), bfhi(xw.x), bflo(xw.y), bfhi(xw.y)}; }
            const float rstd = row_rstd(xv); const float* mv = mod_vec(F, l, row); unsigned char* ho = fHB8(F) + (size_t)row * DM;
#pragma unroll
            for (int j = 0; j < 8; ++j) { const int c = j * 256 + lane * 4; const f32x4 gg = *(const f32x4*)(g + c), sh = *(const f32x4*)(mv + 6144 + c), sc = *(const f32x4*)(mv + 8192 + c);
                const f32x4 h = xv[j] * rstd * gg * (sc + 1.0f) + sh; u32x2 w; w.x = cvt_pk_bf16(h[0], h[1]); w.y = cvt_pk_bf16(h[2], h[3]); *(unsigned*)(ho + c) = cvt_pk_fp8x4_sat(h[0], h[1], h[2], h[3]); *(LAS u32x2*)(T + rr * N2_TP + c) = w; }
            }
        }
        if (ub + 16 < 66) N2_LOADX(ub + 16);
        __syncthreads();
        { const int fr = lane & 15, kq = lane >> 4;
          f32x4 acc[3] = {{0, 0, 0, 0}, {0, 0, 0, 0}, {0, 0, 0, 0}};
#pragma unroll
          for (int s = 0; s < 8; ++s) { const int k0 = (wave * 8 + s) * 32 + kq * 8;
              const bf16x8 tb = *(const LAS bf16x8*)(T + fr * N2_TP + k0);
#pragma unroll
              for (int t3 = 0; t3 < 3; ++t3) acc[t3] = __builtin_amdgcn_mfma_f32_16x16x32_bf16(WA[s][t3], tb, acc[t3], 0, 0, 0); }
#pragma unroll
          for (int t3 = 0; t3 < 3; ++t3) *(LAS f32x4*)(RED + (wave * 16 + fr) * 48 + t3 * 16 + kq * 4) = acc[t3]; }
        __syncthreads();
        for (int q = tid; q < 16 * 48; q += NTHR) { float s = 0.f;
#pragma unroll
            for (int w = 0; w < 8; ++w) s += RED[w * 768 + q];
            const int e = q % 48; LG[q] = s + (e < 4 ? rbg[e] : (e < 36 ? rbe[e - 4] : 0.f)); }
        __syncthreads();
        if (tid < nrow) {
            const int i = ub + tid, row = r0 + i; const int b = row / TB, t = row - b * TB;
            if (l == 1 && t >= SEQ) ri[i * 4] = -1;
            else {
                const LAS float* lg = LG + tid * 48;
                int gs = 0; float gm = lg[0];
#pragma unroll
                for (int k = 1; k < 4; ++k) if (lg[k] > gm) { gm = lg[k]; gs = k; }
                float den = 0.f;
#pragma unroll
                for (int k = 0; k < 4; ++k) den += __expf(lg[k] - gm);
                const float ggate = 1.0f / den;
                const LAS float* le = lg + 4 + gs * 8;
                int i0 = 0; float v0 = le[0];
#pragma unroll
                for (int k = 1; k < 8; ++k) if (le[k] > v0) { v0 = le[k]; i0 = k; }
                int i1 = -1; float v1 = -3.0e38f;
#pragma unroll
                for (int k = 0; k < 8; ++k) if (k != i0 && le[k] > v1) { v1 = le[k]; i1 = k; }
                const float e1 = __expf(v1 - v0), w0 = ggate / (1.0f + e1), w1 = ggate * e1 / (1.0f + e1);
                const int ex0 = gs * 8 + i0, ex1 = gs * 8 + i1;
                const int lp0 = __hip_atomic_fetch_add(lc + ex0, 1, __ATOMIC_RELAXED, __HIP_MEMORY_SCOPE_WORKGROUP), lp1 = __hip_atomic_fetch_add(lc + ex1, 1, __ATOMIC_RELAXED, __HIP_MEMORY_SCOPE_WORKGROUP);
                ri[i * 4 + 0] = ex0; ri[i * 4 + 1] = ex1; ri[i * 4 + 2] = lp0; ri[i * 4 + 3] = lp1; rw[i * 2] = w0; rw[i * 2 + 1] = w1;
            }
        }
    }
#undef N2_LOADX
    __syncthreads();
    if (dry) { __syncthreads(); return; }
    if (tid < 32) { const int c = lc[tid]; gb[tid] = c > 0 ? __hip_atomic_fetch_add(fCNT(F) + l * 32 + tid, c, __ATOMIC_RELAXED, __HIP_MEMORY_SCOPE_AGENT) : 0; }
    __syncthreads();
    if (tid < 66 && ri[tid * 4] >= 0) { const int row = r0 + tid;
#pragma unroll
        for (int k = 0; k < 2; ++k) { const int e = ri[tid * 4 + k]; const size_t pos = (size_t)e * CAP + gb[e] + ri[tid * 4 + 2 + k]; fLDEST(F)[pos] = row * 2 + k; fLW(F)[pos] = rw[tid * 2 + k]; } }
    __syncthreads();
}

__device__ __forceinline__ void qknorm_phase(const Frame& F, int l) {
    const int lane = F.lane, li = lane & 15;
    const float* COS = fROPE(F); const float* SIN = fROPE(F) + 4096;
    const float* gqp = inp(F, I_QNORM) + l * 128 + li * 8; const float* gkp = inp(F, I_KNORM) + l * 128 + li * 8;
    const f32x4 gq0 = *(const f32x4*)gqp, gq1 = *(const f32x4*)(gqp + 4), gk0 = *(const f32x4*)gkp, gk1 = *(const f32x4*)(gkp + 4);
    const int half = (li >> 2) & 1, axis = li >> 3;
#pragma unroll 1
    for (int row = (F.bx * 8 + F.wave) * 4 + (lane >> 4); row < MTOK; row += F.G * 32) {
        bf16_t* base = fP(F) + (size_t)row * INW + li * 8;
        u32x4 raw[6];
#pragma unroll
        for (int sl = 0; sl < 6; ++sl) raw[sl] = *(const u32x4*)(base + (sl < 4 ? C_QA + sl * 128 : C_KA + (sl - 4) * 128));
        const int t = row % TB; const bool rope = t < SEQ;
        const int pos = axis ? (t & 63) : (t >> 6); const int fb = (rope ? pos : 0) * 32 + (li & 3) * 8;
        const f32x4 c0 = *(const f32x4*)(COS + fb), c1 = *(const f32x4*)(COS + fb + 4), s0 = *(const f32x4*)(SIN + fb), s1 = *(const f32x4*)(SIN + fb + 4);
#pragma unroll
        for (int sl = 0; sl < 6; ++sl) {
            const u32x4 rw = raw[sl];
            float v[8] = {bflo(rw.x), bfhi(rw.x), bflo(rw.y), bfhi(rw.y), bflo(rw.z), bfhi(rw.z), bflo(rw.w), bfhi(rw.w)};
            float ss = 0.f;
#pragma unroll
            for (int e = 0; e < 8; ++e) ss += v[e] * v[e];
            ss += __shfl_xor(ss, 1); ss += __shfl_xor(ss, 2); ss += __shfl_xor(ss, 4); ss += __shfl_xor(ss, 8);
            const float rstd = rsqrtf(ss * (1.0f / 128.0f) + EPS);
            const f32x4 g0 = sl < 4 ? gq0 : gk0, g1 = sl < 4 ? gq1 : gk1;
#pragma unroll
            for (int e = 0; e < 4; ++e) { v[e] = v[e] * rstd * g0[e]; v[4 + e] = v[4 + e] * rstd * g1[e]; }
            float pr[8];
#pragma unroll
            for (int e = 0; e < 8; ++e) pr[e] = __shfl_xor(v[e], 4);
            if (rope) {
#pragma unroll
                for (int e = 0; e < 8; ++e) { const float c = e < 4 ? c0[e] : c1[e - 4], sn = e < 4 ? s0[e] : s1[e - 4]; v[e] = half ? v[e] * c + pr[e] * sn : v[e] * c - pr[e] * sn; } }
            u32x4 w; w.x = cvt_pk_bf16(v[0], v[1]); w.y = cvt_pk_bf16(v[2], v[3]); w.z = cvt_pk_bf16(v[4], v[5]); w.w = cvt_pk_bf16(v[6], v[7]);
            *(u32x4*)(base + (sl < 4 ? C_QA + sl * 128 : C_KA + (sl - 4) * 128)) = w;
        }
    }
}

template <int DIR> __device__ __forceinline__ void lru_scan(const f32x16 (&A)[2], f32x16 (&Bv)[2], float h_in, int hi, float& Atot, float& hend, bool want_h) {
    float GA[8], GB[8], PA[8], PB[8], hs[8];
#pragma unroll
    for (int j = 0; j < 8; ++j) { const int mt = j >> 2, rb = (j & 3) * 4; float Bc = 0.f, Ap = 1.f;
#pragma unroll
        for (int q = 0; q < 4; ++q) { const int e = DIR ? 3 - q : q; const float a = A[mt][rb + e], b = Bv[mt][rb + e]; Bc = a * Bc + b; Ap *= a; }
        GA[j] = Ap; GB[j] = Bc; PA[j] = __shfl_xor(Ap, 32); PB[j] = __shfl_xor(Bc, 32); }
    float h = h_in, at = 1.f;
#pragma unroll
    for (int q = 0; q < 8; ++q) { const int j = DIR ? 7 - q : q;
        const bool own_first = DIR ? (hi == 1) : (hi == 0);
        const float a0 = own_first ? GA[j] : PA[j], b0 = own_first ? GB[j] : PB[j], a1 = own_first ? PA[j] : GA[j], b1 = own_first ? PB[j] : GB[j];
        const float h0 = h, h1 = a0 * h0 + b0, h2 = a1 * h1 + b1; hs[j] = own_first ? h0 : h1; h = h2; at *= GA[j] * PA[j]; }
    Atot = at; hend = h;
    if (want_h) {
#pragma unroll
        for (int j = 0; j < 8; ++j) { const int mt = j >> 2, rb = (j & 3) * 4; float hc = hs[j];
#pragma unroll
            for (int q = 0; q < 4; ++q) { const int e = DIR ? 3 - q : q; hc = A[mt][rb + e] * hc + Bv[mt][rb + e]; Bv[mt][rb + e] = hc; } }
    }
}
constexpr int LRU_UCF = 0, LRU_UCB = 32768, LRU_HS = 51200, LRU_CAR = 116736, LRU_CW = 126464;
template <bool FINAL> __device__ __forceinline__ void lru_units(const Frame& F, int l) {
    int tz = threadIdx.x; asm volatile("" : "+v"(tz)); const int tid = tz, lane = tid & 63, wave = __builtin_amdgcn_readfirstlane(tid >> 6), r32 = lane & 31, hi = lane >> 5, d = wave >> 2, cg = wave & 3;
    LAS float* UCf = (LAS float*)(F.lds + LRU_UCF); LAS bf16_t* UCb = (LAS bf16_t*)(F.lds + LRU_UCB); LAS float* HS = (LAS float*)(F.lds + LRU_HS);
    LAS float* CAR = (LAS float*)(F.lds + LRU_CAR); LAS float* CW = (LAS float*)(F.lds + LRU_CW);
    const int nch = (FINAL && l == 1) ? SEQ / 64 : NCHUNK;
    const int nunits = NB * nch * 8;
    const int n = F.bx & 7;
    const int ch = n * 128 + cg * 32 + r32;
    const int q0 = F.bx >> 3;
    for (int i = tid; i < 640; i += NTHR) CW[i] = i < 512 ? inp(F, I_CONVW)[(size_t)l * 4096 + (i >> 7) * 1024 + n * 128 + (i & 127)] : inp(F, I_CONVB)[(size_t)l * 1024 + n * 128 + (i - 512)];
    if (FINAL) {
        const int cb_ = tid >> 8, cd = (tid >> 7) & 1, cl = tid & 127;
        const f32x2* ag = fAGG(F) + (size_t)((cb_ * 2 + cd) * NCHUNK) * 1024 + n * 128 + cl;
        float h = 0.f;
#pragma unroll 1
        for (int p0 = 0; p0 < NCHUNK; p0 += 12) {
            f32x2 ab[12];
#pragma unroll
            for (int j = 0; j < 12; ++j) { const int pp = p0 + j; const int cc = cd ? (NCHUNK - 1 - pp) : (pp + 128) % NCHUNK; ab[j] = ag[(size_t)cc * 1024]; }
#pragma unroll
            for (int j = 0; j < 12; ++j) { const int pp = p0 + j; const int cc = cd ? (NCHUNK - 1 - pp) : (pp + 128) % NCHUNK;
                if (cc < nch) { const int q = cb_ * nch + cc - q0; if (q >= 0 && (q & 31) == 0) CAR[((q >> 5) * 2 + cd) * 128 + cl] = h; }
                h = ab[j].x * h + ab[j].y; }
        }
    }
    bf16x8 Br[8], Bi[8];
    { const bf16_t* wb = fLRUW(F) + ((size_t)(((l * 2 + d) * 8 + n) * 2) * 128 + cg * 32 + r32) * 128 + hi * 8;
#pragma unroll
      for (int s = 0; s < 8; ++s) { Br[s] = *(const bf16x8*)(wb + s * 16); Bi[s] = *(const bf16x8*)(wb + 128 * 128 + s * 16); } }
    const float brv = -1.4426950409f * inp(F, I_LRUBR)[(l * 2 + d) * 1024 + ch], biv = -1.4426950409f * inp(F, I_LRUBI)[(l * 2 + d) * 1024 + ch];
    const float lam = inp(F, I_LAM)[(l * 2 + d) * 1024 + ch]; const float sp8 = -8.0f * 1.4426950409f * log1pf(__expf(-lam));
    const int tok = tid >> 3, ch0 = (tid & 7) * 16;
    u32x4 U[4][2];
#define LRU_LOADU(uu) do { const int q_ = (uu) >> 3, b_ = q_ / nch, c_ = q_ - b_ * nch; const int t_ = c_ * 64 + tok, lo_ = c_ >= 128 ? SEQ : 0, hi_ = c_ >= 128 ? TB : SEQ; \
        _Pragma("unroll") for (int i = 0; i < 4; ++i) { const int tt = t_ - 1 + i; if (tt >= lo_ && tt < hi_) { const bf16_t* up = fP(F) + ((size_t)(b_ * TB + tt)) * INW + C_UB + n * 128 + ch0; U[i][0] = *(const u32x4*)up; U[i][1] = *(const u32x4*)(up + 8); } \
            else { U[i][0] = (u32x4){0u, 0u, 0u, 0u}; U[i][1] = (u32x4){0u, 0u, 0u, 0u}; } } } while (0)
    if (F.bx < nunits) LRU_LOADU(F.bx);
    __syncthreads();
    int kk = 0;
#pragma unroll 1
    for (int u = F.bx; u < nunits; u += F.G, ++kk) {
        const int q = u >> 3, b = q / nch, c = q - b * nch;
        { float y[16];
#pragma unroll
          for (int j = 0; j < 16; j += 4) { const f32x4 bv = *(const LAS f32x4*)(CW + 512 + ch0 + j); y[j] = bv[0]; y[j + 1] = bv[1]; y[j + 2] = bv[2]; y[j + 3] = bv[3]; }
#pragma unroll
          for (int i = 0; i < 4; ++i) { const u32x4 u0 = U[i][0], u1 = U[i][1];
              const float uu[16] = {bflo(u0.x), bfhi(u0.x), bflo(u0.y), bfhi(u0.y), bflo(u0.z), bfhi(u0.z), bflo(u0.w), bfhi(u0.w), bflo(u1.x), bfhi(u1.x), bflo(u1.y), bfhi(u1.y), bflo(u1.z), bfhi(u1.z), bflo(u1.w), bfhi(u1.w)};
#pragma unroll
              for (int j = 0; j < 16; j += 4) { const f32x4 wv = *(const LAS f32x4*)(CW + i * 128 + ch0 + j); y[j] += wv[0] * uu[j]; y[j + 1] += wv[1] * uu[j + 1]; y[j + 2] += wv[2] * uu[j + 2]; y[j + 3] += wv[3] * uu[j + 3]; } }
#pragma unroll
          for (int j = 0; j < 16; j += 4) *(LAS f32x4*)(UCf + tok * 128 + ch0 + j) = (f32x4){y[j], y[j + 1], y[j + 2], y[j + 3]};
          LAS u32x4* ub = (LAS u32x4*)(UCb + tok * 136 + ch0);
          ub[0] = (u32x4){cvt_pk_bf16(y[0], y[1]), cvt_pk_bf16(y[2], y[3]), cvt_pk_bf16(y[4], y[5]), cvt_pk_bf16(y[6], y[7])};
          ub[1] = (u32x4){cvt_pk_bf16(y[8], y[9]), cvt_pk_bf16(y[10], y[11]), cvt_pk_bf16(y[12], y[13]), cvt_pk_bf16(y[14], y[15])}; }
        u32x4 g0 = {0u, 0u, 0u, 0u}, g1 = g0;
        const size_t row = (size_t)b * TB + c * 64 + tok;
        if (FINAL) { const bf16_t* gp = fP(F) + row * INW + C_GB + n * 128 + ch0; g0 = *(const u32x4*)gp; g1 = *(const u32x4*)(gp + 8); }
        if (u + F.G < nunits) LRU_LOADU(u + F.G);
        __syncthreads();
        f32x16 av[2] = {}, bv[2] = {};
#pragma unroll
        for (int s = 0; s < 8; ++s)
#pragma unroll
            for (int mt = 0; mt < 2; ++mt) { const bf16x8 a = *(const LAS bf16x8*)(UCb + (mt * 32 + r32) * 136 + s * 16 + hi * 8);
                av[mt] = __builtin_amdgcn_mfma_f32_32x32x16_bf16(a, Br[s], av[mt], 0, 0, 0); bv[mt] = __builtin_amdgcn_mfma_f32_32x32x16_bf16(a, Bi[s], bv[mt], 0, 0, 0); }
        u32x4* lab = fLAB(F) + ((size_t)(u * 8 + wave) * 8) * 64 + lane;
#pragma unroll
        for (int mt = 0; mt < 2; ++mt)
#pragma unroll
            for (int rg = 0; rg < 4; ++rg) { unsigned w4[4];
#pragma unroll
                for (int j = 0; j < 4; ++j) { const int r = rg * 4 + j; const int tk = mt * 32 + (r & 3) + 8 * (r >> 2) + 4 * hi; const float uc = UCf[tk * 128 + cg * 32 + r32];
                    const float e1 = __builtin_amdgcn_exp2f(fminf(fmaf(av[mt][r], -1.4426950409f, brv), 40.f)), e2 = __builtin_amdgcn_exp2f(fminf(fmaf(bv[mt][r], -1.4426950409f, biv), 40.f));
                    const float d1 = 1.0f + e1, d2 = 1.0f + e2, rc = __builtin_amdgcn_rcpf(d1 * d2); const float la = sp8 * (rc * d2); const float a = __builtin_amdgcn_exp2f(la);
                    const float bb = __builtin_amdgcn_sqrtf(fmaxf(fmaf(-a, a, 1.0f), 0.f)) * (rc * d1) * uc; av[mt][r] = a; bv[mt][r] = bb;
                    if (!FINAL) { const _Float16 hl = (_Float16)la; w4[j] = ((unsigned)__builtin_bit_cast(unsigned short, hl) << 16) | (cvt_pk_bf16(bb, 0.f) & 0xffffu); } }
                if (!FINAL) lab[(mt * 4 + rg) * 64] = (u32x4){w4[0], w4[1], w4[2], w4[3]}; }
        if (!FINAL) {
            float At, he;
            if (d == 0) lru_scan<0>(av, bv, 0.f, hi, At, he, false); else lru_scan<1>(av, bv, 0.f, hi, At, he, false);
            if (hi == 0) fAGG(F)[(size_t)((b * 2 + d) * NCHUNK + c) * 1024 + ch] = (f32x2){At, he};
            __syncthreads();
        } else {
            const float h_in = CAR[(kk * 2 + d) * 128 + cg * 32 + r32];
            float At, he;
            if (d == 0) lru_scan<0>(av, bv, h_in, hi, At, he, true); else lru_scan<1>(av, bv, h_in, hi, At, he, true);
#pragma unroll
            for (int mt = 0; mt < 2; ++mt)
#pragma unroll
                for (int r = 0; r < 16; ++r) { const int tk = mt * 32 + (r & 3) + 8 * (r >> 2) + 4 * hi; HS[(d * 64 + tk) * 128 + cg * 32 + r32] = bv[mt][r]; }
            __syncthreads();
            { const float gg[16] = {bflo(g0.x), bfhi(g0.x), bflo(g0.y), bfhi(g0.y), bflo(g0.z), bfhi(g0.z), bflo(g0.w), bfhi(g0.w), bflo(g1.x), bfhi(g1.x), bflo(g1.y), bfhi(g1.y), bflo(g1.z), bfhi(g1.z), bflo(g1.w), bfhi(g1.w)};
              float o[16];
#pragma unroll
              for (int j = 0; j < 16; ++j) o[j] = (HS[tok * 128 + ch0 + j] + HS[(64 + tok) * 128 + ch0 + j]) * gelu_tanh(gg[j]);
              u32x4* op = (u32x4*)(fMIX(F) + row * DM + 512 + n * 128 + ch0);
              op[0] = (u32x4){cvt_pk_bf16(o[0], o[1]), cvt_pk_bf16(o[2], o[3]), cvt_pk_bf16(o[4], o[5]), cvt_pk_bf16(o[6], o[7])};
              op[1] = (u32x4){cvt_pk_bf16(o[8], o[9]), cvt_pk_bf16(o[10], o[11]), cvt_pk_bf16(o[12], o[13]), cvt_pk_bf16(o[14], o[15])}; }
            __syncthreads();
        }
    }
#undef LRU_LOADU
}

__device__ __forceinline__ void lru_pass2(const Frame& F, int l) {
    int tz = threadIdx.x; asm volatile("" : "+v"(tz)); const int tid = tz, lane = tid & 63, wave = __builtin_amdgcn_readfirstlane(tid >> 6), r32 = lane & 31, hi = lane >> 5, d = wave >> 2, cg = wave & 3;
    LAS float* HS = (LAS float*)(F.lds + LRU_HS); LAS float* CAR = (LAS float*)(F.lds + LRU_CAR);
    const int nch = (l == 1) ? SEQ / 64 : NCHUNK;
    const int nunits = NB * nch * 8, n = F.bx & 7, q0 = F.bx >> 3;
    { const int cb_ = tid >> 8, cd = (tid >> 7) & 1, cl = tid & 127;
      const f32x2* ag = fAGG(F) + (size_t)((cb_ * 2 + cd) * NCHUNK) * 1024 + n * 128 + cl;
      float h = 0.f;
#pragma unroll 1
      for (int p0 = 0; p0 < NCHUNK; p0 += 12) {
          f32x2 ab[12];
#pragma unroll
          for (int j = 0; j < 12; ++j) { const int pp = p0 + j; const int cc = cd ? (NCHUNK - 1 - pp) : (pp + 128) % NCHUNK; ab[j] = ag[(size_t)cc * 1024]; }
#pragma unroll
          for (int j = 0; j < 12; ++j) { const int pp = p0 + j; const int cc = cd ? (NCHUNK - 1 - pp) : (pp + 128) % NCHUNK;
              if (cc < nch) { const int q = cb_ * nch + cc - q0; if (q >= 0 && (q & 31) == 0) CAR[((q >> 5) * 2 + cd) * 128 + cl] = h; }
              h = ab[j].x * h + ab[j].y; }
      } }
    const int tok = tid >> 3, ch0 = (tid & 7) * 16;
    u32x4 W[8];
#define LRU_LOADW(uu) do { const int q_ = (uu) >> 3, b_ = q_ / nch, c_ = q_ - b_ * nch; const u32x4* lab_ = fLAB(F) + ((size_t)(((b_ * NCHUNK + c_) * 8 + n) * 8 + wave) * 8) * 64 + lane; \
        _Pragma("unroll") for (int q8 = 0; q8 < 8; ++q8) W[q8] = __builtin_nontemporal_load(lab_ + q8 * 64); } while (0)
    if (F.bx < nunits) LRU_LOADW(F.bx);
    __syncthreads();
    int kk = 0;
#pragma unroll 1
    for (int u = F.bx; u < nunits; u += F.G, ++kk) {
        const int q = u >> 3, b = q / nch, c = q - b * nch;
        f32x16 av[2], bv[2];
#pragma unroll
        for (int q8 = 0; q8 < 8; ++q8)
#pragma unroll
            for (int j = 0; j < 4; ++j) { const unsigned w = W[q8][j]; const int mt = q8 >> 2, r = (q8 & 3) * 4 + j;
                av[mt][r] = __builtin_amdgcn_exp2f((float)__builtin_bit_cast(_Float16, (unsigned short)(w >> 16))); bv[mt][r] = __uint_as_float(w << 16); }
        const size_t row = (size_t)b * TB + c * 64 + tok;
        const bf16_t* gp = fP(F) + row * INW + C_GB + n * 128 + ch0; const u32x4 g0 = *(const u32x4*)gp, g1 = *(const u32x4*)(gp + 8);
        if (u + F.G < nunits) LRU_LOADW(u + F.G);
        const float h_in = CAR[(kk * 2 + d) * 128 + cg * 32 + r32];
        float At, he;
        if (d == 0) lru_scan<0>(av, bv, h_in, hi, At, he, true); else lru_scan<1>(av, bv, h_in, hi, At, he, true);
#pragma unroll
        for (int mt = 0; mt < 2; ++mt)
#pragma unroll
            for (int r = 0; r < 16; ++r) { const int tk = mt * 32 + (r & 3) + 8 * (r >> 2) + 4 * hi; HS[(d * 64 + tk) * 128 + cg * 32 + r32] = bv[mt][r]; }
        __syncthreads();
        { const float gg[16] = {bflo(g0.x), bfhi(g0.x), bflo(g0.y), bfhi(g0.y), bflo(g0.z), bfhi(g0.z), bflo(g0.w), bfhi(g0.w), bflo(g1.x), bfhi(g1.x), bflo(g1.y), bfhi(g1.y), bflo(g1.z), bfhi(g1.z), bflo(g1.w), bfhi(g1.w)};
          float o[16];
#pragma unroll
          for (int j = 0; j < 16; ++j) o[j] = (HS[tok * 128 + ch0 + j] + HS[(64 + tok) * 128 + ch0 + j]) * gelu_tanh(gg[j]);
          u32x4* op = (u32x4*)(fMIX(F) + row * DM + 512 + n * 128 + ch0);
          op[0] = (u32x4){cvt_pk_bf16(o[0], o[1]), cvt_pk_bf16(o[2], o[3]), cvt_pk_bf16(o[4], o[5]), cvt_pk_bf16(o[6], o[7])};
          op[1] = (u32x4){cvt_pk_bf16(o[8], o[9]), cvt_pk_bf16(o[10], o[11]), cvt_pk_bf16(o[12], o[13]), cvt_pk_bf16(o[14], o[15])}; }
        __syncthreads();
    }
#undef LRU_LOADW
}

#ifndef ATT_REP_MODE
#define ATT_REP_MODE 7
#endif
__device__ __forceinline__ void attn_phase(const Frame& F, int l, int rep) {
    const int amode = rep ? ATT_REP_MODE : 7;
    const Params& p = *F.p; const int bx = F.bx;
    const int x = bx & 7, o = (bx >> 3) & 31;
#ifndef NA_SKIP
    if (amode & 2) {
        att::Job J; J.mode = 1;
        const int b = x >> 2, h = x & 3, rg = o;
        float* rp = (float*)(F.ldsg + att::RPB_OFF);
        for (int i = F.tid; i < 15 * 31; i += NTHR) rp[i] = inp(F, I_RPB)[(size_t)(l * 4 + h) * 465 + i] * (1.0f / att::SCALE);
        J.Q = fP(F) + ((size_t)b * TB + rg * 256) * INW + C_QN + h * 128; J.K = fP(F) + C_KN + h * 128; J.V = fP(F) + C_VN + h * 128;
        J.O = fMIX(F) + ((size_t)b * TB + rg * 256) * DM + 1536 + h * 128; J.nt = 16; J.row_a = b * TB + SEQ; J.gr0 = rg * 4;
        J.kstart = min(max(rg * 4 - 4, 0), 116); J.row_b = b * TB + J.kstart * 64;
        att::opaque(J); att::attn_unit_na(J, F.ldsg);
    }
#endif
#ifndef GQA_SKIP
    const int njobs = (amode & 1) ? ((l == 0 && bx < 16) ? 2 : 1) : 0;
#pragma unroll 1
    for (int k = 0; k < njobs; ++k) {
        att::Job J; J.mode = 0; J.row_b = 0; J.gr0 = 0; J.kstart = 0;
        int qc, kc, vc, oc, q0;
        if (k == 0) { const int b = x >> 2, kvh = (x >> 1) & 1, hq = kvh * 2 + (x & 1); q0 = b * TB + o * 256; qc = C_QA + hq * 128; kc = C_KA + kvh * 128; vc = C_VA + kvh * 128; oc = hq * 128; J.nt = TB / 64; J.row_a = b * TB; }
        else { const int b = bx >> 3, hh = bx & 7; q0 = b * TB + SEQ; J.nt = 4; J.row_a = q0;
            qc = hh < 4 ? C_QA + hh * 128 : C_QN + (hh - 4) * 128; kc = hh < 4 ? C_KA + (hh >> 1) * 128 : C_KN + (hh - 4) * 128; vc = hh < 4 ? C_VA + (hh >> 1) * 128 : C_VN + (hh - 4) * 128; oc = hh < 4 ? hh * 128 : 1536 + (hh - 4) * 128; }
        J.Q = fP(F) + (size_t)q0 * INW + qc; J.K = fP(F) + kc; J.V = fP(F) + vc; J.O = fMIX(F) + (size_t)q0 * DM + oc;
        att::opaque(J); att::attn_unit<0>(J, F.ldsg);
    }
#endif
#ifndef LRU2_SKIP
    if (amode & 4) lru_pass2(F, l);
#endif
}

__device__ __forceinline__ int moe_setup(const Frame& F, int l) {
    LAS int* tp = (LAS int*)(F.lds + LDS_MISC); LAS int* ud = (LAS int*)(F.lds + LDS_UD); LAS int* rows = (LAS int*)(F.lds + LDS_ROWS); LAS float* wts = (LAS float*)(F.lds + LDS_WTS);
    const int* cnt = fCNT(F) + l * 32;
    if (F.tid == 0) { int s = 0; for (int e = 0; e < NEXP; ++e) { tp[e] = s; s += (cnt[e] + 255) >> 8; } tp[NEXP] = s; }
    __syncthreads();
    const int total = tp[NEXP] * 8, cc = (F.bx % 8) * (F.G / 8) + F.bx / 8;
    if (F.tid < 8) { const int i = F.tid, L = i * F.G + cc; int e = -1, pn = 0, ml = 0, pm = 0, cv = 0;
        if (L < total) { e = 0; for (int j = 1; j < NEXP; ++j) e = (L >= tp[j] * 8) ? j : e; const int t0 = tp[e], te = tp[e + 1] - t0, rem = L - t0 * 8; pn = rem / te; ml = rem % te; pm = t0 + ml; cv = cnt[e]; }
        ud[i * 8 + 0] = e; ud[i * 8 + 1] = pn; ud[i * 8 + 2] = ml; ud[i * 8 + 3] = pm; ud[i * 8 + 4] = cv; }
    __syncthreads();
    for (int q = F.tid; q < 8 * 256; q += NTHR) { const int i = q >> 8, r = q & 255; const int e = ud[i * 8]; int d = -1; float w = 0.f;
        if (e >= 0) { const int idx = ud[i * 8 + 2] * 256 + r; if (idx < ud[i * 8 + 4]) { d = fLDEST(F)[e * CAP + idx]; w = fLW(F)[e * CAP + idx]; } }
        rows[q] = d; wts[q] = w; }
    __syncthreads();
    return total;
}

constexpr int N_PHASES = 18;
__global__ void __launch_bounds__(NTHR, 2) fwd_kernel(Params prm) {
    extern __shared__ __attribute__((aligned(16))) unsigned char lds_raw[];
    Frame F0; F0.p = &prm; F0.ws = nullptr; F0.lds = (LAS unsigned char*)lds_raw; F0.ldsg = (char*)lds_raw;
    F0.tid = threadIdx.x; F0.lane = F0.tid & 63; F0.wave = __builtin_amdgcn_readfirstlane(F0.tid >> 6); F0.bx = blockIdx.x; F0.G = gridDim.x;
    if (threadIdx.x < 4) ((LAS unsigned*)(F0.lds + LDS_BARW))[threadIdx.x] = 0u;
    __syncthreads();
    const int lo = prm.ph_lo, hi = prm.ph_hi;
    if (hi - lo > 1) (void)xcd_barrier_post((unsigned*)inp(F0, I_WS), (volatile LAS unsigned*)(F0.lds + LDS_BARW));
#ifndef BG_ON
#define BG_ON 1
#endif
#define DENSE_SHORT(nwg) ((((nwg) + F.G - 1) / F.G) - (((nwg) - F.bx + F.G - 1) / F.G))
#ifndef PH_MASK
#define PH_MASK 0xFFu
#endif
#define IN(k) (lo <= (k) && (k) < hi && ((PH_MASK >> ((k) == 0 ? 0 : (k) == 17 ? 0 : (((k) - 1) % 8))) & 1u))
#define GRIDBAR() do { XcdBarrier bar_; bar_.bar = (unsigned*)inp(F0, I_WS); bar_.x = xb_xcc_id(); bar_.st = (volatile LAS unsigned*)((LAS unsigned char*)lds_raw + LDS_BARW); xcd_barrier(bar_); } while (0)
#define SEAM(k) do { if (IN(k) && (IN((k) + 1) || rep_ + 1 < REPS(k))) GRIDBAR(); } while (0)
#ifndef DUP_PH
#define DUP_PH -1
#endif
#define REPS(k) (((k) == 0 ? 8 : (k) == 17 ? 9 : ((k) - 1) % 8) == DUP_PH ? 2 : 1)
#define PHASE_BEGIN(lv) Frame F; F.p = &prm; F.lds = (LAS unsigned char*)lds_raw; F.ldsg = (char*)lds_raw; F.ws = (unsigned char*)inp(F, I_WS); const int l = launder_i(lv); (void)l; { int tz_ = threadIdx.x; asm volatile("" : "+v"(tz_)); F.tid = tz_; F.lane = tz_ & 63; F.wave = __builtin_amdgcn_readfirstlane(tz_ >> 6); F.bx = launder_i(blockIdx.x); F.G = launder_i(gridDim.x); }
    if (IN(0)) for (int rep_ = 0; rep_ < REPS(0); ++rep_) { PHASE_BEGIN(0) p0_prologue(F); SEAM(0); }
#pragma unroll 1
    for (int l0 = 0; l0 < 2; ++l0) {
        const int pb = 1 + 8 * l0;
        if (IN(pb + 0)) for (int rep_ = 0; rep_ < REPS(pb + 0); ++rep_) { PHASE_BEGIN(l0) n1_phase(F, l, rep_ != 0); if (!rep_ && l == 1) bg_drain(F, P0_CV_L + CV_SMALL); SEAM(pb + 0); }
        if (IN(pb + 1)) for (int rep_ = 0; rep_ < REPS(pb + 1); ++rep_) { PHASE_BEGIN(l0)
            pg8::DenseOrder S; S.init(fHB(F), fWIN(F) + (size_t)l * INW * DM, MTOK / 256, INW / 256, DM * 2, F.G, F.bx, 0);
            pg8::EpiP E{fP(F)};
            pg8::gemm_phase<pg8::EpiP, pg8::DenseOrder, false, false>(F.lds, DM * 2, S, E);
            if (BG_ON && !rep_) bg_fill(F, DENSE_SHORT((MTOK / 256) * (INW / 256)) * 30);
            SEAM(pb + 1);
        }
        if (IN(pb + 2)) for (int rep_ = 0; rep_ < REPS(pb + 2); ++rep_) { PHASE_BEGIN(l0) if (!rep_) qknorm_phase(F, l); lru_units<false>(F, l); if (BG_ON && !rep_) bg_fill(F, F.bx >= 64 ? 4 : 0); SEAM(pb + 2); }
        if (IN(pb + 3)) for (int rep_ = 0; rep_ < REPS(pb + 3); ++rep_) { PHASE_BEGIN(l0) attn_phase(F, l, rep_); if (BG_ON && !rep_ && l == 0) bg_fill(F, (F.bx >= 16 ? 6 : 0) + (F.bx >= 64 ? 6 : 0)); SEAM(pb + 3); }
        if (IN(pb + 4)) for (int rep_ = 0; rep_ < REPS(pb + 4); ++rep_) { PHASE_BEGIN(l0)
            pg8::DenseOrder S; S.init(fMIX(F), fWOUT(F) + (size_t)l * DM * DM, l == 0 ? MTOK / 256 : NB * SEQ / 256, DM / 256, DM * 2, F.G, F.bx, l == 0 ? 0 : 1);
            pg8::EpiResid E{fX(F), fMOD(F) + (size_t)l * 3 * 12288, rep_ ? 0.0f : 1.0f};
            pg8::gemm_phase<pg8::EpiResid, pg8::DenseOrder, false, false>(F.lds, DM * 2, S, E);
            if (BG_ON && !rep_ && l == 0) bg_fill(F, DENSE_SHORT((MTOK / 256) * (DM / 256)) * 28);
            SEAM(pb + 4);
        }
        if (IN(pb + 5)) for (int rep_ = 0; rep_ < REPS(pb + 5); ++rep_) { PHASE_BEGIN(l0) n2_phase(F, l, rep_ != 0); if (!rep_) bg_drain(F, l == 0 ? P0_CV_L : CV_TOTAL); SEAM(pb + 5); }
        if (IN(pb + 6)) for (int rep_ = 0; rep_ < REPS(pb + 6); ++rep_) { PHASE_BEGIN(l0)
            const int mtotal = moe_setup(F, l);
            pg8::MoeOrder S; S.ud = (const LAS int*)(F.lds + LDS_UD); S.rows = (const LAS int*)(F.lds + LDS_ROWS); S.pitch = DM; S.A = (const char*)fHB8(F); S.Bt = (const char*)(fW1(F) + (size_t)l * NEXP * 2048 * DM);
            S.bstride = (size_t)2048 * DM; S.gather = 1;
            pg8::EpiSwiglu E{fACT(F)};
            pg8::gemm_phase<pg8::EpiSwiglu, pg8::MoeOrder, true, true>(F.lds, DM, S, E);
            if (BG_ON && !rep_ && l == 0) { const int cc = (F.bx % 8) * (F.G / 8) + F.bx / 8; bg_fill(F, (((mtotal + F.G - 1) / F.G) - ((mtotal - cc + F.G - 1) / F.G)) * 18); }
            SEAM(pb + 6);
        }
        if (IN(pb + 7)) for (int rep_ = 0; rep_ < REPS(pb + 7); ++rep_) { PHASE_BEGIN(l0)
            const int mtotal = moe_setup(F, l);
            pg8::MoeOrder S; S.ud = (const LAS int*)(F.lds + LDS_UD); S.rows = (const LAS int*)(F.lds + LDS_ROWS); S.pitch = HID; S.A = (const char*)fACT(F); S.Bt = (const char*)(fW2(F) + (size_t)l * NEXP * DM * HID);
            S.bstride = (size_t)DM * HID; S.gather = 0;
            pg8::EpiScatter E{fY(F), (const LAS int*)(F.lds + LDS_ROWS), (const LAS float*)(F.lds + LDS_WTS)};
            pg8::gemm_phase<pg8::EpiScatter, pg8::MoeOrder, false, true>(F.lds, HID, S, E);
            if (BG_ON && !rep_ && l == 0) { const int cc = (F.bx % 8) * (F.G / 8) + F.bx / 8; bg_fill(F, (((mtotal + F.G - 1) / F.G) - ((mtotal - cc + F.G - 1) / F.G)) * 12); }
            SEAM(pb + 7);
        }
    }
    if (IN(17)) for (int rep_ = 0; rep_ < REPS(17); ++rep_) { PHASE_BEGIN(2) fin_phase(F); if (rep_ + 1 < REPS(17)) GRIDBAR(); }
#undef IN
#undef SEAM
}

extern "C" void kernel_launch(void* const* d_in, const int* in_sizes, int n_in, void* d_out, int out_size, void* d_ws, size_t ws_size, hipStream_t stream) {
    static int ok = 0;
    if (ok == 0) {
        if (n_in != 28 || out_size != NB * SEQ * DM || ws_size < WS_END) { fprintf(stderr, "kernel_launch: shape mismatch: n_in %d out %d ws %zu (need %zu)\n", n_in, out_size, ws_size, (size_t)WS_END); ok = -1; return; }
        if (hipFuncSetAttribute((const void*)fwd_kernel, hipFuncAttributeMaxDynamicSharedMemorySize, LDS_BYTES) != hipSuccess) { fprintf(stderr, "kernel_launch: hipFuncSetAttribute failed\n"); ok = -1; return; }
        int per_cu = 0;
        if (hipOccupancyMaxActiveBlocksPerMultiprocessor(&per_cu, (const void*)fwd_kernel, NTHR, LDS_BYTES) != hipSuccess || per_cu < 1) fprintf(stderr, "kernel_launch: occupancy query says %d blocks per CU\n", per_cu);
        (void)hipGetLastError();
        ok = 1;
    }
    if (ok < 0) return;
    (void)hipMemsetAsync((char*)d_ws + WS_CTL, 0, CTL_BYTES, stream);
    Params prm{};
    for (int i = 0; i < 28; ++i) prm.in[i] = (const float*)d_in[i];
    prm.in[I_OUT] = (const float*)d_out; prm.in[I_WS] = (const float*)d_ws;
#if MK_N_LAUNCHES == 1
    prm.ph_lo = 0; prm.ph_hi = N_PHASES;
    hipLaunchKernelGGL(fwd_kernel, dim3(GRID), dim3(NTHR), LDS_BYTES, stream, prm);
#else
    for (int k = 0; k < N_PHASES; ++k) { prm.ph_lo = k; prm.ph_hi = k + 1; hipLaunchKernelGGL(fwd_kernel, dim3(GRID), dim3(NTHR), LDS_BYTES, stream, prm); }
#endif
    const hipError_t le = hipPeekAtLastError();
    if (le != hipSuccess) fprintf(stderr, "kernel_launch: launch failed: %s\n", hipGetErrorName(le));
}
```

```cpp
#include <hip/hip_runtime.h>
#include <stdint.h>
#include <stdio.h>

#ifndef MK_N_LAUNCHES
#define MK_N_LAUNCHES 1
#endif

#define LAS __attribute__((address_space(3)))
typedef unsigned short bf16_t;
typedef short bf16x8 __attribute__((ext_vector_type(8)));
typedef short s16x4 __attribute__((ext_vector_type(4)));
typedef float f32x2 __attribute__((ext_vector_type(2)));
typedef float f32x4 __attribute__((ext_vector_type(4)));
typedef float f32x16 __attribute__((ext_vector_type(16)));
typedef unsigned u32x2 __attribute__((ext_vector_type(2)));
typedef unsigned u32x4 __attribute__((ext_vector_type(4)));

constexpr int DM = 2048, NB = 2, SEQ = 8192, CTXL = 256, TB = SEQ + CTXL, MTOK = NB * TB;
constexpr int INW = 4608;
constexpr int C_QA = 0, C_KA = 512, C_VA = 768, C_UB = 1024, C_GB = 2048, C_QN = 3072, C_KN = 3584, C_VN = 4096;
constexpr int NEXP = 32, HID = 1024, CAP = MTOK, NCHUNK = TB / 64;
constexpr int PMAX = 2 * MTOK + NEXP * 256;
constexpr float EPS = 1e-6f;
constexpr int NTHR = 512;
constexpr int GRID = 256;

constexpr size_t al256(size_t x) { return (x + 255) / 256 * 256; }
constexpr size_t WS_CTL = 0, CTL_BYTES = 65536;
constexpr size_t CTL_CNT = 16384, CTL_Q = 20480;
constexpr size_t WS_MOD = WS_CTL + CTL_BYTES;
constexpr size_t WS_ROPE = WS_MOD + al256((size_t)2 * 3 * 12288 * 4);
constexpr size_t WS_WRT = WS_ROPE + 32768;
constexpr size_t WS_AGG = WS_WRT + al256((size_t)2 * 36 * 2048 * 4);
constexpr size_t WS_LDEST = WS_AGG + al256((size_t)2 * 2 * NCHUNK * 1024 * 8);
constexpr size_t WS_LW = WS_LDEST + al256((size_t)NEXP * CAP * 4);
constexpr size_t WS_X = WS_LW + al256((size_t)NEXP * CAP * 4);
constexpr size_t WS_HB = WS_X + al256((size_t)MTOK * DM * 4);
constexpr size_t WS_P = WS_HB + al256((size_t)MTOK * DM * 2);
constexpr size_t WS_MIX = WS_P + al256((size_t)MTOK * INW * 2);
constexpr size_t WS_ACT = WS_MIX + al256((size_t)MTOK * DM * 2);
constexpr size_t WS_Y = WS_ACT + al256((size_t)PMAX * HID * 2);
constexpr size_t WS_LAB = WS_Y + al256((size_t)MTOK * 2 * DM * 2);
constexpr size_t WS_WIN = WS_LAB + al256((size_t)NB * NCHUNK * 8 * 8 * 8 * 64 * 16);
constexpr size_t WS_WOUT = WS_WIN + al256((size_t)2 * INW * DM * 2);
constexpr size_t WS_LRUW = WS_WOUT + al256((size_t)2 * DM * DM * 2);
constexpr size_t WS_W1 = WS_LRUW + al256((size_t)2 * 2 * 8 * 2 * 128 * 128 * 2);
constexpr size_t WS_W2 = WS_W1 + al256((size_t)2 * NEXP * 2048 * DM);
constexpr size_t WS_END = WS_W2 + al256((size_t)2 * NEXP * DM * HID);

constexpr int LDS_STAGE = 131072;
constexpr int LDS_BARW = LDS_STAGE;
constexpr int LDS_MISC = LDS_STAGE + 64;
constexpr int LDS_UD = LDS_STAGE + 512;
constexpr int LDS_ROWS = LDS_STAGE + 1024;
constexpr int LDS_WTS = LDS_ROWS + 8192;
constexpr int LDS_BYTES = LDS_WTS + 8192;

struct Params { const float* in[30]; int ph_lo, ph_hi; };
enum { I_X = 0, I_C, I_CTX, I_CCTX, I_ADAW, I_ADAB, I_N1G, I_N2G, I_WIN, I_WOUT, I_QNORM, I_KNORM, I_CONVW, I_CONVB, I_LRUWR, I_LRUBR, I_LRUWI, I_LRUBI, I_LAM, I_RPB,
       I_RWG, I_RBG, I_RWE, I_RBE, I_MWG, I_MWU, I_MWD, I_FING, I_OUT, I_WS };

__device__ __forceinline__ unsigned cvt_pk_bf16(float lo, float hi) { unsigned r; asm volatile("v_cvt_pk_bf16_f32 %0, %1, %2" : "=v"(r) : "v"(lo), "v"(hi)); return r; }
__device__ __forceinline__ unsigned cvt_pk_fp8x4(float a, float b, float c, float d) { int w = 0; w = __builtin_amdgcn_cvt_pk_fp8_f32(a, b, w, false); w = __builtin_amdgcn_cvt_pk_fp8_f32(c, d, w, true); return (unsigned)w; }
__device__ __forceinline__ unsigned cvt_pk_fp8x4_sat(float a, float b, float c, float d) {
    return cvt_pk_fp8x4(__builtin_amdgcn_fmed3f(a, -448.f, 448.f), __builtin_amdgcn_fmed3f(b, -448.f, 448.f), __builtin_amdgcn_fmed3f(c, -448.f, 448.f), __builtin_amdgcn_fmed3f(d, -448.f, 448.f)); }
__device__ __forceinline__ float bflo(unsigned w) { return __uint_as_float(w << 16); }
__device__ __forceinline__ float bfhi(unsigned w) { return __uint_as_float(w & 0xffff0000u); }
__device__ __forceinline__ float wave_sum(float v) {
#pragma unroll
    for (int o = 32; o >= 1; o >>= 1) v += __shfl_xor(v, o);
    return v;
}
__device__ __forceinline__ float sigmoidf_(float x) { return __builtin_amdgcn_rcpf(1.0f + __expf(-x)); }
__device__ __forceinline__ float gelu_tanh(float x) { const float z = 0.7978845608028654f * (x + 0.044715f * x * x * x); const float e = __expf(2.0f * z); const float th = 1.0f - 2.0f * __builtin_amdgcn_rcpf(e + 1.0f); return 0.5f * x * (1.0f + th); }

#define XB_TMO      128
#define XB_XCNT(j)  (256  + 64 * (j))
#define XB_XSUB(j)  (1280 + 64 * (j))
#define XB_XGEN(j)  (2304 + 64 * (j))
#define XB_TOP      3328
#define XB_TOPGEN   3392
#define XCD_BAR_WORDS 3456
#define XB_SPIN_CAP (1u << 18)
__device__ __forceinline__ unsigned xb_ld(unsigned* p)              { return __hip_atomic_load(p, __ATOMIC_RELAXED, __HIP_MEMORY_SCOPE_AGENT); }
__device__ __forceinline__ unsigned xb_add(unsigned* p, unsigned v) { return __hip_atomic_fetch_add(p, v, __ATOMIC_RELAXED, __HIP_MEMORY_SCOPE_AGENT); }
__device__ __forceinline__ unsigned xb_xcc_id() { return (unsigned)__builtin_amdgcn_s_getreg((3 << 11) | 20) & 0xFu; }
#define XB_SPIN(cond, bar) do { unsigned _sp = 0; while (cond) { __builtin_amdgcn_s_sleep(1); \
    if ((++_sp & 255u) == 0u) { if (xb_ld(&(bar)[XB_TMO])) break; if (_sp > XB_SPIN_CAP) { atomicAdd(&(bar)[XB_TMO], 1u); break; } } } } while (0)
struct XcdBarrier { unsigned* bar; unsigned x; volatile LAS unsigned* st; };
__device__ __forceinline__ XcdBarrier xcd_barrier_post(unsigned* bar, volatile LAS unsigned* st) {
    XcdBarrier b; b.bar = bar; b.x = xb_xcc_id(); b.st = st;
    if (threadIdx.x == 0) (void)xb_add(&bar[XB_XCNT(b.x)], 1u);
    return b;
}
__device__ __forceinline__ void xcd_barrier_complete(unsigned* bar, unsigned x, unsigned& nloc, unsigned& nx) {
    const unsigned G = gridDim.x * gridDim.y * gridDim.z;
    unsigned sum, cnt, mine, sp = 0u;
    for (;;) {
        sum = 0u; cnt = 0u; mine = 0u;
#pragma unroll
        for (unsigned j = 0; j < 16; ++j) { const unsigned c = xb_ld(&bar[XB_XCNT(j)]); sum += c; cnt += (c > 0u) ? 1u : 0u; mine = (j == x) ? c : mine; }
        if (sum == G) break;
        __builtin_amdgcn_s_sleep(1);
        if ((++sp & 255u) == 0u) { if (xb_ld(&bar[XB_TMO])) break; if (sp > XB_SPIN_CAP) { atomicAdd(&bar[XB_TMO], 1u); break; } }
    }
    nloc = mine > 0u ? mine : 1u; nx = cnt > 0u ? cnt : 1u;
}
__device__ __forceinline__ void xcd_barrier(const XcdBarrier& b) {
    asm volatile("s_waitcnt vmcnt(0)" ::: "memory");
    __syncthreads();
    if (threadIdx.x == 0) {
        unsigned* bar = b.bar;
        __builtin_amdgcn_s_waitcnt(0);
        unsigned nloc = b.st[0], nx = b.st[1];
        if (nloc == 0u) { xcd_barrier_complete(bar, b.x, nloc, nx); b.st[0] = nloc; b.st[1] = nx; }
        const unsigned old = xb_add(&bar[XB_XSUB(b.x)], 1u);
        const unsigned gen = old / nloc;
        if (old + 1u == (gen + 1u) * nloc) {
            __builtin_amdgcn_fence(__ATOMIC_RELEASE, "agent");
            asm volatile("s_waitcnt vmcnt(0)" ::: "memory");
            const unsigned og = xb_add(&bar[XB_TOP], 1u);
            const unsigned tg = og / nx;
            if (og + 1u == (tg + 1u) * nx) xb_add(&bar[XB_TOPGEN], 1u);
            else XB_SPIN(xb_ld(&bar[XB_TOPGEN]) == tg, bar);
            __builtin_amdgcn_fence(__ATOMIC_ACQUIRE, "agent");
            xb_add(&bar[XB_XGEN(b.x)], 1u);
            asm volatile("s_waitcnt vmcnt(0)" ::: "memory");
        } else {
            XB_SPIN(xb_ld(&bar[XB_XGEN(b.x)]) == gen, bar);
            __builtin_amdgcn_fence(__ATOMIC_ACQUIRE, "agent");
            asm volatile("s_waitcnt vmcnt(0)" ::: "memory");
        }
    }
    __syncthreads();
}

namespace pg8 {
constexpr int BM = 256, BK = 64, HALF = 128, HTB = HALF * BK * 2, STAGE_BYTES = 8 * HTB, NXCD = 8, WGM = 8;
__device__ __forceinline__ int lds_byte(int r, int c) { const int st = (r >> 4) * 2 + (c >> 5), rr = r & 15, cc = c & 31, ob = rr * 64 + cc * 2; return st * 1024 + (ob ^ (((ob >> 9) & 1) << 5)); }
__device__ __forceinline__ void stage_rc(int b, int& R, int& C) { const int st = b / 1024, sb = b % 1024, swz = sb ^ (((sb >> 9) & 1) << 5); R = (st >> 1) * 16 + swz / 64; C = (st & 1) * 32 + (swz % 64) / 2; }
__device__ __forceinline__ int perm32(int rho) { const int n = rho >> 4, i = rho & 15; return 8 * (i >> 2) + 4 * n + (i & 3); }

struct Unit { int pm, pn, e, ml, cntv, ui; const char* A; const char* B; };

struct DenseOrder {
    int nM, nN, nwg, G, c, pitch, skip32; const char* A; const char* Bt;
    __device__ void init(const void* A_, const void* Bt_, int nM_, int nN_, int pitch_, int G_, int c_, int skip32_) { A = (const char*)A_; Bt = (const char*)Bt_; nM = nM_; nN = nN_; pitch = pitch_; nwg = nM * nN; G = G_; c = c_; skip32 = skip32_; }
    __device__ __forceinline__ bool next(int i, Unit& u) const {
        const long L = (long)i * G + c; if (L >= nwg) return false;
        int wgid = (int)L; { const int q = nwg / NXCD, r = nwg % NXCD, xcd = wgid % NXCD, off = wgid / NXCD; wgid = (xcd < r ? xcd * (q + 1) : r * (q + 1) + (xcd - r) * q) + off; }
        const int nig = WGM * nN, gid = wgid / nig, fm = gid * WGM, gsz = (nM - fm) < WGM ? (nM - fm) : WGM;
        int pm = fm + ((wgid % nig) % gsz); u.pn = (wgid % nig) / gsz; if (skip32) pm += pm >> 5; u.pm = pm; u.e = 0; u.ml = 0; u.cntv = 0; u.ui = 0;
        u.A = A + (size_t)pm * 256 * pitch; u.B = Bt + (size_t)u.pn * 256 * pitch; return true;
    }
    __device__ __forceinline__ unsigned grow(const Unit&, int) const { return 0u; }
};
struct MoeOrder {
    const LAS int* ud; const LAS int* rows; int pitch; const char* A; const char* Bt; size_t bstride; int gather;
    __device__ __forceinline__ bool next(int i, Unit& u) const {
        if (i >= 8) return false;
        const int e = __builtin_amdgcn_readfirstlane(ud[i * 8 + 0]); if (e < 0) return false;
        u.e = e; u.pn = __builtin_amdgcn_readfirstlane(ud[i * 8 + 1]); u.ml = __builtin_amdgcn_readfirstlane(ud[i * 8 + 2]); u.pm = __builtin_amdgcn_readfirstlane(ud[i * 8 + 3]); u.cntv = __builtin_amdgcn_readfirstlane(ud[i * 8 + 4]); u.ui = i;
        u.A = gather ? A : A + (size_t)u.pm * 256 * pitch; u.B = Bt + (size_t)e * bstride + (size_t)u.pn * 256 * pitch; return true;
    }
    __device__ __forceinline__ unsigned grow(const Unit& u, int r) const { const int d = rows[u.ui * 256 + r]; return d >= 0 ? (unsigned)(d >> 1) : 0u; }
};

typedef int i32x8 __attribute__((ext_vector_type(8)));
typedef int i32x4_ __attribute__((ext_vector_type(4)));
template <class Epi, class Sched, bool GATHER, bool FP8>
__device__ __forceinline__ void gemm_phase(LAS unsigned char* lds, const int pitch, const Sched& S, const Epi& E) {
    int tz = threadIdx.x; asm volatile("" : "+v"(tz));
    const int tid = tz, wid = __builtin_amdgcn_readfirstlane(tid >> 6), lane = tid & 63, wr = wid >> 2, wc = wid & 3, fr = lane & 15, fq = lane >> 4;
    const int nt = pitch / 128;
    unsigned voffA[2], voffB[2];
#pragma unroll
    for (int i = 0; i < 2; ++i) { int R, C; stage_rc(tid * 16 + i * 8192, R, C); const int Rb = Epi::PERM ? ((R & ~31) + perm32(R & 31)) : R;
        voffA[i] = (unsigned)(R * pitch + C * 2); voffB[i] = (unsigned)(Rb * pitch + C * 2); }
    const size_t kstep = (size_t)(BK * 2);
    const size_t hstep = (size_t)HALF * pitch;
    const unsigned ldsw = (unsigned)wid * 1024u;
    const int aoff = lds_byte(wr * 64 + fr, fq * 8), boff = lds_byte(wc * 32 + fr, fq * 8);
#define PG8_SA(b, h) (((b) * 2 + (h)) * HTB)
#define PG8_SB(b, h) ((4 + (b) * 2 + (h)) * HTB)
#define PG8_STAGE(bufoff, gbase, voff) do { _Pragma("unroll") for (int _i = 0; _i < 2; ++_i) \
        __builtin_amdgcn_global_load_lds((const unsigned*)((const char*)(gbase) + (voff)[_i]), (LAS unsigned*)(lds + (bufoff) + ldsw + _i * 8192), 16, 0, 0); } while (0)
#define PG8_STAGE_A(bufoff, gbase, h, nx) do { if (GATHER) { unsigned _v[2]; _v[0] = (nx) ? nG[h][0] : gA[h][0]; _v[1] = (nx) ? nG[h][1] : gA[h][1]; PG8_STAGE(bufoff, gbase, _v); } \
        else PG8_STAGE(bufoff, (gbase) + (h) * hstep, voffA); } while (0)
#define PG8_RD(off) (*(const LAS i32x4_*)(lds + (off)))
#define PG8_LDA(dst, b, h) do { _Pragma("unroll") for (int m = 0; m < 4; ++m) dst[m] = __builtin_shufflevector(PG8_RD(PG8_SA(b, h) + aoff + m * 2048), PG8_RD(PG8_SA(b, h) + aoff + m * 2048 + 1024), 0, 1, 2, 3, 4, 5, 6, 7); } while (0)
#define PG8_LDB(dst, b, h) do { _Pragma("unroll") for (int n = 0; n < 2; ++n) dst[n] = __builtin_shufflevector(PG8_RD(PG8_SB(b, h) + boff + n * 2048), PG8_RD(PG8_SB(b, h) + boff + n * 2048 + 1024), 0, 1, 2, 3, 4, 5, 6, 7); } while (0)
#define PG8_LO(x) __builtin_bit_cast(bf16x8, __builtin_shufflevector(x, x, 0, 1, 2, 3))
#define PG8_HI(x) __builtin_bit_cast(bf16x8, __builtin_shufflevector(x, x, 4, 5, 6, 7))
#define PG8_MMA(ai, bj, At, Bt) do { __builtin_amdgcn_s_setprio(1); \
        if (FP8) { _Pragma("unroll") for (int m = 0; m < 4; ++m) _Pragma("unroll") for (int n = 0; n < 2; ++n) \
            asm volatile("v_mfma_scale_f32_16x16x128_f8f6f4 %0, %1, %2, %0, %3, %3 op_sel_hi:[0,0,0]" : "+v"(acc[ai][bj][m][n]) : "v"(Bt[n]), "v"(At[m]), "v"(sc1)); } \
        else { _Pragma("unroll") for (int m = 0; m < 4; ++m) _Pragma("unroll") for (int n = 0; n < 2; ++n) { \
            acc[ai][bj][m][n] = __builtin_amdgcn_mfma_f32_16x16x32_bf16(PG8_LO(Bt[n]), PG8_LO(At[m]), acc[ai][bj][m][n], 0, 0, 0); \
            acc[ai][bj][m][n] = __builtin_amdgcn_mfma_f32_16x16x32_bf16(PG8_HI(Bt[n]), PG8_HI(At[m]), acc[ai][bj][m][n], 0, 0, 0); } } \
        __builtin_amdgcn_s_setprio(0); } while (0)
#define PG8_WAIT_V(n) asm volatile("s_waitcnt vmcnt(" #n ")" ::: "memory")
#define PG8_WAIT_L(n) asm volatile("s_waitcnt lgkmcnt(" #n ")" ::: "memory")
#define PG8_BAR __builtin_amdgcn_s_barrier()
#define PG8_SCHED __builtin_amdgcn_sched_barrier(0)
    Unit cur, nxt; int ui = 0;
    if (!S.next(0, cur)) return;
    unsigned gA[2][2] = {{0u, 0u}, {0u, 0u}}, nG[2][2] = {{0u, 0u}, {0u, 0u}};
    if (GATHER) {
#pragma unroll
        for (int h = 0; h < 2; ++h)
#pragma unroll
            for (int i = 0; i < 2; ++i) { int R, C; stage_rc(tid * 16 + i * 8192, R, C); gA[h][i] = S.grow(cur, h * HALF + R) * (unsigned)pitch + (unsigned)C * 2u; }
    }
    f32x4 acc[2][2][4][2];
#pragma unroll
    for (int a = 0; a < 2; ++a)
#pragma unroll
        for (int b = 0; b < 2; ++b)
#pragma unroll
            for (int m = 0; m < 4; ++m)
#pragma unroll
                for (int n = 0; n < 2; ++n) acc[a][b][m][n] = (f32x4){0.f, 0.f, 0.f, 0.f};
    i32x8 At[4], B0[2], B1[2];
    int sc1 = 0x7F7F7F7F; asm volatile("" : "+v"(sc1));
    const char* cA = cur.A; const char* cB = cur.B;
    PG8_STAGE(PG8_SB(0, 0), cB, voffB); PG8_STAGE_A(PG8_SA(0, 0), cA, 0, false); PG8_STAGE(PG8_SB(0, 1), cB + hstep, voffB); PG8_STAGE_A(PG8_SA(0, 1), cA, 1, false);
    if (wr == 1) PG8_BAR;
    PG8_WAIT_V(4); PG8_BAR;
    PG8_STAGE(PG8_SB(1, 0), cB + kstep, voffB); PG8_STAGE_A(PG8_SA(1, 0), cA + kstep, 0, false); PG8_STAGE(PG8_SB(1, 1), cB + hstep + kstep, voffB);
    PG8_WAIT_V(6); PG8_BAR;
    for (;;) {
        const bool has_next = S.next(ui + 1, nxt);
        const char* nA = has_next ? nxt.A : cA; const char* nB = has_next ? nxt.B : cB;
        if (GATHER) {
#pragma unroll
            for (int h = 0; h < 2; ++h)
#pragma unroll
                for (int i = 0; i < 2; ++i) { int tg = threadIdx.x; asm volatile("" : "+v"(tg)); int R, C; stage_rc(tg * 16 + i * 8192, R, C); nG[h][i] = has_next ? S.grow(nxt, h * HALF + R) * (unsigned)pitch + (unsigned)C * 2u : gA[h][i]; }
        }
#pragma unroll 1
        for (int t = 0; t < nt; t += 2) {
            const bool last = (t == nt - 2);
            const char* a1 = cA + (size_t)(t + 1) * kstep;
            const char* a2 = last ? nA : cA + (size_t)(t + 2) * kstep; const char* b2 = last ? nB : cB + (size_t)(t + 2) * kstep;
            const char* a3 = a2 + kstep; const char* b3 = b2 + kstep;
            PG8_LDB(B0, 0, 0); PG8_SCHED; PG8_LDA(At, 0, 0); PG8_STAGE_A(PG8_SA(1, 1), a1, 1, false);
            PG8_WAIT_L(8); PG8_BAR; PG8_WAIT_L(0); PG8_MMA(0, 0, At, B0); PG8_BAR; PG8_SCHED;
            PG8_LDB(B1, 0, 1); PG8_STAGE(PG8_SB(0, 0), b2, voffB);
            PG8_BAR; PG8_WAIT_L(0); PG8_MMA(0, 1, At, B1); PG8_BAR;
            PG8_LDA(At, 0, 1); PG8_STAGE_A(PG8_SA(0, 0), a2, 0, last);
            PG8_BAR; PG8_WAIT_L(0); PG8_MMA(1, 0, At, B0); PG8_BAR; PG8_SCHED;
            PG8_STAGE(PG8_SB(0, 1), b2 + hstep, voffB);
            PG8_WAIT_V(6); PG8_BAR; PG8_MMA(1, 1, At, B1); PG8_BAR;
            PG8_LDB(B0, 1, 0); PG8_SCHED; PG8_LDA(At, 1, 0); PG8_STAGE_A(PG8_SA(0, 1), a2, 1, last);
            PG8_WAIT_L(8); PG8_BAR; PG8_WAIT_L(0); PG8_MMA(0, 0, At, B0); PG8_BAR; PG8_SCHED;
            PG8_LDB(B1, 1, 1); PG8_STAGE(PG8_SB(1, 0), b3, voffB);
            PG8_BAR; PG8_WAIT_L(0); PG8_MMA(0, 1, At, B1); PG8_BAR;
            PG8_LDA(At, 1, 1); PG8_STAGE_A(PG8_SA(1, 0), a3, 0, last);
            PG8_BAR; PG8_WAIT_L(0); PG8_MMA(1, 0, At, B0); PG8_BAR; PG8_SCHED;
            PG8_STAGE(PG8_SB(1, 1), b3 + hstep, voffB);
            PG8_WAIT_V(6); PG8_BAR; PG8_MMA(1, 1, At, B1); PG8_BAR;
        }
        if (FP8) asm volatile("s_nop 15\n\ts_nop 15\n\ts_nop 15" ::: "memory");
        { int te = threadIdx.x; asm volatile("" : "+v"(te)); const int le = te & 63; E(acc, cur, wr, wc, le & 15, le >> 4); }
        if (!has_next) break;
#pragma unroll
        for (int a = 0; a < 2; ++a)
#pragma unroll
            for (int b = 0; b < 2; ++b)
#pragma unroll
                for (int m = 0; m < 4; ++m)
#pragma unroll
                    for (int n = 0; n < 2; ++n) acc[a][b][m][n] = (f32x4){0.f, 0.f, 0.f, 0.f};
        cur = nxt; cA = nA; cB = nB; ++ui;
        if (GATHER) {
#pragma unroll
            for (int h = 0; h < 2; ++h)
#pragma unroll
                for (int i = 0; i < 2; ++i) gA[h][i] = nG[h][i];
        }
    }
    PG8_WAIT_V(0);
    if (wr == 0) PG8_BAR;
    PG8_BAR;
#undef PG8_SA
#undef PG8_SB
#undef PG8_STAGE
#undef PG8_STAGE_A
#undef PG8_LDA
#undef PG8_LDB
#undef PG8_MMA
#undef PG8_RD
#undef PG8_LO
#undef PG8_HI
#undef PG8_WAIT_V
#undef PG8_WAIT_L
#undef PG8_BAR
#undef PG8_SCHED
}

struct EpiP {
    static constexpr bool PERM = true;
    bf16_t* O;
    __device__ __forceinline__ void operator()(const f32x4 (&acc)[2][2][4][2], const Unit& u, int wr, int wc, int fr, int fq) const {
        const int row0 = u.pm * BM + wr * 64 + fr, col0 = u.pn * BM + wc * 32 + 8 * fq;
#pragma unroll
        for (int ai = 0; ai < 2; ++ai)
#pragma unroll
            for (int m = 0; m < 4; ++m) { bf16_t* rowp = O + (size_t)(row0 + ai * HALF + m * 16) * INW + col0;
#pragma unroll
                for (int bj = 0; bj < 2; ++bj) { const f32x4 v0 = acc[ai][bj][m][0], v1 = acc[ai][bj][m][1];
                    u32x4 w; w.x = cvt_pk_bf16(v0[0], v0[1]); w.y = cvt_pk_bf16(v0[2], v0[3]); w.z = cvt_pk_bf16(v1[0], v1[1]); w.w = cvt_pk_bf16(v1[2], v1[3]);
                    *(u32x4*)(rowp + bj * HALF) = w; } }
    }
};
struct EpiResid {
    static constexpr bool PERM = true;
    bf16_t* X; const float* mod; float scale;
    __device__ __forceinline__ void operator()(const f32x4 (&acc)[2][2][4][2], const Unit& u, int wr, int wc, int fr, int fq) const {
        const int row0 = u.pm * BM + wr * 64 + fr, col0 = u.pn * BM + wc * 32 + 8 * fq;
        const int sel = (u.pm % 33 == 32) ? 2 : u.pm / 33;
        const float* gv = mod + sel * 12288 + 4096;
        f32x4 g[2][2];
#pragma unroll
        for (int bj = 0; bj < 2; ++bj)
#pragma unroll
            for (int n = 0; n < 2; ++n) g[bj][n] = *(const f32x4*)(gv + col0 + bj * HALF + n * 4) * scale;
#pragma unroll
        for (int ai = 0; ai < 2; ++ai)
#pragma unroll
            for (int m = 0; m < 4; ++m) { bf16_t* rowp = X + (size_t)(row0 + ai * HALF + m * 16) * DM + col0;
#pragma unroll
                for (int bj = 0; bj < 2; ++bj) { u32x4* q = (u32x4*)(rowp + bj * HALF); const u32x4 xw = *q;
                    const f32x4 v0 = (f32x4){bflo(xw.x), bfhi(xw.x), bflo(xw.y), bfhi(xw.y)} + g[bj][0] * acc[ai][bj][m][0], v1 = (f32x4){bflo(xw.z), bfhi(xw.z), bflo(xw.w), bfhi(xw.w)} + g[bj][1] * acc[ai][bj][m][1];
                    u32x4 w; w.x = cvt_pk_bf16(v0[0], v0[1]); w.y = cvt_pk_bf16(v0[2], v0[3]); w.z = cvt_pk_bf16(v1[0], v1[1]); w.w = cvt_pk_bf16(v1[2], v1[3]); *q = w; } }
    }
};
struct EpiSwiglu {
    static constexpr bool PERM = true;
    unsigned char* ACT;
    __device__ __forceinline__ void operator()(const f32x4 (&acc)[2][2][4][2], const Unit& u, int wr, int wc, int fr, int fq) const {
        const int row0 = u.pm * BM + wr * 64 + fr, col0 = u.pn * HALF + wc * 32 + 8 * fq;
#pragma unroll
        for (int ai = 0; ai < 2; ++ai)
#pragma unroll
            for (int m = 0; m < 4; ++m) { unsigned char* rowp = ACT + (size_t)(row0 + ai * HALF + m * 16) * HID + col0;
                float o[8];
#pragma unroll
                for (int n = 0; n < 2; ++n)
#pragma unroll
                    for (int j = 0; j < 4; ++j) { const float g = acc[ai][0][m][n][j] * 0.00390625f, up = acc[ai][1][m][n][j] * 0.00390625f; o[n * 4 + j] = g * sigmoidf_(g) * up; }
                u32x2 w; w.x = cvt_pk_fp8x4_sat(o[0], o[1], o[2], o[3]); w.y = cvt_pk_fp8x4_sat(o[4], o[5], o[6], o[7]);
                *(u32x2*)rowp = w; }
    }
};
struct EpiScatter {
    static constexpr bool PERM = true;
    unsigned char* Y; const LAS int* rows; const LAS float* wts;
    __device__ __forceinline__ void operator()(const f32x4 (&acc)[2][2][4][2], const Unit& u, int wr, int wc, int fr, int fq) const {
        const int r0 = wr * 64 + fr, col0 = u.pn * BM + wc * 32 + 8 * fq;
#pragma unroll
        for (int ai = 0; ai < 2; ++ai)
#pragma unroll
            for (int m = 0; m < 4; ++m) { const int r = r0 + ai * HALF + m * 16; const int dest = rows[u.ui * 256 + r];
                if (dest >= 0) { const float w_ = wts[u.ui * 256 + r] * 0.0625f; unsigned char* rowp = Y + (size_t)dest * DM + col0;
#pragma unroll
                    for (int bj = 0; bj < 2; ++bj) { const f32x4 v0 = acc[ai][bj][m][0] * w_, v1 = acc[ai][bj][m][1] * w_;
                        u32x2 w; w.x = cvt_pk_fp8x4_sat(v0[0], v0[1], v0[2], v0[3]); w.y = cvt_pk_fp8x4_sat(v1[0], v1[1], v1[2], v1[3]);
                        *(u32x2*)(rowp + bj * HALF) = w; } } }
    }
};
}

namespace att {
constexpr int D = 128, NW = 8, QBLK = 32, KVBLK = 64;
constexpr float SCALE = 0.088388347648318440f;
constexpr float THR = 8.f;
constexpr int LDP = INW;
constexpr int LDO = DM;
constexpr size_t SHM_V = KVBLK * D * 2, SHM_K = KVBLK * D * 2, SHM_ATTN = 2 * SHM_V + 2 * SHM_K + NW * 64 * 4;
constexpr int RPB_OFF = (int)SHM_ATTN;
#define KSWZ(row, colB) ((row) * 256 + ((colB) ^ (((row) & 7) << 4)))
#define SBAR() __builtin_amdgcn_sched_barrier(0)
__device__ __forceinline__ int crow(int r, int hi) { return (r & 3) + 8 * (r >> 2) + 4 * hi; }

__device__ __forceinline__ void partialSM(f32x16& p0, f32x16& p1, float& m_reg, float& mn, float& alpha) {
  constexpr float C = SCALE * 1.4426950408889634f;
  float pmax = p0[0]; for (int r = 1; r < 16; ++r) pmax = fmaxf(pmax, p0[r]); for (int r = 0; r < 16; ++r) pmax = fmaxf(pmax, p1[r]);
  { auto rr = __builtin_amdgcn_permlane32_swap(__float_as_uint(pmax), __float_as_uint(pmax), false, false);
    pmax = fmaxf(__uint_as_float(rr[0]), __uint_as_float(rr[1])); }
  if (__builtin_expect(__all(pmax - m_reg <= THR / SCALE), 1)) { mn = m_reg; alpha = 1.f; }
  else { mn = fmaxf(m_reg, pmax); alpha = __builtin_amdgcn_exp2f((m_reg - mn) * C); m_reg = mn; }
  float mnC = -mn * C;
  for (int r = 0; r < 16; ++r) p0[r] = fmaf(p0[r], C, mnC); for (int r = 0; r < 16; ++r) p1[r] = fmaf(p1[r], C, mnC);
  for (int r = 0; r < 16; ++r) p0[r] = __builtin_amdgcn_exp2f(p0[r]);
}
__device__ __forceinline__ void finishSM(f32x16& p0, f32x16& p1, float alpha, float& l_reg, bf16x8& pa0, bf16x8& pa1, bf16x8& pa2, bf16x8& pa3) {
  for (int r = 0; r < 16; ++r) p1[r] = __builtin_amdgcn_exp2f(p1[r]);
  float ps = 0; for (int r = 0; r < 16; ++r) ps += p0[r]; for (int r = 0; r < 16; ++r) ps += p1[r];
  { auto rr = __builtin_amdgcn_permlane32_swap(__float_as_uint(ps), __float_as_uint(ps), false, false);
    ps = __uint_as_float(rr[0]) + __uint_as_float(rr[1]); }
  l_reg = l_reg * alpha + ps;
#define PK4(P, BASE, OUT) do { unsigned a0 = cvt_pk_bf16(P[BASE + 0], P[BASE + 1]), a1 = cvt_pk_bf16(P[BASE + 2], P[BASE + 3]);   \
    unsigned b0 = cvt_pk_bf16(P[BASE + 4], P[BASE + 5]), b1 = cvt_pk_bf16(P[BASE + 6], P[BASE + 7]);                              \
    auto r0 = __builtin_amdgcn_permlane32_swap(a0, b0, false, false); auto r1 = __builtin_amdgcn_permlane32_swap(a1, b1, false, false); \
    u32x4 w = {r0[0], r1[0], r0[1], r1[1]}; OUT = *reinterpret_cast<bf16x8*>(&w); } while (0)
  PK4(p0, 0, pa0); PK4(p0, 8, pa1); PK4(p1, 0, pa2); PK4(p1, 8, pa3);
#undef PK4
}
__device__ __forceinline__ void qkt(f32x16& p0, f32x16& p1, const bf16_t* Ks, const bf16x8* qr, int r32, int hi) {
  p0 = f32x16{}; p1 = f32x16{};
  for (int d0 = 0; d0 < 8; ++d0) { int cb = (d0 * 16 + hi * 8) * 2;
    bf16x8 b0 = *reinterpret_cast<const bf16x8*>((const char*)Ks + KSWZ(r32, cb));
    bf16x8 b1 = *reinterpret_cast<const bf16x8*>((const char*)Ks + KSWZ(32 + r32, cb));
    p0 = __builtin_amdgcn_mfma_f32_32x32x16_bf16(b0, qr[d0], p0, 0, 0, 0);
    p1 = __builtin_amdgcn_mfma_f32_32x32x16_bf16(b1, qr[d0], p1, 0, 0, 0); }
}
__device__ __forceinline__ int v_st(int k, int c) { const int kk = (k & ~0xC) | ((k & 4) << 1) | ((k & 8) >> 1); return ((kk >> 3) * 4 + (c >> 5)) * 512 + ((kk & 7) * 32 + (c & 31)) * 2; }
__device__ __forceinline__ int v_rd_base(int lane) { return ((lane & 3) << 3) | (((lane >> 2) & 3) << 6) | (((lane >> 4) & 1) << 5) | (((lane >> 5) & 1) << 8); }
constexpr int v_rd_off(int d0, int ks, int half) { return d0 * 512 + ks * 4096 + half * 2048; }
template <int OFF> __device__ __forceinline__ s16x4 tr_read(int vb) {
  s16x4 r; asm volatile("ds_read_b64_tr_b16 %0, %1 offset:%2" : "=&v"(r) : "v"(vb), "i"(OFF) : "memory"); return r;
}
template <int D0> __device__ __forceinline__ void pv_one(f32x16& od, int vb, bf16x8 pa0, bf16x8 pa1, bf16x8 pa2, bf16x8 pa3) {
  const s16x4 l0 = tr_read<v_rd_off(D0, 0, 0)>(vb), h0 = tr_read<v_rd_off(D0, 0, 1)>(vb), l1 = tr_read<v_rd_off(D0, 1, 0)>(vb), h1 = tr_read<v_rd_off(D0, 1, 1)>(vb);
  const s16x4 l2 = tr_read<v_rd_off(D0, 2, 0)>(vb), h2 = tr_read<v_rd_off(D0, 2, 1)>(vb), l3 = tr_read<v_rd_off(D0, 3, 0)>(vb), h3 = tr_read<v_rd_off(D0, 3, 1)>(vb);
  asm volatile("s_waitcnt lgkmcnt(0)" ::: "memory"); SBAR();
#define PK(L, H) (bf16x8){L[0], L[1], L[2], L[3], H[0], H[1], H[2], H[3]}
  od = __builtin_amdgcn_mfma_f32_32x32x16_bf16(pa0, PK(l0, h0), od, 0, 0, 0);
  od = __builtin_amdgcn_mfma_f32_32x32x16_bf16(pa1, PK(l1, h1), od, 0, 0, 0);
  od = __builtin_amdgcn_mfma_f32_32x32x16_bf16(pa2, PK(l2, h2), od, 0, 0, 0);
  od = __builtin_amdgcn_mfma_f32_32x32x16_bf16(pa3, PK(l3, h3), od, 0, 0, 0);
#undef PK
}
__device__ __forceinline__ void pv_d0(f32x16* o, int vb, bf16x8 pa0, bf16x8 pa1, bf16x8 pa2, bf16x8 pa3) {
  pv_one<0>(o[0], vb, pa0, pa1, pa2, pa3); pv_one<1>(o[1], vb, pa0, pa1, pa2, pa3); pv_one<2>(o[2], vb, pa0, pa1, pa2, pa3); pv_one<3>(o[3], vb, pa0, pa1, pa2, pa3);
}

struct Job { const bf16_t* Q; const bf16_t* K; const bf16_t* V; bf16_t* O; int nt, mode, row_a, row_b, gr0, kstart; };
__device__ __forceinline__ int ufy(int v) { v = __builtin_amdgcn_readfirstlane(v); asm volatile("" : "+s"(v)); return v; }
template <class T> __device__ __forceinline__ T* ufyp(T* q) { unsigned long long a = (unsigned long long)q; unsigned lo = __builtin_amdgcn_readfirstlane((unsigned)a), hi = __builtin_amdgcn_readfirstlane((unsigned)(a >> 32)); asm volatile("" : "+s"(lo), "+s"(hi)); return (T*)(((unsigned long long)hi << 32) | lo); }
__device__ __forceinline__ void opaque(Job& J) { J.Q = ufyp(J.Q); J.K = ufyp(J.K); J.V = ufyp(J.V); J.O = ufyp(J.O); J.nt = ufy(J.nt); J.row_a = ufy(J.row_a); J.row_b = ufy(J.row_b); J.gr0 = ufy(J.gr0); J.kstart = ufy(J.kstart); }

template <int MODE> __device__ __forceinline__ void na_mask(f32x16& p0, f32x16& p1, const Job& J, int t, int wid, int r32, int hi, const float* rpb) {
  if (MODE == 1 && t >= 4) {
    const int r = J.gr0 + (wid >> 1), j = ((wid & 1) << 5) + r32, kr = J.kstart + t - 4;
    const int rs = min(max(r - 4, 0), 120), cs = min(max(j - 8, 0), 48);
    const bool rowok = (kr >= rs) && (kr < rs + 8);
    const int base = (kr - r + 7) * 31 - j + 15;
#pragma unroll
    for (int q = 0; q < 16; ++q) {
      const int c0 = crow(q, hi), c1 = c0 + 32;
      const bool in0 = rowok && ((unsigned)(c0 - cs) < 16u), in1 = rowok && ((unsigned)(c1 - cs) < 16u);
      const float b0 = rpb[in0 ? base + c0 : 0], b1 = rpb[in1 ? base + c1 : 0];
      p0[q] = in0 ? p0[q] + b0 : -1e30f; p1[q] = in1 ? p1[q] + b1 : -1e30f;
    }
  }
}

template <int MODE> __device__ __forceinline__ void attn_unit(const Job& J, char* lds) {
  int tz = threadIdx.x; asm volatile("" : "+v"(tz));
  const int tid = tz, wid = tid >> 6, lane = tid & 63, r32 = lane & 31, hi = lane >> 5;
  bf16_t* V_lds = (bf16_t*)lds; bf16_t* K_lds = (bf16_t*)(lds + 2 * SHM_V);
  float* ws = (float*)(lds + 2 * SHM_V + 2 * SHM_K) + wid * 64; float* li_l = ws; float* al_l = ws + 32;
  const float* rpb = (const float*)(lds + RPB_OFF);
  float m_reg = -1e30f, l_reg = 0; f32x16 o[4] = {}; bf16x8 qr[8];
  const bf16_t* Qw = J.Q + (long)(wid * QBLK + r32) * LDP + hi * 8;
#pragma unroll
  for (int d0 = 0; d0 < 8; ++d0) qr[d0] = *reinterpret_cast<const bf16x8*>(Qw + d0 * 16);
  const int sr = tid >> 4, sc = (tid & 15) * 8, vst0 = v_st(sr, sc), vst1 = v_st(32 + sr, sc);
  const int vb0 = (int)(uintptr_t)V_lds + v_rd_base(lane);
  struct { bf16x8 vs0, vs1, ks0, ks1; } sr_[2];
#define TROW(t) ((MODE == 1 && (t) >= 4) ? (J.row_b + 64 * ((t) - 4)) : (J.row_a + 64 * (t)))
#define SLOAD(i, t) do { const long _r0 = (long)(TROW(t) + sr) * LDP + sc; sr_[i].vs0 = *reinterpret_cast<const bf16x8*>(J.V + _r0); sr_[i].vs1 = *reinterpret_cast<const bf16x8*>(J.V + _r0 + 32L * LDP); \
    sr_[i].ks0 = *reinterpret_cast<const bf16x8*>(J.K + _r0); sr_[i].ks1 = *reinterpret_cast<const bf16x8*>(J.K + _r0 + 32L * LDP); } while (0)
#define SWRITE(b, i) do { *(bf16x8*)((char*)V_lds + (b) * SHM_V + vst0) = sr_[i].vs0;          \
    *(bf16x8*)((char*)V_lds + (b) * SHM_V + vst1) = sr_[i].vs1; int kc = sc * 2;               \
    *(bf16x8*)((char*)K_lds + (b) * SHM_K + KSWZ(sr, kc)) = sr_[i].ks0;                       \
    *(bf16x8*)((char*)K_lds + (b) * SHM_K + KSWZ(32 + sr, kc)) = sr_[i].ks1; } while (0)
#define SWAIT() asm volatile("s_waitcnt vmcnt(4)" ::: "memory")
#define RESC(a) do { if (__any((a) < 1.f)) { if (hi == 0) al_l[r32] = (a); asm volatile("s_waitcnt lgkmcnt(0)" ::: "memory"); \
    for (int d = 0; d < 4; ++d) for (int r = 0; r < 16; ++r) o[d][r] *= al_l[crow(r, hi)]; } } while (0)
  f32x16 pA0, pA1, pB0, pB1; float mnA, mnB, alA, alB; bf16x8 pa0, pa1, pa2, pa3; int NT = J.nt; asm volatile("" : "+s"(NT));
  constexpr int SE = 0, SO = 1;
  SLOAD(SE, 0); asm volatile("s_waitcnt vmcnt(0)" ::: "memory"); SWRITE(0, SE); __syncthreads();
  qkt(pA0, pA1, K_lds, qr, r32, hi); na_mask<MODE>(pA0, pA1, J, 0, wid, r32, hi, rpb); partialSM(pA0, pA1, m_reg, mnA, alA);
  SLOAD(SO, 1); if (2 < NT) SLOAD(SE, 2);
  SWAIT(); SWRITE(1, SO); __syncthreads();
#pragma unroll 1
  for (int j = 1; j + 1 < NT; j += 2) {
    SBAR(); qkt(pB0, pB1, (bf16_t*)((char*)K_lds + SHM_K), qr, r32, hi);
    finishSM(pA0, pA1, alA, l_reg, pa0, pa1, pa2, pa3); SBAR();
    SLOAD(SO, min(j + 2, NT - 1)); SBAR();
    pv_d0(o, vb0, pa0, pa1, pa2, pa3); na_mask<MODE>(pB0, pB1, J, j, wid, r32, hi, rpb); partialSM(pB0, pB1, m_reg, mnB, alB);
    __syncthreads(); SWAIT(); SWRITE(0, SE);
    RESC(alB); __syncthreads();
    SBAR(); qkt(pA0, pA1, K_lds, qr, r32, hi);
    finishSM(pB0, pB1, alB, l_reg, pa0, pa1, pa2, pa3); SBAR();
    if (j + 3 < NT) SLOAD(SE, j + 3); SBAR();
    pv_d0(o, vb0 + (int)SHM_V, pa0, pa1, pa2, pa3); na_mask<MODE>(pA0, pA1, J, j + 1, wid, r32, hi, rpb); partialSM(pA0, pA1, m_reg, mnA, alA);
    __syncthreads(); SWAIT(); SWRITE(1, SO);
    RESC(alA); __syncthreads();
  }
  SBAR(); qkt(pB0, pB1, (bf16_t*)((char*)K_lds + SHM_K), qr, r32, hi);
  finishSM(pA0, pA1, alA, l_reg, pa0, pa1, pa2, pa3); SBAR();
  pv_d0(o, vb0, pa0, pa1, pa2, pa3); na_mask<MODE>(pB0, pB1, J, NT - 1, wid, r32, hi, rpb); partialSM(pB0, pB1, m_reg, mnB, alB);
  __syncthreads(); RESC(alB);
  finishSM(pB0, pB1, alB, l_reg, pa0, pa1, pa2, pa3); SBAR();
  pv_d0(o, vb0 + (int)SHM_V, pa0, pa1, pa2, pa3);
  if (hi == 0) li_l[r32] = l_reg; asm volatile("s_waitcnt lgkmcnt(0)" ::: "memory");
  float rli[16];
#pragma unroll
  for (int r = 0; r < 16; ++r) rli[r] = __builtin_amdgcn_rcpf(li_l[crow(r, hi)]);
  bf16_t* Ow = J.O + (long)(wid * QBLK) * LDO;
#pragma unroll
  for (int r = 0; r < 16; ++r) { int orow = crow(r, hi);
    for (int d0 = 0; d0 < 4; ++d0) Ow[(long)orow * LDO + d0 * 32 + r32] = (bf16_t)(cvt_pk_bf16(o[d0][r] * rli[r], 0.f) & 0xffffu); }
  asm volatile("s_waitcnt vmcnt(0)" ::: "memory");
  __syncthreads();
#undef TROW
#undef SLOAD
#undef SWRITE
#undef SWAIT
#undef RESC
}

__device__ __forceinline__ void attn_unit_na(const Job& J, char* lds) {
  int tz = threadIdx.x; asm volatile("" : "+v"(tz));
  const int tid = tz, wid = tid >> 6, lane = tid & 63, r32 = lane & 31, hi = lane >> 5;
  bf16_t* V_lds = (bf16_t*)lds; bf16_t* K_lds = (bf16_t*)(lds + 2 * SHM_V);
  float* ws = (float*)(lds + 2 * SHM_V + 2 * SHM_K) + wid * 64; float* li_l = ws; float* al_l = ws + 32;
  const float* rpb = (const float*)(lds + RPB_OFF);
  float m_reg = -1e30f, l_reg = 0; f32x16 o[4] = {}; bf16x8 qr[8];
  const bf16_t* Qw = J.Q + (long)(wid * QBLK + r32) * LDP + hi * 8;
#pragma unroll
  for (int d0 = 0; d0 < 8; ++d0) qr[d0] = *reinterpret_cast<const bf16x8*>(Qw + d0 * 16);
  const int sr = tid >> 4, sc = (tid & 15) * 8, vst0 = v_st(sr, sc), vst1 = v_st(32 + sr, sc);
  const int vb0 = (int)(uintptr_t)V_lds + v_rd_base(lane);
  bf16x8 vs0, vs1, ks0, ks1;
#define TROW(t) (((t) >= 4) ? (J.row_b + 64 * ((t) - 4)) : (J.row_a + 64 * (t)))
#define SLOAD(t) do { const long _r0 = (long)(TROW(t) + sr) * LDP + sc; vs0 = *reinterpret_cast<const bf16x8*>(J.V + _r0); vs1 = *reinterpret_cast<const bf16x8*>(J.V + _r0 + 32L * LDP); \
    ks0 = *reinterpret_cast<const bf16x8*>(J.K + _r0); ks1 = *reinterpret_cast<const bf16x8*>(J.K + _r0 + 32L * LDP); } while (0)
#define SWRITE(b) do { *(bf16x8*)((char*)V_lds + (b) * SHM_V + vst0) = vs0; *(bf16x8*)((char*)V_lds + (b) * SHM_V + vst1) = vs1; int kc = sc * 2;               \
    *(bf16x8*)((char*)K_lds + (b) * SHM_K + KSWZ(sr, kc)) = ks0; *(bf16x8*)((char*)K_lds + (b) * SHM_K + KSWZ(32 + sr, kc)) = ks1; } while (0)
  SLOAD(0); asm volatile("s_waitcnt vmcnt(0)" ::: "memory"); SWRITE(0); __syncthreads();
  const int NT = J.nt;
#pragma unroll 1
  for (int t = 0; t < NT; ++t) {
    const int bsel = t & 1;
    if (t + 1 < NT) SLOAD(t + 1);
    bool active = true;
    if (t >= 4) { const int r = J.gr0 + (wid >> 1), kr = J.kstart + t - 4, rs = min(max(r - 4, 0), 120); active = (kr >= rs) && (kr < rs + 8); }
    if (active) {
    f32x16 p0, p1; float mn, al; bf16x8 pa0, pa1, pa2, pa3;
    qkt(p0, p1, (bf16_t*)((char*)K_lds + bsel * SHM_K), qr, r32, hi);
    na_mask<1>(p0, p1, J, t, wid, r32, hi, rpb);
    partialSM(p0, p1, m_reg, mn, al);
    if (__any(al < 1.f)) { if (hi == 0) al_l[r32] = al; asm volatile("s_waitcnt lgkmcnt(0)" ::: "memory");
      for (int d = 0; d < 4; ++d) for (int r = 0; r < 16; ++r) o[d][r] *= al_l[crow(r, hi)]; }
    finishSM(p0, p1, al, l_reg, pa0, pa1, pa2, pa3); SBAR();
    pv_d0(o, vb0 + bsel * (int)SHM_V, pa0, pa1, pa2, pa3);
    }
    if (t + 1 < NT) { asm volatile("s_waitcnt vmcnt(0)" ::: "memory"); SWRITE(bsel ^ 1); }
    __syncthreads();
  }
  if (hi == 0) li_l[r32] = l_reg; asm volatile("s_waitcnt lgkmcnt(0)" ::: "memory");
  float rli[16];
#pragma unroll
  for (int r = 0; r < 16; ++r) rli[r] = __builtin_amdgcn_rcpf(li_l[crow(r, hi)]);
  bf16_t* Ow = J.O + (long)(wid * QBLK) * LDO;
#pragma unroll
  for (int r = 0; r < 16; ++r) { int orow = crow(r, hi);
    for (int d0 = 0; d0 < 4; ++d0) Ow[(long)orow * LDO + d0 * 32 + r32] = (bf16_t)(cvt_pk_bf16(o[d0][r] * rli[r], 0.f) & 0xffffu); }
  asm volatile("s_waitcnt vmcnt(0)" ::: "memory");
  __syncthreads();
#undef TROW
#undef SLOAD
#undef SWRITE
}
}

struct Frame {
    const Params* p; unsigned char* ws; LAS unsigned char* lds; char* ldsg; int tid, lane, wave, bx, G;
};
__device__ __forceinline__ const float* inp(const Frame& F, int i) { i = __builtin_amdgcn_readfirstlane(i); asm volatile("" : "+s"(i)); return F.p->in[i]; }
__device__ __forceinline__ unsigned char* launder_ws(unsigned char* q) { unsigned long long a = (unsigned long long)q; unsigned lo = (unsigned)a, hi = (unsigned)(a >> 32); asm volatile("" : "+s"(lo), "+s"(hi)); return (unsigned char*)(((unsigned long long)hi << 32) | lo); }
__device__ __forceinline__ int launder_i(int v) { asm volatile("" : "+s"(v)); return v; }
#define FACC(name, type, off) __device__ __forceinline__ type* name(const Frame& F) { return (type*)(F.ws + (off)); }
FACC(fMOD, float, WS_MOD) FACC(fROPE, float, WS_ROPE) FACC(fWRT, float, WS_WRT) FACC(fAGG, f32x2, WS_AGG) FACC(fLDEST, int, WS_LDEST) FACC(fLW, float, WS_LW) FACC(fX, bf16_t, WS_X)
FACC(fHB, bf16_t, WS_HB) FACC(fHB8, unsigned char, WS_HB) FACC(fP, bf16_t, WS_P) FACC(fMIX, bf16_t, WS_MIX) FACC(fACT, unsigned char, WS_ACT) FACC(fY, unsigned char, WS_Y) FACC(fWIN, bf16_t, WS_WIN) FACC(fWOUT, bf16_t, WS_WOUT)
FACC(fLAB, u32x4, WS_LAB) FACC(fLRUW, bf16_t, WS_LRUW) FACC(fW1, unsigned char, WS_W1) FACC(fW2, unsigned char, WS_W2) FACC(fCNT, int, WS_CTL + CTL_CNT)

constexpr int P0_CV_L = 26304;
struct CvtDesc { const float* src; void* dst; int ldsrc, lddst, f8; };
__device__ __forceinline__ CvtDesc cvt_desc(const Frame& F, int l, int r) {
    CvtDesc d; d.f8 = 0;
    if (r < 1152) { const int kt = r / 72, nt = r % 72; d.src = inp(F, I_WIN) + ((size_t)l * 2048 + kt * 128) * INW + nt * 64; d.ldsrc = INW; d.dst = fWIN(F) + ((size_t)l * INW + nt * 64) * DM + kt * 128; d.lddst = DM; }
    else if (r < 1664) { r -= 1152; const int kt = r / 32, nt = r % 32; d.src = inp(F, I_WOUT) + ((size_t)l * 2048 + kt * 128) * DM + nt * 64; d.ldsrc = DM; d.dst = fWOUT(F) + ((size_t)l * DM + nt * 64) * DM + kt * 128; d.lddst = DM; }
    else if (r < 1664 + 16384) { r -= 1664; const int up = r >= 8192; r -= up * 8192; const int e = r >> 8, t = r & 255, kt = t >> 4, nt = t & 15, n0 = nt * 64;
        d.src = inp(F, up ? I_MWU : I_MWG) + ((size_t)(l * NEXP + e) * 2048 + kt * 128) * HID + n0; d.ldsrc = HID;
        const int drow = 256 * (n0 >> 7) + (n0 & 127) + up * 128; d.dst = fW1(F) + ((size_t)(l * NEXP + e) * 2048 + drow) * DM + kt * 128; d.lddst = DM; d.f8 = 1; }
    else if (r < 1664 + 24576) { r -= 1664 + 16384; const int e = r >> 8, t = r & 255, kt = t >> 5, nt = t & 31;
        d.src = inp(F, I_MWD) + ((size_t)(l * NEXP + e) * HID + kt * 128) * DM + nt * 64; d.ldsrc = DM; d.dst = fW2(F) + ((size_t)(l * NEXP + e) * DM + nt * 64) * HID + kt * 128; d.lddst = HID; d.f8 = 1; }
    else { r -= 1664 + 24576; const int mat = r >> 1, nt = r & 1, gate = mat >> 4, dd = (mat >> 3) & 1, n = mat & 7;
        d.src = inp(F, gate ? I_LRUWI : I_LRUWR) + ((size_t)((l * 2 + dd) * 8 + n) * 128) * 128 + nt * 64; d.ldsrc = 128;
        d.dst = fLRUW(F) + ((size_t)(((l * 2 + dd) * 8 + n) * 2 + gate) * 128 + nt * 64) * 128; d.lddst = 128; }
    return d;
}
__device__ __forceinline__ CvtDesc cvt_desc_g(const Frame& F, int g) {
    const int l = g >= P0_CV_L ? 1 : 0, sidx = g - l * P0_CV_L;
    const int r = sidx < 1664 ? sidx : (sidx < 1728 ? 26240 + (sidx - 1664) : sidx - 64);
    return cvt_desc(F, l, r);
}
__device__ __forceinline__ void cvt_run(const Frame& F, int first, int stride, int end, LAS float* T) {
    const int tid = F.tid, kk = tid >> 4, n4 = tid & 15, wv = tid >> 6, lane = tid & 63;
    if (first >= end) return;
    f32x4 v[4]; CvtDesc d = cvt_desc_g(F, first);
#pragma unroll
    for (int q = 0; q < 4; ++q) v[q] = __builtin_nontemporal_load((const f32x4*)(d.src + (size_t)(q * 32 + kk) * d.ldsrc + n4 * 4));
    int buf = 0;
#pragma unroll 1
    for (int r = first; r < end; r += stride, buf ^= 1) {
        LAS float* Tb = T + buf * (128 * 65);
#pragma unroll
        for (int q = 0; q < 4; ++q) { const int kr = q * 32 + kk; LAS float* w = Tb + kr * 65 + ((n4 * 4) ^ ((kr >> 4) << 2)); w[0] = v[q][0]; w[1] = v[q][1]; w[2] = v[q][2]; w[3] = v[q][3]; }
        const CvtDesc dc = d;
        if (r + stride < end) { d = cvt_desc_g(F, r + stride);
#pragma unroll
            for (int q = 0; q < 4; ++q) v[q] = __builtin_nontemporal_load((const f32x4*)(d.src + (size_t)(q * 32 + kk) * d.ldsrc + n4 * 4)); }
        __syncthreads();
        if (dc.f8) {
            const int nn = wv * 8 + (lane >> 3), k0 = (lane & 7) * 16; float x[16];
#pragma unroll
            for (int j = 0; j < 16; ++j) x[j] = Tb[(k0 + j) * 65 + (nn ^ ((k0 >> 4) << 2))] * 256.0f;
            *(u32x4*)((unsigned char*)dc.dst + (size_t)nn * dc.lddst + k0) = (u32x4){cvt_pk_fp8x4(x[0], x[1], x[2], x[3]), cvt_pk_fp8x4(x[4], x[5], x[6], x[7]), cvt_pk_fp8x4(x[8], x[9], x[10], x[11]), cvt_pk_fp8x4(x[12], x[13], x[14], x[15])};
        } else {
            const int rr = lane >> 4, k0 = (lane & 15) * 8;
#pragma unroll
            for (int i = 0; i < 2; ++i) { const int nn = wv * 8 + i * 4 + rr; float x[8];
#pragma unroll
                for (int j = 0; j < 8; ++j) x[j] = Tb[(k0 + j) * 65 + (nn ^ ((k0 >> 4) << 2))];
                *(u32x4*)((bf16_t*)dc.dst + (size_t)nn * dc.lddst + k0) = (u32x4){cvt_pk_bf16(x[0], x[1]), cvt_pk_bf16(x[2], x[3]), cvt_pk_bf16(x[4], x[5]), cvt_pk_bf16(x[6], x[7])}; }
        }
    }
    __syncthreads();
}
constexpr int CV_SMALL = 1728, CV_TOTAL = 2 * P0_CV_L;
constexpr int BG_T = 49152;
__device__ __forceinline__ int bg_claim(const Frame& F, int n) {
    LAS int* slot = (LAS int*)(F.lds + LDS_MISC + 256);
    __syncthreads();
    if (F.tid == 0) *slot = __hip_atomic_fetch_add((int*)(F.ws + WS_CTL + CTL_Q), n, __ATOMIC_RELAXED, __HIP_MEMORY_SCOPE_AGENT);
    __syncthreads();
    return *slot;
}
__device__ __forceinline__ void bg_fill(const Frame& F, int quota) {
    if (quota <= 0) return;
    const int g0 = bg_claim(F, quota); if (g0 >= CV_TOTAL) return;
    cvt_run(F, g0, 1, min(g0 + quota, CV_TOTAL), (LAS float*)(F.lds + BG_T));
}
__device__ __forceinline__ void bg_drain(const Frame& F, int target) {
    for (;;) { const int g0 = bg_claim(F, 6); if (g0 >= CV_TOTAL) break; cvt_run(F, g0, 1, min(g0 + 6, CV_TOTAL), (LAS float*)(F.lds + BG_T)); if (g0 + 6 >= target) break; }
}
constexpr int P0_ADA = 384, P0_RT = 96, P0_ROPE = 1, P0_UNITS = P0_ADA + P0_RT + P0_ROPE;
__device__ __forceinline__ void p0_prologue(const Frame& F) {
    const Params& p = *F.p; const int tid = F.tid;
    LAS float* sv = (LAS float*)F.lds;
    LAS float* part = (LAS float*)(F.lds + 24576);
    LAS float* T = (LAS float*)(F.lds + 49152);
    for (int i = tid; i < 3 * 2048; i += NTHR) { const float c = i < 4096 ? inp(F, I_C)[i] : inp(F, I_CCTX)[i - 4096]; sv[i] = c / (1.0f + __expf(-c)); }
    __syncthreads();
    for (int u = F.bx; u < P0_UNITS; u += F.G) {
        if (u < P0_ADA) {
            const int l = u / 192, col0 = (u % 192) * 64, c4 = tid & 15, ks = tid >> 4;
            const float* W = inp(F, I_ADAW) + ((size_t)l * 2048 + ks * 64) * 12288 + col0 + c4 * 4;
            f32x4 a0 = {0, 0, 0, 0}, a1 = a0, a2 = a0;
#pragma unroll 8
            for (int k = 0; k < 64; ++k) { const f32x4 w = __builtin_nontemporal_load((const f32x4*)(W + (size_t)k * 12288)); const float s0 = sv[ks * 64 + k], s1 = sv[2048 + ks * 64 + k], s2 = sv[4096 + ks * 64 + k];
                a0 += w * s0; a1 += w * s1; a2 += w * s2; }
#pragma unroll
            for (int j = 0; j < 4; ++j) { part[(ks * 3 + 0) * 64 + c4 * 4 + j] = a0[j]; part[(ks * 3 + 1) * 64 + c4 * 4 + j] = a1[j]; part[(ks * 3 + 2) * 64 + c4 * 4 + j] = a2[j]; }
            __syncthreads();
            if (tid < 192) { const int v = tid >> 6, c = tid & 63; float s = 0.f;
#pragma unroll
                for (int k = 0; k < 32; ++k) s += part[(k * 3 + v) * 64 + c];
                fMOD(F)[(size_t)(l * 3 + v) * 12288 + col0 + c] = s + inp(F, I_ADAB)[(size_t)l * 12288 + col0 + c]; }
            __syncthreads();
        } else if (u < P0_ADA + P0_RT) {
            const int q = u - P0_ADA, l = q / 48, j = q % 48; bf16_t* wrb = (bf16_t*)fWRT(F);
            for (int k = tid; k < 2048; k += NTHR) { const float v = j < 4 ? inp(F, I_RWG)[((size_t)l * 2048 + k) * 4 + j] : (j < 36 ? inp(F, I_RWE)[((size_t)l * 2048 + k) * 32 + (j - 4)] : 0.f);
                wrb[(size_t)(l * 48 + j) * 2048 + k] = (bf16_t)(cvt_pk_bf16(v, 0.f) & 0xffffu); }
        } else if (u < P0_ADA + P0_RT + P0_ROPE) {
            for (int i = tid; i < 4096; i += NTHR) { const int pos = i >> 5, f = i & 31; const double inv = exp(-9.210340371976184 * (double)f / 32.0); const double ang = (double)pos * inv;
                fROPE(F)[i] = (float)cos(ang); fROPE(F)[4096 + i] = (float)sin(ang); }
        }
    }
    __syncthreads();
    bg_drain(F, CV_SMALL);
}

__device__ __forceinline__ const float* mod_vec(const Frame& F, int l, int row) { const int b = row / TB, t = row - b * TB; return fMOD(F) + (size_t)(l * 3 + (t >= SEQ ? 2 : b)) * 12288; }
typedef u32x4 RowRaw[8];
__device__ __forceinline__ void load_raw(const Frame& F, int l, int row, RowRaw& r) {
    const int lane = F.lane; const int b = row / TB, t = row - b * TB;
    if (l == 0) { const float* src = t >= SEQ ? inp(F, I_CTX) + ((size_t)b * CTXL + (t - SEQ)) * DM : inp(F, I_X) + ((size_t)b * SEQ + t) * DM;
#pragma unroll
        for (int j = 0; j < 8; ++j) r[j] = __builtin_nontemporal_load((const u32x4*)(src + j * 256 + lane * 4));
    } else { const bf16_t* xr = fX(F) + (size_t)row * DM; const unsigned char* y0 = fY(F) + (size_t)row * 2 * DM; const unsigned char* y1 = y0 + DM;
#pragma unroll
        for (int j = 0; j < 8; ++j) { const int c = j * 256 + lane * 4; const u32x2 xw = __builtin_nontemporal_load((const u32x2*)(xr + c)); r[j] = (u32x4){xw.x, xw.y, __builtin_nontemporal_load((const unsigned*)(y0 + c)), __builtin_nontemporal_load((const unsigned*)(y1 + c))}; } }
}
__device__ __forceinline__ void finish_raw(const Frame& F, int l, int row, const RowRaw& r, f32x4 (&xv)[8]) {
    const int lane = F.lane;
    if (l == 0) {
#pragma unroll
        for (int j = 0; j < 8; ++j) xv[j] = __builtin_bit_cast(f32x4, r[j]);
    } else { const float* g = mod_vec(F, l - 1, row) + 10240;
#pragma unroll
        for (int j = 0; j < 8; ++j) { const int c = j * 256 + lane * 4; const f32x4 x = {bflo(r[j].x), bfhi(r[j].x), bflo(r[j].y), bfhi(r[j].y)}, gg = *(const f32x4*)(g + c);
            const unsigned a = r[j].z, bb = r[j].w;
            const f32x2 a0 = __builtin_amdgcn_cvt_pk_f32_fp8((int)a, false), a1 = __builtin_amdgcn_cvt_pk_f32_fp8((int)a, true), b0 = __builtin_amdgcn_cvt_pk_f32_fp8((int)bb, false), b1 = __builtin_amdgcn_cvt_pk_f32_fp8((int)bb, true);
            f32x4 y; y[0] = a0[0] + b0[0]; y[1] = a0[1] + b0[1]; y[2] = a1[0] + b1[0]; y[3] = a1[1] + b1[1]; xv[j] = x + gg * (y * 0.0625f); } }
}
__device__ __forceinline__ float row_rstd(const f32x4 (&xv)[8]) { float s = 0.f;
#pragma unroll
    for (int j = 0; j < 8; ++j) s += xv[j][0] * xv[j][0] + xv[j][1] * xv[j][1] + xv[j][2] * xv[j][2] + xv[j][3] * xv[j][3];
    s = wave_sum(s); return rsqrtf(s * (1.0f / DM) + EPS); }

__device__ __forceinline__ void n1_phase(const Frame& F, int l, bool dry) {
    const int lane = F.lane, stride = F.G * 8;
    int row = F.bx * 8 + F.wave; RowRaw cur, nxt;
    if (row < MTOK) load_raw(F, l, row, cur);
#pragma unroll 1
    for (; row < MTOK; row += stride) {
        const bool hn = row + stride < MTOK;
        if (hn) load_raw(F, l, row + stride, nxt);
        f32x4 xv[8]; finish_raw(F, l, row, cur, xv);
        bf16_t* xo = (dry ? fP(F) : fX(F)) + (size_t)row * DM;
#pragma unroll
        for (int j = 0; j < 8; ++j) { u32x2 w; w.x = cvt_pk_bf16(xv[j][0], xv[j][1]); w.y = cvt_pk_bf16(xv[j][2], xv[j][3]); *(u32x2*)(xo + j * 256 + lane * 4) = w; }
        const float rstd = row_rstd(xv); const float* mv = mod_vec(F, l, row); const float* g = inp(F, I_N1G) + (size_t)l * DM; bf16_t* ho = (dry ? fMIX(F) : fHB(F)) + (size_t)row * DM;
#pragma unroll
        for (int j = 0; j < 8; ++j) { const int c = j * 256 + lane * 4; const f32x4 gg = *(const f32x4*)(g + c), sh = *(const f32x4*)(mv + c), sc = *(const f32x4*)(mv + 2048 + c);
            const f32x4 h = xv[j] * rstd * gg * (sc + 1.0f) + sh; u32x2 w; w.x = cvt_pk_bf16(h[0], h[1]); w.y = cvt_pk_bf16(h[2], h[3]); *(u32x2*)(ho + c) = w; }
#pragma unroll
        for (int j = 0; j < 8; ++j) cur[j] = nxt[j];
    }
}
__device__ __forceinline__ void fin_phase(const Frame& F) {
    const int lane = F.lane, stride = F.G * 8;
    int q = F.bx * 8 + F.wave; RowRaw cur, nxt;
#define FIN_ROW(qq) (((qq) / SEQ) * TB + ((qq) % SEQ))
    if (q < NB * SEQ) load_raw(F, 2, FIN_ROW(q), cur);
#pragma unroll 1
    for (; q < NB * SEQ; q += stride) {
        const bool hn = q + stride < NB * SEQ;
        if (hn) load_raw(F, 2, FIN_ROW(q + stride), nxt);
        f32x4 xv[8]; finish_raw(F, 2, FIN_ROW(q), cur, xv);
        const float rstd = row_rstd(xv); const float* g = inp(F, I_FING); float* o = (float*)inp(F, I_OUT) + (size_t)q * DM;
#pragma unroll
        for (int j = 0; j < 8; ++j) { const int c = j * 256 + lane * 4; __builtin_nontemporal_store(xv[j] * rstd * *(const f32x4*)(g + c), (f32x4*)(o + c)); }
#pragma unroll
        for (int j = 0; j < 8; ++j) cur[j] = nxt[j];
    }
#undef FIN_ROW
}

constexpr int N2_T = 0, N2_TP = 2056, N2_RED = 16 * N2_TP * 2, N2_LG = N2_RED + 8 * 16 * 48 * 4, N2_CTL = N2_LG + 16 * 48 * 4;
__device__ __forceinline__ void n2_phase(const Frame& F, int l, bool dry) {
    const int lane = F.lane, tid = F.tid, wave = F.wave;
    LAS bf16_t* T = (LAS bf16_t*)(F.lds + N2_T); LAS float* RED = (LAS float*)(F.lds + N2_RED); LAS float* LG = (LAS float*)(F.lds + N2_LG);
    LAS int* lc = (LAS int*)(F.lds + N2_CTL);
    LAS int* gb = lc + 32;
    LAS int* ri = gb + 32;
    LAS float* rw = (LAS float*)(ri + 66 * 4);
    if (tid < 32) lc[tid] = 0;
    __syncthreads();
    const int r0 = F.bx * 66;
    const bf16_t* wrb = (const bf16_t*)fWRT(F) + (size_t)l * 48 * 2048;
    const float* g = inp(F, I_N2G) + (size_t)l * DM; const float* rbg = inp(F, I_RBG) + l * 4; const float* rbe = inp(F, I_RBE) + l * 32;
    bf16x8 WA[8][3];
    { const int fr_ = lane & 15, kq_ = lane >> 4;
#pragma unroll
      for (int s8 = 0; s8 < 8; ++s8)
#pragma unroll
          for (int t3 = 0; t3 < 3; ++t3) WA[s8][t3] = *(const bf16x8*)(wrb + (size_t)(t3 * 16 + fr_) * 2048 + (wave * 8 + s8) * 32 + kq_ * 8); }
    u32x2 xraw[2][8];
#define N2_LOADX(ubv) do { _Pragma("unroll") for (int q2 = 0; q2 < 2; ++q2) { const int rr_ = wave * 2 + q2, row_ = r0 + (ubv) + rr_; const int t_ = row_ % TB; \
        const bool ok_ = ((ubv) + rr_ < 66) && !(l == 1 && t_ >= SEQ); const bf16_t* xr_ = fX(F) + (size_t)row_ * DM; \
        _Pragma("unroll") for (int j = 0; j < 8; ++j) xraw[q2][j] = ok_ ? *(const u32x2*)(xr_ + j * 256 + lane * 4) : (u32x2){0u, 0u}; } } while (0)
    N2_LOADX(0);
#pragma unroll 1
    for (int ub = 0; ub < 66; ub += 16) {
        const int nrow = min(16, 66 - ub);
#pragma unroll
        for (int q2 = 0; q2 < 2; ++q2) {
            const int rr = wave * 2 + q2;
            const int i = ub + rr, row = r0 + i; const int b = row / TB, t = row - b * TB;
            const bool ok = (rr < nrow) && !(l == 1 && t >= SEQ);
            if (ok) {
            f32x4 xv[8];
#pragma unroll
            for (int j = 0; j < 8; ++j) { const u32x2 xw = xraw[q2][j]; xv[j] = (f32x4){bflo(xw.x), bfhi(xw.x), bflo(xw.y), bfhi(xw.y)}; }
            const float rstd = row_rstd(xv); const float* mv = mod_vec(F, l, row); unsigned char* ho = fHB8(F) + (size_t)row * DM;
#pragma unroll
            for (int j = 0; j < 8; ++j) { const int c = j * 256 + lane * 4; const f32x4 gg = *(const f32x4*)(g + c), sh = *(const f32x4*)(mv + 6144 + c), sc = *(const f32x4*)(mv + 8192 + c);
                const f32x4 h = xv[j] * rstd * gg * (sc + 1.0f) + sh; u32x2 w; w.x = cvt_pk_bf16(h[0], h[1]); w.y = cvt_pk_bf16(h[2], h[3]); *(unsigned*)(ho + c) = cvt_pk_fp8x4_sat(h[0], h[1], h[2], h[3]); *(LAS u32x2*)(T + rr * N2_TP + c) = w; }
            }
        }
        if (ub + 16 < 66) N2_LOADX(ub + 16);
        __syncthreads();
        { const int fr = lane & 15, kq = lane >> 4;
          f32x4 acc[3] = {{0, 0, 0, 0}, {0, 0, 0, 0}, {0, 0, 0, 0}};
#pragma unroll
          for (int s = 0; s < 8; ++s) { const int k0 = (wave * 8 + s) * 32 + kq * 8;
              const bf16x8 tb = *(const LAS bf16x8*)(T + fr * N2_TP + k0);
#pragma unroll
              for (int t3 = 0; t3 < 3; ++t3) acc[t3] = __builtin_amdgcn_mfma_f32_16x16x32_bf16(WA[s][t3], tb, acc[t3], 0, 0, 0); }
#pragma unroll
          for (int t3 = 0; t3 < 3; ++t3) *(LAS f32x4*)(RED + (wave * 16 + fr) * 48 + t3 * 16 + kq * 4) = acc[t3]; }
        __syncthreads();
        for (int q = tid; q < 16 * 48; q += NTHR) { float s = 0.f;
#pragma unroll
            for (int w = 0; w < 8; ++w) s += RED[w * 768 + q];
            const int e = q % 48; LG[q] = s + (e < 4 ? rbg[e] : (e < 36 ? rbe[e - 4] : 0.f)); }
        __syncthreads();
        if (tid < nrow) {
            const int i = ub + tid, row = r0 + i; const int b = row / TB, t = row - b * TB;
            if (l == 1 && t >= SEQ) ri[i * 4] = -1;
            else {
                const LAS float* lg = LG + tid * 48;
                int gs = 0; float gm = lg[0];
#pragma unroll
                for (int k = 1; k < 4; ++k) if (lg[k] > gm) { gm = lg[k]; gs = k; }
                float den = 0.f;
#pragma unroll
                for (int k = 0; k < 4; ++k) den += __expf(lg[k] - gm);
                const float ggate = 1.0f / den;
                const LAS float* le = lg + 4 + gs * 8;
                int i0 = 0; float v0 = le[0];
#pragma unroll
                for (int k = 1; k < 8; ++k) if (le[k] > v0) { v0 = le[k]; i0 = k; }
                int i1 = -1; float v1 = -3.0e38f;
#pragma unroll
                for (int k = 0; k < 8; ++k) if (k != i0 && le[k] > v1) { v1 = le[k]; i1 = k; }
                const float e1 = __expf(v1 - v0), w0 = ggate / (1.0f + e1), w1 = ggate * e1 / (1.0f + e1);
                const int ex0 = gs * 8 + i0, ex1 = gs * 8 + i1;
                const int lp0 = __hip_atomic_fetch_add(lc + ex0, 1, __ATOMIC_RELAXED, __HIP_MEMORY_SCOPE_WORKGROUP), lp1 = __hip_atomic_fetch_add(lc + ex1, 1, __ATOMIC_RELAXED, __HIP_MEMORY_SCOPE_WORKGROUP);
                ri[i * 4 + 0] = ex0; ri[i * 4 + 1] = ex1; ri[i * 4 + 2] = lp0; ri[i * 4 + 3] = lp1; rw[i * 2] = w0; rw[i * 2 + 1] = w1;
            }
        }
    }
#undef N2_LOADX
    __syncthreads();
    if (dry) { __syncthreads(); return; }
    if (tid < 32) { const int c = lc[tid]; gb[tid] = c > 0 ? __hip_atomic_fetch_add(fCNT(F) + l * 32 + tid, c, __ATOMIC_RELAXED, __HIP_MEMORY_SCOPE_AGENT) : 0; }
    __syncthreads();
    if (tid < 66 && ri[tid * 4] >= 0) { const int row = r0 + tid;
#pragma unroll
        for (int k = 0; k < 2; ++k) { const int e = ri[tid * 4 + k]; const size_t pos = (size_t)e * CAP + gb[e] + ri[tid * 4 + 2 + k]; fLDEST(F)[pos] = row * 2 + k; fLW(F)[pos] = rw[tid * 2 + k]; } }
    __syncthreads();
}

__device__ __forceinline__ void qknorm_phase(const Frame& F, int l) {
    const int lane = F.lane, li = lane & 15;
    const float* COS = fROPE(F); const float* SIN = fROPE(F) + 4096;
    const float* gqp = inp(F, I_QNORM) + l * 128 + li * 8; const float* gkp = inp(F, I_KNORM) + l * 128 + li * 8;
    const f32x4 gq0 = *(const f32x4*)gqp, gq1 = *(const f32x4*)(gqp + 4), gk0 = *(const f32x4*)gkp, gk1 = *(const f32x4*)(gkp + 4);
    const int half = (li >> 2) & 1, axis = li >> 3;
#pragma unroll 1
    for (int row = (F.bx * 8 + F.wave) * 4 + (lane >> 4); row < MTOK; row += F.G * 32) {
        bf16_t* base = fP(F) + (size_t)row * INW + li * 8;
        u32x4 raw[6];
#pragma unroll
        for (int sl = 0; sl < 6; ++sl) raw[sl] = *(const u32x4*)(base + (sl < 4 ? C_QA + sl * 128 : C_KA + (sl - 4) * 128));
        const int t = row % TB; const bool rope = t < SEQ;
        const int pos = axis ? (t & 63) : (t >> 6); const int fb = (rope ? pos : 0) * 32 + (li & 3) * 8;
        const f32x4 c0 = *(const f32x4*)(COS + fb), c1 = *(const f32x4*)(COS + fb + 4), s0 = *(const f32x4*)(SIN + fb), s1 = *(const f32x4*)(SIN + fb + 4);
#pragma unroll
        for (int sl = 0; sl < 6; ++sl) {
            const u32x4 rw = raw[sl];
            float v[8] = {bflo(rw.x), bfhi(rw.x), bflo(rw.y), bfhi(rw.y), bflo(rw.z), bfhi(rw.z), bflo(rw.w), bfhi(rw.w)};
            float ss = 0.f;
#pragma unroll
            for (int e = 0; e < 8; ++e) ss += v[e] * v[e];
            ss += __shfl_xor(ss, 1); ss += __shfl_xor(ss, 2); ss += __shfl_xor(ss, 4); ss += __shfl_xor(ss, 8);
            const float rstd = rsqrtf(ss * (1.0f / 128.0f) + EPS);
            const f32x4 g0 = sl < 4 ? gq0 : gk0, g1 = sl < 4 ? gq1 : gk1;
#pragma unroll
            for (int e = 0; e < 4; ++e) { v[e] = v[e] * rstd * g0[e]; v[4 + e] = v[4 + e] * rstd * g1[e]; }
            float pr[8];
#pragma unroll
            for (int e = 0; e < 8; ++e) pr[e] = __shfl_xor(v[e], 4);
            if (rope) {
#pragma unroll
                for (int e = 0; e < 8; ++e) { const float c = e < 4 ? c0[e] : c1[e - 4], sn = e < 4 ? s0[e] : s1[e - 4]; v[e] = half ? v[e] * c + pr[e] * sn : v[e] * c - pr[e] * sn; } }
            u32x4 w; w.x = cvt_pk_bf16(v[0], v[1]); w.y = cvt_pk_bf16(v[2], v[3]); w.z = cvt_pk_bf16(v[4], v[5]); w.w = cvt_pk_bf16(v[6], v[7]);
            *(u32x4*)(base + (sl < 4 ? C_QA + sl * 128 : C_KA + (sl - 4) * 128)) = w;
        }
    }
}

template <int DIR> __device__ __forceinline__ void lru_scan(const f32x16 (&A)[2], f32x16 (&Bv)[2], float h_in, int hi, float& Atot, float& hend, bool want_h) {
    float GA[8], GB[8], PA[8], PB[8], hs[8];
#pragma unroll
    for (int j = 0; j < 8; ++j) { const int mt = j >> 2, rb = (j & 3) * 4; float Bc = 0.f, Ap = 1.f;
#pragma unroll
        for (int q = 0; q < 4; ++q) { const int e = DIR ? 3 - q : q; const float a = A[mt][rb + e], b = Bv[mt][rb + e]; Bc = a * Bc + b; Ap *= a; }
        GA[j] = Ap; GB[j] = Bc; PA[j] = __shfl_xor(Ap, 32); PB[j] = __shfl_xor(Bc, 32); }
    float h = h_in, at = 1.f;
#pragma unroll
    for (int q = 0; q < 8; ++q) { const int j = DIR ? 7 - q : q;
        const bool own_first = DIR ? (hi == 1) : (hi == 0);
        const float a0 = own_first ? GA[j] : PA[j], b0 = own_first ? GB[j] : PB[j], a1 = own_first ? PA[j] : GA[j], b1 = own_first ? PB[j] : GB[j];
        const float h0 = h, h1 = a0 * h0 + b0, h2 = a1 * h1 + b1; hs[j] = own_first ? h0 : h1; h = h2; at *= GA[j] * PA[j]; }
    Atot = at; hend = h;
    if (want_h) {
#pragma unroll
        for (int j = 0; j < 8; ++j) { const int mt = j >> 2, rb = (j & 3) * 4; float hc = hs[j];
#pragma unroll
            for (int q = 0; q < 4; ++q) { const int e = DIR ? 3 - q : q; hc = A[mt][rb + e] * hc + Bv[mt][rb + e]; Bv[mt][rb + e] = hc; } }
    }
}
constexpr int LRU_UCF = 0, LRU_UCB = 32768, LRU_HS = 51200, LRU_CAR = 116736, LRU_CW = 126464;
template <bool FINAL> __device__ __forceinline__ void lru_units(const Frame& F, int l) {
    int tz = threadIdx.x; asm volatile("" : "+v"(tz)); const int tid = tz, lane = tid & 63, wave = __builtin_amdgcn_readfirstlane(tid >> 6), r32 = lane & 31, hi = lane >> 5, d = wave >> 2, cg = wave & 3;
    LAS float* UCf = (LAS float*)(F.lds + LRU_UCF); LAS bf16_t* UCb = (LAS bf16_t*)(F.lds + LRU_UCB); LAS float* HS = (LAS float*)(F.lds + LRU_HS);
    LAS float* CAR = (LAS float*)(F.lds + LRU_CAR); LAS float* CW = (LAS float*)(F.lds + LRU_CW);
    const int nch = (FINAL && l == 1) ? SEQ / 64 : NCHUNK;
    const int nunits = NB * nch * 8;
    const int n = F.bx & 7;
    const int ch = n * 128 + cg * 32 + r32;
    const int q0 = F.bx >> 3;
    for (int i = tid; i < 640; i += NTHR) CW[i] = i < 512 ? inp(F, I_CONVW)[(size_t)l * 4096 + (i >> 7) * 1024 + n * 128 + (i & 127)] : inp(F, I_CONVB)[(size_t)l * 1024 + n * 128 + (i - 512)];
    if (FINAL) {
        const int cb_ = tid >> 8, cd = (tid >> 7) & 1, cl = tid & 127;
        const f32x2* ag = fAGG(F) + (size_t)((cb_ * 2 + cd) * NCHUNK) * 1024 + n * 128 + cl;
        float h = 0.f;
#pragma unroll 1
        for (int p0 = 0; p0 < NCHUNK; p0 += 12) {
            f32x2 ab[12];
#pragma unroll
            for (int j = 0; j < 12; ++j) { const int pp = p0 + j; const int cc = cd ? (NCHUNK - 1 - pp) : (pp + 128) % NCHUNK; ab[j] = ag[(size_t)cc * 1024]; }
#pragma unroll
            for (int j = 0; j < 12; ++j) { const int pp = p0 + j; const int cc = cd ? (NCHUNK - 1 - pp) : (pp + 128) % NCHUNK;
                if (cc < nch) { const int q = cb_ * nch + cc - q0; if (q >= 0 && (q & 31) == 0) CAR[((q >> 5) * 2 + cd) * 128 + cl] = h; }
                h = ab[j].x * h + ab[j].y; }
        }
    }
    bf16x8 Br[8], Bi[8];
    { const bf16_t* wb = fLRUW(F) + ((size_t)(((l * 2 + d) * 8 + n) * 2) * 128 + cg * 32 + r32) * 128 + hi * 8;
#pragma unroll
      for (int s = 0; s < 8; ++s) { Br[s] = *(const bf16x8*)(wb + s * 16); Bi[s] = *(const bf16x8*)(wb + 128 * 128 + s * 16); } }
    const float brv = -1.4426950409f * inp(F, I_LRUBR)[(l * 2 + d) * 1024 + ch], biv = -1.4426950409f * inp(F, I_LRUBI)[(l * 2 + d) * 1024 + ch];
    const float lam = inp(F, I_LAM)[(l * 2 + d) * 1024 + ch]; const float sp8 = -8.0f * 1.4426950409f * log1pf(__expf(-lam));
    const int tok = tid >> 3, ch0 = (tid & 7) * 16;
    u32x4 U[4][2];
#define LRU_LOADU(uu) do { const int q_ = (uu) >> 3, b_ = q_ / nch, c_ = q_ - b_ * nch; const int t_ = c_ * 64 + tok, lo_ = c_ >= 128 ? SEQ : 0, hi_ = c_ >= 128 ? TB : SEQ; \
        _Pragma("unroll") for (int i = 0; i < 4; ++i) { const int tt = t_ - 1 + i; if (tt >= lo_ && tt < hi_) { const bf16_t* up = fP(F) + ((size_t)(b_ * TB + tt)) * INW + C_UB + n * 128 + ch0; U[i][0] = *(const u32x4*)up; U[i][1] = *(const u32x4*)(up + 8); } \
            else { U[i][0] = (u32x4){0u, 0u, 0u, 0u}; U[i][1] = (u32x4){0u, 0u, 0u, 0u}; } } } while (0)
    if (F.bx < nunits) LRU_LOADU(F.bx);
    __syncthreads();
    int kk = 0;
#pragma unroll 1
    for (int u = F.bx; u < nunits; u += F.G, ++kk) {
        const int q = u >> 3, b = q / nch, c = q - b * nch;
        { float y[16];
#pragma unroll
          for (int j = 0; j < 16; j += 4) { const f32x4 bv = *(const LAS f32x4*)(CW + 512 + ch0 + j); y[j] = bv[0]; y[j + 1] = bv[1]; y[j + 2] = bv[2]; y[j + 3] = bv[3]; }
#pragma unroll
          for (int i = 0; i < 4; ++i) { const u32x4 u0 = U[i][0], u1 = U[i][1];
              const float uu[16] = {bflo(u0.x), bfhi(u0.x), bflo(u0.y), bfhi(u0.y), bflo(u0.z), bfhi(u0.z), bflo(u0.w), bfhi(u0.w), bflo(u1.x), bfhi(u1.x), bflo(u1.y), bfhi(u1.y), bflo(u1.z), bfhi(u1.z), bflo(u1.w), bfhi(u1.w)};
#pragma unroll
              for (int j = 0; j < 16; j += 4) { const f32x4 wv = *(const LAS f32x4*)(CW + i * 128 + ch0 + j); y[j] += wv[0] * uu[j]; y[j + 1] += wv[1] * uu[j + 1]; y[j + 2] += wv[2] * uu[j + 2]; y[j + 3] += wv[3] * uu[j + 3]; } }
#pragma unroll
          for (int j = 0; j < 16; j += 4) *(LAS f32x4*)(UCf + tok * 128 + ch0 + j) = (f32x4){y[j], y[j + 1], y[j + 2], y[j + 3]};
          LAS u32x4* ub = (LAS u32x4*)(UCb + tok * 136 + ch0);
          ub[0] = (u32x4){cvt_pk_bf16(y[0], y[1]), cvt_pk_bf16(y[2], y[3]), cvt_pk_bf16(y[4], y[5]), cvt_pk_bf16(y[6], y[7])};
          ub[1] = (u32x4){cvt_pk_bf16(y[8], y[9]), cvt_pk_bf16(y[10], y[11]), cvt_pk_bf16(y[12], y[13]), cvt_pk_bf16(y[14], y[15])}; }
        u32x4 g0 = {0u, 0u, 0u, 0u}, g1 = g0;
        const size_t row = (size_t)b * TB + c * 64 + tok;
        if (FINAL) { const bf16_t* gp = fP(F) + row * INW + C_GB + n * 128 + ch0; g0 = *(const u32x4*)gp; g1 = *(const u32x4*)(gp + 8); }
        if (u + F.G < nunits) LRU_LOADU(u + F.G);
        __syncthreads();
        f32x16 av[2] = {}, bv[2] = {};
#pragma unroll
        for (int s = 0; s < 8; ++s)
#pragma unroll
            for (int mt = 0; mt < 2; ++mt) { const bf16x8 a = *(const LAS bf16x8*)(UCb + (mt * 32 + r32) * 136 + s * 16 + hi * 8);
                av[mt] = __builtin_amdgcn_mfma_f32_32x32x16_bf16(a, Br[s], av[mt], 0, 0, 0); bv[mt] = __builtin_amdgcn_mfma_f32_32x32x16_bf16(a, Bi[s], bv[mt], 0, 0, 0); }
        u32x4* lab = fLAB(F) + ((size_t)(u * 8 + wave) * 8) * 64 + lane;
#pragma unroll
        for (int mt = 0; mt < 2; ++mt)
#pragma unroll
            for (int rg = 0; rg < 4; ++rg) { unsigned w4[4];
#pragma unroll
                for (int j = 0; j < 4; ++j) { const int r = rg * 4 + j; const int tk = mt * 32 + (r & 3) + 8 * (r >> 2) + 4 * hi; const float uc = UCf[tk * 128 + cg * 32 + r32];
                    const float e1 = __builtin_amdgcn_exp2f(fminf(fmaf(av[mt][r], -1.4426950409f, brv), 40.f)), e2 = __builtin_amdgcn_exp2f(fminf(fmaf(bv[mt][r], -1.4426950409f, biv), 40.f));
                    const float d1 = 1.0f + e1, d2 = 1.0f + e2, rc = __builtin_amdgcn_rcpf(d1 * d2); const float la = sp8 * (rc * d2); const float a = __builtin_amdgcn_exp2f(la);
                    const float bb = __builtin_amdgcn_sqrtf(fmaxf(fmaf(-a, a, 1.0f), 0.f)) * (rc * d1) * uc; av[mt][r] = a; bv[mt][r] = bb;
                    if (!FINAL) { const _Float16 hl = (_Float16)la; w4[j] = ((unsigned)__builtin_bit_cast(unsigned short, hl) << 16) | (cvt_pk_bf16(bb, 0.f) & 0xffffu); } }
                if (!FINAL) lab[(mt * 4 + rg) * 64] = (u32x4){w4[0], w4[1], w4[2], w4[3]}; }
        if (!FINAL) {
            float At, he;
            if (d == 0) lru_scan<0>(av, bv, 0.f, hi, At, he, false); else lru_scan<1>(av, bv, 0.f, hi, At, he, false);
            if (hi == 0) fAGG(F)[(size_t)((b * 2 + d) * NCHUNK + c) * 1024 + ch] = (f32x2){At, he};
            __syncthreads();
        } else {
            const float h_in = CAR[(kk * 2 + d) * 128 + cg * 32 + r32];
            float At, he;
            if (d == 0) lru_scan<0>(av, bv, h_in, hi, At, he, true); else lru_scan<1>(av, bv, h_in, hi, At, he, true);
#pragma unroll
            for (int mt = 0; mt < 2; ++mt)
#pragma unroll
                for (int r = 0; r < 16; ++r) { const int tk = mt * 32 + (r & 3) + 8 * (r >> 2) + 4 * hi; HS[(d * 64 + tk) * 128 + cg * 32 + r32] = bv[mt][r]; }
            __syncthreads();
            { const float gg[16] = {bflo(g0.x), bfhi(g0.x), bflo(g0.y), bfhi(g0.y), bflo(g0.z), bfhi(g0.z), bflo(g0.w), bfhi(g0.w), bflo(g1.x), bfhi(g1.x), bflo(g1.y), bfhi(g1.y), bflo(g1.z), bfhi(g1.z), bflo(g1.w), bfhi(g1.w)};
              float o[16];
#pragma unroll
              for (int j = 0; j < 16; ++j) o[j] = (HS[tok * 128 + ch0 + j] + HS[(64 + tok) * 128 + ch0 + j]) * gelu_tanh(gg[j]);
              u32x4* op = (u32x4*)(fMIX(F) + row * DM + 512 + n * 128 + ch0);
              op[0] = (u32x4){cvt_pk_bf16(o[0], o[1]), cvt_pk_bf16(o[2], o[3]), cvt_pk_bf16(o[4], o[5]), cvt_pk_bf16(o[6], o[7])};
              op[1] = (u32x4){cvt_pk_bf16(o[8], o[9]), cvt_pk_bf16(o[10], o[11]), cvt_pk_bf16(o[12], o[13]), cvt_pk_bf16(o[14], o[15])}; }
            __syncthreads();
        }
    }
#undef LRU_LOADU
}

__device__ __forceinline__ void lru_pass2(const Frame& F, int l) {
    int tz = threadIdx.x; asm volatile("" : "+v"(tz)); const int tid = tz, lane = tid & 63, wave = __builtin_amdgcn_readfirstlane(tid >> 6), r32 = lane & 31, hi = lane >> 5, d = wave >> 2, cg = wave & 3;
    LAS float* HS = (LAS float*)(F.lds + LRU_HS); LAS float* CAR = (LAS float*)(F.lds + LRU_CAR);
    const int nch = (l == 1) ? SEQ / 64 : NCHUNK;
    const int nunits = NB * nch * 8, n = F.bx & 7, q0 = F.bx >> 3;
    { const int cb_ = tid >> 8, cd = (tid >> 7) & 1, cl = tid & 127;
      const f32x2* ag = fAGG(F) + (size_t)((cb_ * 2 + cd) * NCHUNK) * 1024 + n * 128 + cl;
      float h = 0.f;
#pragma unroll 1
      for (int p0 = 0; p0 < NCHUNK; p0 += 12) {
          f32x2 ab[12];
#pragma unroll
          for (int j = 0; j < 12; ++j) { const int pp = p0 + j; const int cc = cd ? (NCHUNK - 1 - pp) : (pp + 128) % NCHUNK; ab[j] = ag[(size_t)cc * 1024]; }
#pragma unroll
          for (int j = 0; j < 12; ++j) { const int pp = p0 + j; const int cc = cd ? (NCHUNK - 1 - pp) : (pp + 128) % NCHUNK;
              if (cc < nch) { const int q = cb_ * nch + cc - q0; if (q >= 0 && (q & 31) == 0) CAR[((q >> 5) * 2 + cd) * 128 + cl] = h; }
              h = ab[j].x * h + ab[j].y; }
      } }
    const int tok = tid >> 3, ch0 = (tid & 7) * 16;
    u32x4 W[8];
#define LRU_LOADW(uu) do { const int q_ = (uu) >> 3, b_ = q_ / nch, c_ = q_ - b_ * nch; const u32x4* lab_ = fLAB(F) + ((size_t)(((b_ * NCHUNK + c_) * 8 + n) * 8 + wave) * 8) * 64 + lane; \
        _Pragma("unroll") for (int q8 = 0; q8 < 8; ++q8) W[q8] = __builtin_nontemporal_load(lab_ + q8 * 64); } while (0)
    if (F.bx < nunits) LRU_LOADW(F.bx);
    __syncthreads();
    int kk = 0;
#pragma unroll 1
    for (int u = F.bx; u < nunits; u += F.G, ++kk) {
        const int q = u >> 3, b = q / nch, c = q - b * nch;
        f32x16 av[2], bv[2];
#pragma unroll
        for (int q8 = 0; q8 < 8; ++q8)
#pragma unroll
            for (int j = 0; j < 4; ++j) { const unsigned w = W[q8][j]; const int mt = q8 >> 2, r = (q8 & 3) * 4 + j;
                av[mt][r] = __builtin_amdgcn_exp2f((float)__builtin_bit_cast(_Float16, (unsigned short)(w >> 16))); bv[mt][r] = __uint_as_float(w << 16); }
        const size_t row = (size_t)b * TB + c * 64 + tok;
        const bf16_t* gp = fP(F) + row * INW + C_GB + n * 128 + ch0; const u32x4 g0 = *(const u32x4*)gp, g1 = *(const u32x4*)(gp + 8);
        if (u + F.G < nunits) LRU_LOADW(u + F.G);
        const float h_in = CAR[(kk * 2 + d) * 128 + cg * 32 + r32];
        float At, he;
        if (d == 0) lru_scan<0>(av, bv, h_in, hi, At, he, true); else lru_scan<1>(av, bv, h_in, hi, At, he, true);
#pragma unroll
        for (int mt = 0; mt < 2; ++mt)
#pragma unroll
            for (int r = 0; r < 16; ++r) { const int tk = mt * 32 + (r & 3) + 8 * (r >> 2) + 4 * hi; HS[(d * 64 + tk) * 128 + cg * 32 + r32] = bv[mt][r]; }
        __syncthreads();
        { const float gg[16] = {bflo(g0.x), bfhi(g0.x), bflo(g0.y), bfhi(g0.y), bflo(g0.z), bfhi(g0.z), bflo(g0.w), bfhi(g0.w), bflo(g1.x), bfhi(g1.x), bflo(g1.y), bfhi(g1.y), bflo(g1.z), bfhi(g1.z), bflo(g1.w), bfhi(g1.w)};
          float o[16];
#pragma unroll
          for (int j = 0; j < 16; ++j) o[j] = (HS[tok * 128 + ch0 + j] + HS[(64 + tok) * 128 + ch0 + j]) * gelu_tanh(gg[j]);
          u32x4* op = (u32x4*)(fMIX(F) + row * DM + 512 + n * 128 + ch0);
          op[0] = (u32x4){cvt_pk_bf16(o[0], o[1]), cvt_pk_bf16(o[2], o[3]), cvt_pk_bf16(o[4], o[5]), cvt_pk_bf16(o[6], o[7])};
          op[1] = (u32x4){cvt_pk_bf16(o[8], o[9]), cvt_pk_bf16(o[10], o[11]), cvt_pk_bf16(o[12], o[13]), cvt_pk_bf16(o[14], o[15])}; }
        __syncthreads();
    }
#undef LRU_LOADW
}

#ifndef ATT_REP_MODE
#define ATT_REP_MODE 7
#endif
__device__ __forceinline__ void attn_phase(const Frame& F, int l, int rep) {
    const int amode = rep ? ATT_REP_MODE : 7;
    const Params& p = *F.p; const int bx = F.bx;
    const int x = bx & 7, o = (bx >> 3) & 31;
    const bool p2_first = ((bx >> 3) & 1) != 0;
#ifndef LRU2_SKIP
    if ((amode & 4) && p2_first) lru_pass2(F, l);
#endif
#ifndef NA_SKIP
    if (amode & 2) {
        att::Job J; J.mode = 1;
        const int b = x >> 2, h = x & 3, rg = o;
        float* rp = (float*)(F.ldsg + att::RPB_OFF);
        for (int i = F.tid; i < 15 * 31; i += NTHR) rp[i] = inp(F, I_RPB)[(size_t)(l * 4 + h) * 465 + i] * (1.0f / att::SCALE);
        J.Q = fP(F) + ((size_t)b * TB + rg * 256) * INW + C_QN + h * 128; J.K = fP(F) + C_KN + h * 128; J.V = fP(F) + C_VN + h * 128;
        J.O = fMIX(F) + ((size_t)b * TB + rg * 256) * DM + 1536 + h * 128; J.nt = 16; J.row_a = b * TB + SEQ; J.gr0 = rg * 4;
        J.kstart = min(max(rg * 4 - 4, 0), 116); J.row_b = b * TB + J.kstart * 64;
        att::opaque(J); att::attn_unit_na(J, F.ldsg);
    }
#endif
#ifndef GQA_SKIP
    const int njobs = (amode & 1) ? ((l == 0 && bx < 16) ? 2 : 1) : 0;
#pragma unroll 1
    for (int k = 0; k < njobs; ++k) {
        att::Job J; J.mode = 0; J.row_b = 0; J.gr0 = 0; J.kstart = 0;
        int qc, kc, vc, oc, q0;
        if (k == 0) { const int b = x >> 2, kvh = (x >> 1) & 1, hq = kvh * 2 + (x & 1); q0 = b * TB + o * 256; qc = C_QA + hq * 128; kc = C_KA + kvh * 128; vc = C_VA + kvh * 128; oc = hq * 128; J.nt = TB / 64; J.row_a = b * TB; }
        else { const int b = bx >> 3, hh = bx & 7; q0 = b * TB + SEQ; J.nt = 4; J.row_a = q0;
            qc = hh < 4 ? C_QA + hh * 128 : C_QN + (hh - 4) * 128; kc = hh < 4 ? C_KA + (hh >> 1) * 128 : C_KN + (hh - 4) * 128; vc = hh < 4 ? C_VA + (hh >> 1) * 128 : C_VN + (hh - 4) * 128; oc = hh < 4 ? hh * 128 : 1536 + (hh - 4) * 128; }
        J.Q = fP(F) + (size_t)q0 * INW + qc; J.K = fP(F) + kc; J.V = fP(F) + vc; J.O = fMIX(F) + (size_t)q0 * DM + oc;
        att::opaque(J); att::attn_unit<0>(J, F.ldsg);
    }
#endif
#ifndef LRU2_SKIP
    if ((amode & 4) && !p2_first) lru_pass2(F, l);
#endif
}

__device__ __forceinline__ int moe_setup(const Frame& F, int l) {
    LAS int* tp = (LAS int*)(F.lds + LDS_MISC); LAS int* ud = (LAS int*)(F.lds + LDS_UD); LAS int* rows = (LAS int*)(F.lds + LDS_ROWS); LAS float* wts = (LAS float*)(F.lds + LDS_WTS);
    const int* cnt = fCNT(F) + l * 32;
    if (F.tid == 0) { int s = 0; for (int e = 0; e < NEXP; ++e) { tp[e] = s; s += (cnt[e] + 255) >> 8; } tp[NEXP] = s; }
    __syncthreads();
    const int total = tp[NEXP] * 8, cc = (F.bx % 8) * (F.G / 8) + F.bx / 8;
    if (F.tid < 8) { const int i = F.tid, L = i * F.G + cc; int e = -1, pn = 0, ml = 0, pm = 0, cv = 0;
        if (L < total) { e = 0; for (int j = 1; j < NEXP; ++j) e = (L >= tp[j] * 8) ? j : e; const int t0 = tp[e], te = tp[e + 1] - t0, rem = L - t0 * 8; pn = rem / te; ml = rem % te; pm = t0 + ml; cv = cnt[e]; }
        ud[i * 8 + 0] = e; ud[i * 8 + 1] = pn; ud[i * 8 + 2] = ml; ud[i * 8 + 3] = pm; ud[i * 8 + 4] = cv; }
    __syncthreads();
    for (int q = F.tid; q < 8 * 256; q += NTHR) { const int i = q >> 8, r = q & 255; const int e = ud[i * 8]; int d = -1; float w = 0.f;
        if (e >= 0) { const int idx = ud[i * 8 + 2] * 256 + r; if (idx < ud[i * 8 + 4]) { d = fLDEST(F)[e * CAP + idx]; w = fLW(F)[e * CAP + idx]; } }
        rows[q] = d; wts[q] = w; }
    __syncthreads();
    return total;
}

constexpr int N_PHASES = 18;
__global__ void __launch_bounds__(NTHR, 2) fwd_kernel(Params prm) {
    extern __shared__ __attribute__((aligned(16))) unsigned char lds_raw[];
    Frame F0; F0.p = &prm; F0.ws = nullptr; F0.lds = (LAS unsigned char*)lds_raw; F0.ldsg = (char*)lds_raw;
    F0.tid = threadIdx.x; F0.lane = F0.tid & 63; F0.wave = __builtin_amdgcn_readfirstlane(F0.tid >> 6); F0.bx = blockIdx.x; F0.G = gridDim.x;
    if (threadIdx.x < 4) ((LAS unsigned*)(F0.lds + LDS_BARW))[threadIdx.x] = 0u;
    __syncthreads();
    const int lo = prm.ph_lo, hi = prm.ph_hi;
    if (hi - lo > 1) (void)xcd_barrier_post((unsigned*)inp(F0, I_WS), (volatile LAS unsigned*)(F0.lds + LDS_BARW));
#ifndef BG_ON
#define BG_ON 1
#endif
#ifndef N2_PRE
#define N2_PRE 28
#endif
#define DENSE_SHORT(nwg) ((((nwg) + F.G - 1) / F.G) - (((nwg) - F.bx + F.G - 1) / F.G))
#ifndef PH_MASK
#define PH_MASK 0xFFu
#endif
#define IN(k) (lo <= (k) && (k) < hi && ((PH_MASK >> ((k) == 0 ? 0 : (k) == 17 ? 0 : (((k) - 1) % 8))) & 1u))
#define GRIDBAR() do { XcdBarrier bar_; bar_.bar = (unsigned*)inp(F0, I_WS); bar_.x = xb_xcc_id(); bar_.st = (volatile LAS unsigned*)((LAS unsigned char*)lds_raw + LDS_BARW); xcd_barrier(bar_); } while (0)
#define SEAM(k) do { if (IN(k) && (IN((k) + 1) || rep_ + 1 < REPS(k))) GRIDBAR(); } while (0)
#ifndef DUP_PH
#define DUP_PH -1
#endif
#define REPS(k) (((k) == 0 ? 8 : (k) == 17 ? 9 : ((k) - 1) % 8) == DUP_PH ? 2 : 1)
#define PHASE_BEGIN(lv) Frame F; F.p = &prm; F.lds = (LAS unsigned char*)lds_raw; F.ldsg = (char*)lds_raw; F.ws = (unsigned char*)inp(F, I_WS); const int l = launder_i(lv); (void)l; { int tz_ = threadIdx.x; asm volatile("" : "+v"(tz_)); F.tid = tz_; F.lane = tz_ & 63; F.wave = __builtin_amdgcn_readfirstlane(tz_ >> 6); F.bx = launder_i(blockIdx.x); F.G = launder_i(gridDim.x); }
    if (IN(0)) for (int rep_ = 0; rep_ < REPS(0); ++rep_) { PHASE_BEGIN(0) p0_prologue(F); SEAM(0); }
#pragma unroll 1
    for (int l0 = 0; l0 < 2; ++l0) {
        const int pb = 1 + 8 * l0;
        if (IN(pb + 0)) for (int rep_ = 0; rep_ < REPS(pb + 0); ++rep_) { PHASE_BEGIN(l0) n1_phase(F, l, rep_ != 0); if (!rep_ && l == 1) bg_drain(F, P0_CV_L + CV_SMALL); SEAM(pb + 0); }
        if (IN(pb + 1)) for (int rep_ = 0; rep_ < REPS(pb + 1); ++rep_) { PHASE_BEGIN(l0)
            pg8::DenseOrder S; S.init(fHB(F), fWIN(F) + (size_t)l * INW * DM, MTOK / 256, INW / 256, DM * 2, F.G, F.bx, 0);
            pg8::EpiP E{fP(F)};
            pg8::gemm_phase<pg8::EpiP, pg8::DenseOrder, false, false>(F.lds, DM * 2, S, E);
            if (BG_ON && !rep_) bg_fill(F, DENSE_SHORT((MTOK / 256) * (INW / 256)) * 30);
            SEAM(pb + 1);
        }
        if (IN(pb + 2)) for (int rep_ = 0; rep_ < REPS(pb + 2); ++rep_) { PHASE_BEGIN(l0) if (!rep_) qknorm_phase(F, l); lru_units<false>(F, l); if (BG_ON && !rep_) bg_fill(F, F.bx >= 64 ? 4 : 0); SEAM(pb + 2); }
        if (IN(pb + 3)) for (int rep_ = 0; rep_ < REPS(pb + 3); ++rep_) { PHASE_BEGIN(l0) attn_phase(F, l, rep_); if (BG_ON && !rep_ && l == 0) bg_fill(F, (F.bx >= 16 ? 6 : 0) + (F.bx >= 64 ? 6 : 0)); SEAM(pb + 3); }
        if (IN(pb + 4)) for (int rep_ = 0; rep_ < REPS(pb + 4); ++rep_) { PHASE_BEGIN(l0)
            pg8::DenseOrder S; S.init(fMIX(F), fWOUT(F) + (size_t)l * DM * DM, l == 0 ? MTOK / 256 : NB * SEQ / 256, DM / 256, DM * 2, F.G, F.bx, l == 0 ? 0 : 1);
            pg8::EpiResid E{fX(F), fMOD(F) + (size_t)l * 3 * 12288, rep_ ? 0.0f : 1.0f};
            pg8::gemm_phase<pg8::EpiResid, pg8::DenseOrder, false, false>(F.lds, DM * 2, S, E);
            if (BG_ON && !rep_ && l == 0) bg_fill(F, DENSE_SHORT((MTOK / 256) * (DM / 256)) * 28);
            SEAM(pb + 4);
        }
        if (IN(pb + 5)) for (int rep_ = 0; rep_ < REPS(pb + 5); ++rep_) { PHASE_BEGIN(l0) if (!rep_ && ((F.bx >> 3) & 1)) bg_fill(F, N2_PRE);
            n2_phase(F, l, rep_ != 0); if (!rep_) bg_drain(F, l == 0 ? P0_CV_L : CV_TOTAL); SEAM(pb + 5); }
        if (IN(pb + 6)) for (int rep_ = 0; rep_ < REPS(pb + 6); ++rep_) { PHASE_BEGIN(l0)
            const int mtotal = moe_setup(F, l);
            pg8::MoeOrder S; S.ud = (const LAS int*)(F.lds + LDS_UD); S.rows = (const LAS int*)(F.lds + LDS_ROWS); S.pitch = DM; S.A = (const char*)fHB8(F); S.Bt = (const char*)(fW1(F) + (size_t)l * NEXP * 2048 * DM);
            S.bstride = (size_t)2048 * DM; S.gather = 1;
            pg8::EpiSwiglu E{fACT(F)};
            pg8::gemm_phase<pg8::EpiSwiglu, pg8::MoeOrder, true, true>(F.lds, DM, S, E);
            if (BG_ON && !rep_ && l == 0) { const int cc = (F.bx % 8) * (F.G / 8) + F.bx / 8; bg_fill(F, (((mtotal + F.G - 1) / F.G) - ((mtotal - cc + F.G - 1) / F.G)) * 18); }
            SEAM(pb + 6);
        }
        if (IN(pb + 7)) for (int rep_ = 0; rep_ < REPS(pb + 7); ++rep_) { PHASE_BEGIN(l0)
            const int mtotal = moe_setup(F, l);
            pg8::MoeOrder S; S.ud = (const LAS int*)(F.lds + LDS_UD); S.rows = (const LAS int*)(F.lds + LDS_ROWS); S.pitch = HID; S.A = (const char*)fACT(F); S.Bt = (const char*)(fW2(F) + (size_t)l * NEXP * DM * HID);
            S.bstride = (size_t)DM * HID; S.gather = 0;
            pg8::EpiScatter E{fY(F), (const LAS int*)(F.lds + LDS_ROWS), (const LAS float*)(F.lds + LDS_WTS)};
            pg8::gemm_phase<pg8::EpiScatter, pg8::MoeOrder, false, true>(F.lds, HID, S, E);
            if (BG_ON && !rep_ && l == 0) { const int cc = (F.bx % 8) * (F.G / 8) + F.bx / 8; bg_fill(F, (((mtotal + F.G - 1) / F.G) - ((mtotal - cc + F.G - 1) / F.G)) * 12); }
            SEAM(pb + 7);
        }
    }
    if (IN(17)) for (int rep_ = 0; rep_ < REPS(17); ++rep_) { PHASE_BEGIN(2) fin_phase(F); if (rep_ + 1 < REPS(17)) GRIDBAR(); }
#undef IN
#undef SEAM
}

extern "C" void kernel_launch(void* const* d_in, const int* in_sizes, int n_in, void* d_out, int out_size, void* d_ws, size_t ws_size, hipStream_t stream) {
    static int ok = 0;
    if (ok == 0) {
        if (n_in != 28 || out_size != NB * SEQ * DM || ws_size < WS_END) { fprintf(stderr, "kernel_launch: shape mismatch: n_in %d out %d ws %zu (need %zu)\n", n_in, out_size, ws_size, (size_t)WS_END); ok = -1; return; }
        if (hipFuncSetAttribute((const void*)fwd_kernel, hipFuncAttributeMaxDynamicSharedMemorySize, LDS_BYTES) != hipSuccess) { fprintf(stderr, "kernel_launch: hipFuncSetAttribute failed\n"); ok = -1; return; }
        int per_cu = 0;
        if (hipOccupancyMaxActiveBlocksPerMultiprocessor(&per_cu, (const void*)fwd_kernel, NTHR, LDS_BYTES) != hipSuccess || per_cu < 1) fprintf(stderr, "kernel_launch: occupancy query says %d blocks per CU\n", per_cu);
        (void)hipGetLastError();
        ok = 1;
    }
    if (ok < 0) return;
    (void)hipMemsetAsync((char*)d_ws + WS_CTL, 0, CTL_BYTES, stream);
    Params prm{};
    for (int i = 0; i < 28; ++i) prm.in[i] = (const float*)d_in[i];
    prm.in[I_OUT] = (const float*)d_out; prm.in[I_WS] = (const float*)d_ws;
#if MK_N_LAUNCHES == 1
    prm.ph_lo = 0; prm.ph_hi = N_PHASES;
    hipLaunchKernelGGL(fwd_kernel, dim3(GRID), dim3(NTHR), LDS_BYTES, stream, prm);
#else
    for (int k = 0; k < N_PHASES; ++k) { prm.ph_lo = k; prm.ph_hi = k + 1; hipLaunchKernelGGL(fwd_kernel, dim3(GRID), dim3(NTHR), LDS_BYTES, stream, prm); }
#endif
    const hipError_t le = hipPeekAtLastError();
    if (le != hipSuccess) fprintf(stderr, "kernel_launch: launch failed: %s\n", hipGetErrorName(le));
}
```
